# Optimizing an MI355X kernel written in HIP

```python
import jax
import jax.numpy as jnp
from jax import lax
import numpy as np

D_MODEL = 1024
BATCH = 32
SEQ = 2048
DEPTH = 2
DEC_BATCH = 16
DEC_SEQ = 2048
PAST_LEN = 128

N_META = 16
W_A = 512
A_BLOCKS = 8
A_BLOCK = W_A // A_BLOCKS
CONV_W = 4
LRU_C = 8.0
W_B = 512
RWKV_HEADS = 8
RWKV_HD = W_B // RWKV_HEADS
LORA_W = 64
LORA_A = 64
LORA_G = 128
B_COLS = 3 * W_B + 2 * LORA_W + 2 * LORA_A + LORA_G
RWKV_GN_EPS = 64e-5
W_C = 512
HGRN_HEADS = 4
HGRN_HD = W_C // HGRN_HEADS
HGRN_CHUNK = 16
RET_HEADS = 4
RET_DK = 64
RET_DV = 128
RET_QK = RET_HEADS * RET_DK
W_D = RET_HEADS * RET_DV
RET_CHUNK = 128
ROPE_BASE = 10000.0
N_BRANCH = 4
W_BRANCH = 512
IN_SIZES = (W_A, W_A, B_COLS, W_C, 2 * W_C, W_C, W_C, RET_QK, RET_QK, W_D, W_D, N_BRANCH * D_MODEL)
N_IN = 2 * W_A + B_COLS + 5 * W_C + 2 * RET_QK + 2 * W_D + N_BRANCH * D_MODEL
N_EXPERTS = 16
D_FF_EXPERT = 2 * D_MODEL
EC_CAPACITY = 2
ALPHA = (2 * DEPTH) ** 0.25
BETA = (8 * DEPTH) ** -0.25
LN_EPS = 1e-5
NORM_EPS = 1e-6

kernel_name = 'hybrid_bidir_encoder_ec_moe'


def split_last(u, sizes):
    offs = [int(o) for o in np.cumsum(sizes)[:-1]]
    return jnp.split(u, offs, axis=-1)


def flip_t(t):
    return jnp.flip(t, axis=1)


def layer_norm(x, g, b):
    xf = x.astype(jnp.float32)
    mu = jnp.mean(xf, -1, keepdims=True)
    var = jnp.mean(jnp.square(xf - mu), -1, keepdims=True)
    y = (xf - mu) * lax.rsqrt(var + LN_EPS) * g.astype(jnp.float32) + b.astype(jnp.float32)
    return y.astype(x.dtype)


def head_group_norm(y, eps):
    yf = y.astype(jnp.float32)
    mu = jnp.mean(yf, -1, keepdims=True)
    var = jnp.mean(jnp.square(yf - mu), -1, keepdims=True)
    return (yf - mu) * lax.rsqrt(var + eps)


def head_rms_norm(y, eps):
    yf = y.astype(jnp.float32)
    return yf * lax.rsqrt(jnp.mean(jnp.square(yf), -1, keepdims=True) + eps)


def to_chunks(t, c):
    bn, l, h, x = t.shape
    return t.reshape(bn, l // c, c, h, x).transpose(1, 0, 3, 2, 4).astype(jnp.float32)


def from_chunks(o):
    nc, bn, h, c, x = o.shape
    return o.transpose(1, 0, 3, 2, 4).reshape(bn, nc * c, h, x)


def linear_recurrence(a, b):
    def combine(e1, e2):
        a1, b1 = e1
        a2, b2 = e2
        return a1 * a2, a2 * b1 + b2
    _, h = lax.associative_scan(combine, (a, b), axis=1)
    return h


def rglru_branch(xa, gate, conv_w, conv_b, wr, br, wi, bi, lam):
    bn, l, _ = xa.shape
    xp = jnp.pad(xa, ((0, 0), (CONV_W // 2, CONV_W - 1 - CONV_W // 2), (0, 0)))
    xc = conv_b + sum(xp[:, j:j + l] * conv_w[j] for j in range(CONV_W))
    xb = xc.reshape(bn, l, A_BLOCKS, A_BLOCK)
    h = jnp.zeros((bn, l, W_A), jnp.float32)
    for d in range(2):
        r = jax.nn.sigmoid(jnp.einsum('blgi,gij->blgj', xb, wr[d]).reshape(bn, l, W_A) + br[d])
        i = jax.nn.sigmoid(jnp.einsum('blgi,gij->blgj', xb, wi[d]).reshape(bn, l, W_A) + bi[d])
        log_a = -LRU_C * jax.nn.softplus(-lam[d].astype(jnp.float32)) * r.astype(jnp.float32)
        a = jnp.exp(log_a)
        b = jnp.sqrt(-jnp.expm1(2.0 * log_a)) * (i * xc).astype(jnp.float32)
        if d == 0:
            h = h + linear_recurrence(a, b)
        else:
            h = h + flip_t(linear_recurrence(flip_t(a), flip_t(b)))
    return (jax.nn.gelu(gate.astype(jnp.float32)) * h).astype(xa.dtype)


def rwkv7_scan(r, w, k, v, kk, a):
    bn, l, h, n = r.shape

    def step(s, inp):
        r_t, w_t, k_t, v_t, kk_t, a_t = inp
        sa = jnp.einsum('bhij,bhj->bhi', s, kk_t)
        s = (s * w_t[:, :, None, :] - sa[..., None] * (kk_t * a_t)[:, :, None, :]
             + v_t[..., None] * k_t[:, :, None, :])
        return s, jnp.einsum('bhij,bhj->bhi', s, r_t)

    xs = tuple(jnp.swapaxes(t, 0, 1) for t in (r, w, k, v, kk, a))
    s0 = jnp.zeros((bn, h, n, n), jnp.float32)
    _, y = lax.scan(step, s0, xs)
    return jnp.swapaxes(y, 0, 1)


def rwkv7_branch(cols, mu, w0, w2, a0, a2, g2, k_k, k_a, r_k, lnx_g, lnx_b):
    bn, l, _ = cols.shape
    f32 = jnp.float32
    xp = jnp.pad(cols, ((0, 0), (1, 1), (0, 0)))
    cols = cols + mu * (0.5 * (xp[:, :-2] + xp[:, 2:]) - cols)
    r, k, v, wdn, adn, gdn = split_last(cols, (W_B, W_B, W_B, 2 * LORA_W, 2 * LORA_A, LORA_G))

    def hs(t):
        return t.reshape(bn, l, RWKV_HEADS, RWKV_HD).astype(f32)

    kk = hs(k * k_k)
    kk = kk / jnp.maximum(jnp.sqrt(jnp.sum(jnp.square(kk), -1, keepdims=True)), 1e-12)
    wdn = wdn.reshape(bn, l, 2, LORA_W)
    adn = adn.reshape(bn, l, 2, LORA_A)
    rh, vh = hs(r), hs(v)
    rk = r_k.reshape(RWKV_HEADS, RWKV_HD).astype(f32)
    y = jnp.zeros((bn, l, RWKV_HEADS, RWKV_HD), f32)
    bonus = jnp.zeros_like(y)
    for d in range(2):
        w_log = -jax.nn.softplus(-(w0[d] + jnp.tanh(wdn[:, :, d]) @ w2[d]).astype(f32)) - 0.5
        decay = hs(jnp.exp(-jnp.exp(w_log)))
        a = jax.nn.sigmoid(a0[d] + adn[:, :, d] @ a2[d])
        kd = k * (1.0 + (a - 1.0) * k_a)
        ah, kh = hs(a), hs(kd)
        if d == 0:
            y = y + rwkv7_scan(rh, decay, kh, vh, kk, ah)
        else:
            y = y + flip_t(rwkv7_scan(flip_t(rh), flip_t(decay), flip_t(kh), flip_t(vh),
                                      flip_t(kk), flip_t(ah)))
        bonus = bonus + jnp.sum(rh * kh * rk, -1, keepdims=True) * vh
    g = jnp.einsum('blr,rw->blw', jax.nn.sigmoid(gdn), g2).astype(f32)
    yn = head_group_norm(y, RWKV_GN_EPS).reshape(bn, l, W_B) * lnx_g + lnx_b
    return ((yn + bonus.reshape(bn, l, W_B)) * g).astype(cols.dtype)


def gla_chunk_scan(q, k, v, logf):
    bn, l, h, dk = q.shape
    dv = v.shape[-1]
    c = HGRN_CHUNK
    mask = jnp.tril(jnp.ones((c, c), bool))[:, :, None]

    def step(s, inp):
        q_c, k_c, v_c, lf_c = inp
        bcum = jnp.cumsum(lf_c, axis=-2)
        diff = bcum[:, :, :, None, :] - bcum[:, :, None, :, :]
        dec = jnp.exp(jnp.where(mask, diff, -jnp.inf))
        att = jnp.einsum('bhid,bhijd,bhjd->bhij', q_c, dec, k_c)
        o = (jnp.einsum('bhij,bhje->bhie', att, v_c)
             + jnp.einsum('bhid,bhde->bhie', q_c * jnp.exp(bcum), s))
        b_last = bcum[:, :, -1:, :]
        s = (jnp.exp(b_last[:, :, 0, :])[..., None] * s
             + jnp.einsum('bhjd,bhje->bhde', k_c * jnp.exp(b_last - bcum), v_c))
        return s, o

    s0 = jnp.zeros((bn, h, dk, dv), jnp.float32)
    _, o = lax.scan(step, s0, (to_chunks(q, c), to_chunks(k, c), to_chunks(v, c), to_chunks(logf, c)))
    return from_chunks(o)


def hgrn2_branch(q, f2, i, g, lb, norm_g):
    bn, l, _ = q.shape
    f32 = jnp.float32

    def hs(t):
        return t.reshape(bn, l, HGRN_HEADS, HGRN_HD)

    qh = hs(jax.nn.silu(q.astype(f32)) * HGRN_HD ** -0.5)
    ih = hs(i.astype(f32))
    f2 = f2.astype(f32).reshape(bn, l, 2, W_C)
    log_lb, log_1m_lb = jnp.log(lb), jnp.log1p(-lb)
    o = jnp.zeros((bn, l, HGRN_HEADS, HGRN_HD), f32)
    for d in range(2):
        fr = f2[:, :, d]
        logf = hs(jnp.logaddexp(log_lb, log_1m_lb + jax.nn.log_sigmoid(fr)))
        kh = hs((1.0 - lb) * jax.nn.sigmoid(-fr))
        if d == 0:
            o = o + gla_chunk_scan(qh, kh, ih, logf)
        else:
            o = o + flip_t(gla_chunk_scan(flip_t(qh), flip_t(kh), flip_t(ih), flip_t(logf)))
    on = head_rms_norm(o, NORM_EPS).reshape(bn, l, W_C) * norm_g
    return (on * jax.nn.silu(g.astype(f32))).astype(q.dtype)


def rotary(x, pos):
    half = x.shape[-1] // 2
    inv = ROPE_BASE ** (-jnp.arange(half, dtype=jnp.float32) / half)
    ang = pos.astype(jnp.float32)[:, None] * inv
    cos, sin = jnp.cos(ang)[:, None, :], jnp.sin(ang)[:, None, :]
    xf = x.astype(jnp.float32)
    x1, x2 = xf[..., :half], xf[..., half:]
    return jnp.concatenate([x1 * cos - x2 * sin, x1 * sin + x2 * cos], -1).astype(x.dtype)


def retention_chunk_scan(q, k, v, log_gamma):
    c = RET_CHUNK
    bn, lp, h, dk = q.shape
    dv = v.shape[-1]
    idx = jnp.arange(c, dtype=jnp.float32)
    rel = idx[:, None] - idx[None, :]
    dmat = jnp.where(rel >= 0, jnp.exp(jnp.maximum(rel, 0.0) * log_gamma[:, None, None]), 0.0)
    xi = jnp.exp((idx + 1.0) * log_gamma[:, None])[..., None]
    zeta = jnp.exp((c - 1.0 - idx) * log_gamma[:, None])[..., None]
    g_c = jnp.exp(c * log_gamma)[:, None, None]

    def step(state, inp):
        q_c, k_c, v_c = inp
        att = jnp.einsum('bhid,bhjd->bhij', q_c, k_c) * dmat
        o = (jnp.einsum('bhij,bhje->bhie', att, v_c)
             + jnp.einsum('bhid,bhde->bhie', q_c, state) * xi)
        state = g_c * state + jnp.einsum('bhjd,bhje->bhde', k_c * zeta, v_c)
        return state, o

    s0 = jnp.zeros((bn, h, dk, dv), jnp.float32)
    _, o = lax.scan(step, s0, (to_chunks(q, c), to_chunks(k, c), to_chunks(v, c)))
    return from_chunks(o)


def retention_branch(q, k, v, g, decay_logit):
    bn, l, _ = q.shape
    pos = jnp.arange(l)
    qh = rotary(q.reshape(bn, l, RET_HEADS, RET_DK), pos)
    kh = rotary(k.reshape(bn, l, RET_HEADS, RET_DK), pos) * RET_DK ** -0.5
    vh = v.reshape(bn, l, RET_HEADS, RET_DV)
    n_pad = RET_CHUNK - N_META
    pad = ((0, 0), (n_pad, 0), (0, 0), (0, 0))
    qh, kh, vh = jnp.pad(qh, pad), jnp.pad(kh, pad), jnp.pad(vh, pad)
    log_gamma = jax.nn.log_sigmoid(decay_logit.astype(jnp.float32))
    o = (retention_chunk_scan(qh, kh, vh, log_gamma[0])
         + flip_t(retention_chunk_scan(flip_t(qh), flip_t(kh), flip_t(vh), log_gamma[1])))[:, n_pad:]
    on = head_group_norm(o, NORM_EPS).reshape(bn, l, W_D)
    return (on * jax.nn.silu(g.astype(jnp.float32))).astype(q.dtype)


def token_mixer(h, p, li, lb):
    bn, l, _ = h.shape
    u = jnp.einsum('bld,dn->bln', h, p['w_in'][li])
    a_x, a_g, b_cols, c_q, c_f, c_i, c_g, d_q, d_k, d_v, d_g, m = split_last(u, IN_SIZES)
    o_a = rglru_branch(a_x, a_g, p['conv_w'][li], p['conv_b'][li], p['lru_wr'][li], p['lru_br'][li],
                       p['lru_wi'][li], p['lru_bi'][li], p['lru_lambda'][li])
    o_b = rwkv7_branch(b_cols, p['rwkv_mu'][li], p['rwkv_w0'][li], p['rwkv_w2'][li], p['rwkv_a0'][li],
                       p['rwkv_a2'][li], p['rwkv_g2'][li], p['rwkv_kk'][li], p['rwkv_ka'][li],
                       p['rwkv_rk'][li], p['rwkv_lnx_g'][li], p['rwkv_lnx_b'][li])
    o_c = hgrn2_branch(c_q, c_f, c_i, c_g, lb, p['hgrn_norm_g'][li])
    o_d = retention_branch(d_q, d_k, d_v, d_g, p['ret_decay'][li])
    branches = jnp.stack([o_a, o_b, o_c, o_d], axis=2)
    proj = jnp.einsum('blnw,nwd->blnd', branches, p['w_branch'][li])
    gates = jax.nn.sigmoid(m.reshape(bn, l, N_BRANCH, D_MODEL))
    merged = jnp.sum(gates * proj, axis=2)
    return jnp.einsum('bld,de->ble', merged, p['w_out'][li])


def expert_choice_ffn(x, router, w1, w3, w2):
    n = x.shape[0]
    cap = EC_CAPACITY * n // N_EXPERTS
    aff = jax.nn.softmax(jnp.einsum('nd,de->ne', x, router).astype(jnp.float32), axis=-1)
    gate, idx = lax.top_k(aff.T, cap)

    def one_expert(args):
        w1e, w3e, w2e, ie, ge = args
        xe = x[ie]
        he = jax.nn.silu(xe @ w1e) * (xe @ w3e)
        return (he @ w2e) * ge[:, None].astype(x.dtype)

    ye = lax.map(one_expert, (w1, w3, w2, idx, gate))
    return jnp.zeros_like(x).at[idx.reshape(-1)].add(ye.reshape(-1, x.shape[-1]))


def encode(x, p, lb_all):
    bn = x.shape[0]
    meta = jnp.broadcast_to(p['meta'][None].astype(x.dtype), (bn, N_META, D_MODEL))
    h = layer_norm(jnp.concatenate([meta, x], axis=1), p['ln_emb_g'], p['ln_emb_b'])
    for li in range(DEPTH):
        h = layer_norm(ALPHA * h + token_mixer(h, p, li, lb_all[li]), p['ln1_g'][li], p['ln1_b'][li])
        bn, l, _ = h.shape
        moe = expert_choice_ffn(h.reshape(bn * l, D_MODEL), p['router'][li], p['exp_w1'][li],
                                p['exp_w3'][li], p['exp_w2'][li]).reshape(bn, l, D_MODEL)
        h = layer_norm(ALPHA * h + moe, p['ln2_g'][li], p['ln2_b'][li])
    return h[:, N_META:]


def setup_inputs(seed: int = 0) -> dict:
    key = jax.random.key(seed)
    ks = iter(jax.random.split(key, 48))
    f32 = jnp.float32

    def nrm(shape, scale):
        return jax.random.normal(next(ks), shape, f32) * scale

    def unif(shape, lo, hi):
        return jax.random.uniform(next(ks), shape, f32, lo, hi)

    x_prompt = nrm((BATCH, SEQ, D_MODEL), 1.0)
    x_sample = nrm((DEC_BATCH, DEC_SEQ, D_MODEL), 1.0)
    meta = nrm((N_META, D_MODEL), 1.0)
    ln_emb_g = 1.0 + nrm((D_MODEL,), 0.02)
    ln_emb_b = nrm((D_MODEL,), 0.02)
    hgrn_lb = nrm((DEPTH, W_C), 0.5)
    w_in = nrm((DEPTH, D_MODEL, N_IN), D_MODEL ** -0.5)
    conv_w = nrm((DEPTH, CONV_W, W_A), CONV_W ** -0.5)
    conv_b = nrm((DEPTH, W_A), 0.02)
    lru_wr = nrm((DEPTH, 2, A_BLOCKS, A_BLOCK, A_BLOCK), A_BLOCK ** -0.5)
    lru_br = nrm((DEPTH, 2, W_A), 0.02)
    lru_wi = nrm((DEPTH, 2, A_BLOCKS, A_BLOCK, A_BLOCK), A_BLOCK ** -0.5)
    lru_bi = nrm((DEPTH, 2, W_A), 0.02)
    u = unif((DEPTH, 2, W_A), 0.9, 0.999)
    a_base = u ** (1.0 / LRU_C)
    lru_lambda = jnp.log(a_base) - jnp.log1p(-a_base)
    rwkv_mu = unif((DEPTH, B_COLS), 0.0, 1.0)
    rwkv_w0 = unif((DEPTH, 2, W_B), -6.0, 1.0)
    rwkv_w2 = nrm((DEPTH, 2, LORA_W, W_B), 0.5 * LORA_W ** -0.5)
    rwkv_a0 = nrm((DEPTH, 2, W_B), 0.1)
    rwkv_a2 = nrm((DEPTH, 2, LORA_A, W_B), 0.5 * LORA_A ** -0.5)
    rwkv_g2 = nrm((DEPTH, LORA_G, W_B), LORA_G ** -0.5)
    rwkv_kk = 0.85 + nrm((DEPTH, W_B), 0.02)
    rwkv_ka = 1.0 + nrm((DEPTH, W_B), 0.02)
    rwkv_rk = nrm((DEPTH, W_B), 0.1)
    rwkv_lnx_g = 1.0 + nrm((DEPTH, W_B), 0.02)
    rwkv_lnx_b = nrm((DEPTH, W_B), 0.02)
    hgrn_norm_g = 1.0 + nrm((DEPTH, W_C), 0.02)
    gamma0 = 1.0 - jnp.exp2(-5.0 - jnp.arange(RET_HEADS, dtype=f32))
    ret_decay = (jnp.log(gamma0) - jnp.log1p(-gamma0)) + nrm((DEPTH, 2, RET_HEADS), 0.01)
    w_branch = nrm((DEPTH, N_BRANCH, W_BRANCH, D_MODEL), W_BRANCH ** -0.5)
    w_out = nrm((DEPTH, D_MODEL, D_MODEL), BETA * D_MODEL ** -0.5)
    ln1_g = 1.0 + nrm((DEPTH, D_MODEL), 0.02)
    ln1_b = nrm((DEPTH, D_MODEL), 0.02)
    router = nrm((DEPTH, D_MODEL, N_EXPERTS), D_MODEL ** -0.5)
    exp_w1 = nrm((DEPTH, N_EXPERTS, D_MODEL, D_FF_EXPERT), D_MODEL ** -0.5)
    exp_w3 = nrm((DEPTH, N_EXPERTS, D_MODEL, D_FF_EXPERT), D_MODEL ** -0.5)
    exp_w2 = nrm((DEPTH, N_EXPERTS, D_FF_EXPERT, D_MODEL), BETA * D_FF_EXPERT ** -0.5)
    ln2_g = 1.0 + nrm((DEPTH, D_MODEL), 0.02)
    ln2_b = nrm((DEPTH, D_MODEL), 0.02)
    return {'x_prompt': x_prompt, 'x_sample': x_sample, 'meta': meta, 'ln_emb_g': ln_emb_g,
            'ln_emb_b': ln_emb_b, 'hgrn_lb': hgrn_lb, 'w_in': w_in, 'conv_w': conv_w, 'conv_b': conv_b,
            'lru_wr': lru_wr, 'lru_br': lru_br, 'lru_wi': lru_wi, 'lru_bi': lru_bi,
            'lru_lambda': lru_lambda, 'rwkv_mu': rwkv_mu, 'rwkv_w0': rwkv_w0, 'rwkv_w2': rwkv_w2,
            'rwkv_a0': rwkv_a0, 'rwkv_a2': rwkv_a2, 'rwkv_g2': rwkv_g2, 'rwkv_kk': rwkv_kk,
            'rwkv_ka': rwkv_ka, 'rwkv_rk': rwkv_rk, 'rwkv_lnx_g': rwkv_lnx_g, 'rwkv_lnx_b': rwkv_lnx_b,
            'hgrn_norm_g': hgrn_norm_g, 'ret_decay': ret_decay, 'w_branch': w_branch, 'w_out': w_out,
            'ln1_g': ln1_g, 'ln1_b': ln1_b, 'router': router, 'exp_w1': exp_w1, 'exp_w3': exp_w3,
            'exp_w2': exp_w2, 'ln2_g': ln2_g, 'ln2_b': ln2_b}


def reference(x_prompt, x_sample, meta, ln_emb_g, ln_emb_b, hgrn_lb, w_in, conv_w, conv_b,
              lru_wr, lru_br, lru_wi, lru_bi, lru_lambda, rwkv_mu, rwkv_w0, rwkv_w2, rwkv_a0,
              rwkv_a2, rwkv_g2, rwkv_kk, rwkv_ka, rwkv_rk, rwkv_lnx_g, rwkv_lnx_b, hgrn_norm_g,
              ret_decay, w_branch, w_out, ln1_g, ln1_b, router, exp_w1, exp_w3, exp_w2, ln2_g, ln2_b):
    p = dict(meta=meta, ln_emb_g=ln_emb_g, ln_emb_b=ln_emb_b, w_in=w_in, conv_w=conv_w,
             conv_b=conv_b, lru_wr=lru_wr, lru_br=lru_br, lru_wi=lru_wi, lru_bi=lru_bi,
             lru_lambda=lru_lambda, rwkv_mu=rwkv_mu, rwkv_w0=rwkv_w0, rwkv_w2=rwkv_w2,
             rwkv_a0=rwkv_a0, rwkv_a2=rwkv_a2, rwkv_g2=rwkv_g2, rwkv_kk=rwkv_kk, rwkv_ka=rwkv_ka,
             rwkv_rk=rwkv_rk, rwkv_lnx_g=rwkv_lnx_g, rwkv_lnx_b=rwkv_lnx_b, hgrn_norm_g=hgrn_norm_g,
             ret_decay=ret_decay, w_branch=w_branch, w_out=w_out, ln1_g=ln1_g, ln1_b=ln1_b,
             router=router, exp_w1=exp_w1, exp_w3=exp_w3, exp_w2=exp_w2, ln2_g=ln2_g, ln2_b=ln2_b)
    cum = jnp.cumsum(jax.nn.softmax(hgrn_lb.astype(jnp.float32), axis=0), axis=0)
    lb_all = cum - cum[:1]
    y_prompt = encode(x_prompt, p, lb_all)
    y_sample = encode(x_sample, p, lb_all)
    return (y_prompt, y_sample)
```

```cpp
#include <hip/hip_runtime.h>
#include <cstdio>
#include <cstdint>
#include <cstddef>

#define LAS __attribute__((address_space(3)))
typedef unsigned short bf16_t;
typedef short bf16x8 __attribute__((ext_vector_type(8)));
typedef float f32x4 __attribute__((ext_vector_type(4)));
typedef float f32x2 __attribute__((ext_vector_type(2)));
typedef unsigned u32x4 __attribute__((ext_vector_type(4)));
typedef unsigned u32x2 __attribute__((ext_vector_type(2)));

constexpr int D = 1024, LSEQ = 2064, NSEQ = 48, NTOK = NSEQ * LSEQ, NMETA = 16, SEQ = 2048, NSEQ0 = 32, TOK0 = NSEQ0 * LSEQ;
constexpr int N_IN = 11136, NLAYER = 2;
constexpr int N1 = 2560, N2 = 3072, NG = 1536, NM = 4096;
constexpr int NE = 16, DFF = 2048, CAP0 = 8256, CAP1 = 4128, EVALID = CAP0 + CAP1, EROWS = 12544, ETILES = EROWS / 256;
constexpr int NTILE_M = NTOK / 256;
static_assert(NTOK % 256 == 0, "token tiling");
constexpr float ALPHA = 1.41421356237f;
constexpr int NTHREADS = 512, NWAVES = 8;
constexpr int LDS_BYTES = 147456;
constexpr int LDS_MISC = LDS_BYTES - 64;

constexpr int U1_AX = 0, U1_R = 512, U1_K = 1024, U1_V = 1536, U1_WDN = 2048, U1_ADN = 2176, U1_GDN = 2304;
constexpr int U2_CQ = 0, U2_CF = 512, U2_CI = 1536, U2_DQ = 2048, U2_DK = 2304, U2_DV = 2560;

constexpr size_t al256(size_t x) { return (x + 255) & ~(size_t)255; }
constexpr size_t WS_CTL = 0, CTL_BYTES = 65536;
constexpr size_t WS_AFF = WS_CTL + CTL_BYTES;
constexpr size_t WS_INV = WS_AFF + al256((size_t)NTOK * 16 * 4);
constexpr size_t WS_STOK = WS_INV + al256((size_t)NTOK * 16 * 4);
constexpr size_t WS_SGATE = WS_STOK + al256((size_t)NE * EROWS * 4);
constexpr size_t WS_HIST = WS_SGATE + al256((size_t)NE * EROWS * 4);
constexpr size_t WS_BON = WS_HIST + al256((size_t)3 * 32 * 1024 * 4);
constexpr size_t WS_G2T = WS_BON + al256((size_t)NTOK * 16 * 4);
constexpr size_t WS_LB = WS_G2T + al256((size_t)2 * 512 * 128 * 2);
constexpr size_t WS_RW2T = WS_LB + al256((size_t)2 * 512 * 4);
constexpr size_t WS_LRUT = WS_RW2T + al256((size_t)2 * 2 * 2 * 512 * 64 * 2);
constexpr size_t WS_HBUF = WS_LRUT + al256((size_t)2 * 2 * 2 * 8 * 64 * 64 * 2);
constexpr size_t WS_W1T = WS_HBUF + al256((size_t)NTOK * D * 2);
constexpr size_t WS_W2T = WS_W1T + al256((size_t)2 * N1 * D * 2);
constexpr size_t WS_WGT = WS_W2T + al256((size_t)2 * N2 * D * 2);
constexpr size_t WS_WMT = WS_WGT + al256((size_t)2 * NG * D * 2);
constexpr size_t WS_WBT = WS_WMT + al256((size_t)2 * NM * D * 2);
constexpr size_t WS_WOT = WS_WBT + al256((size_t)2 * 4 * D * 512 * 2);
constexpr size_t WS_R = WS_WOT + al256((size_t)2 * D * D * 2);
constexpr size_t SZ_TD2 = (size_t)NTOK * D * 2;
constexpr size_t R_BR = WS_R;
constexpr size_t R_U = WS_R + 2 * SZ_TD2;
constexpr size_t R_PB = R_U;
constexpr size_t R_MERGED = WS_R;
constexpr size_t R_H8 = WS_R;
constexpr size_t OUT_HIN8 = SZ_TD2;
constexpr float WM_SCALE = 32.0f;
constexpr float W13_SCALE = 32.0f, W2_SCALE = 64.0f;
constexpr size_t R_X1 = R_U;
constexpr size_t R_WEXP = WS_R;
constexpr size_t SZ_W13 = (size_t)NE * 4096 * D * 2, SZ_W2E = (size_t)NE * D * DFF * 2;
constexpr size_t R_YE = R_WEXP + SZ_W13 + SZ_W2E;
constexpr size_t SZ_YE = (size_t)NE * EROWS * D * 2;
constexpr size_t R_HE = R_YE + SZ_YE;
constexpr size_t SZ_HE = (size_t)8 * EROWS * DFF * 2;
constexpr size_t WS_END_A = R_U + (size_t)NTOK * N2 * 2;
constexpr size_t WS_END_B = R_HE + SZ_HE;
constexpr size_t WS_END = WS_END_A > WS_END_B ? WS_END_A : WS_END_B;

constexpr int CW_BAR = 0;
constexpr int CW_CNT = 4096;
constexpr int CW_TIE = 4160;

__device__ __forceinline__ float bf2f(bf16_t v) { return __uint_as_float(((unsigned)v) << 16); }
typedef __bf16 bf16n2 __attribute__((ext_vector_type(2)));
__device__ __forceinline__ unsigned pk2(float lo, float hi) { const f32x2 v = {lo, hi}; return __builtin_bit_cast(unsigned, __builtin_convertvector(v, bf16n2)); }
__device__ __forceinline__ bf16_t f2bf(float f) { return (bf16_t)(pk2(f, 0.f) & 0xffffu); }
__device__ __forceinline__ unsigned pk4_fp8(float a, float b, float c, float d) { int p = __builtin_amdgcn_cvt_pk_fp8_f32(a, b, 0, false); p = __builtin_amdgcn_cvt_pk_fp8_f32(c, d, p, true); return (unsigned)p; }
__device__ __forceinline__ float sigmoidf_(float x) { return __builtin_amdgcn_rcpf(1.0f + __expf(-x)); }
__device__ __forceinline__ float siluf_(float x) { return x * __builtin_amdgcn_rcpf(1.0f + __expf(-x)); }
__device__ __forceinline__ float gelu_tanh_(float x) { const float u = 1.5957691216f * (x + 0.044715f * x * x * x); return x * __builtin_amdgcn_rcpf(1.0f + __expf(-u)); }
__device__ __forceinline__ float softplusf_(float x) { return fmaxf(x, 0.f) + log1pf(__expf(-fabsf(x))); }
__device__ __forceinline__ float dppx(float v, int sel) {
    const int x = __float_as_int(v); int r;
    if (sel == 0) r = __builtin_amdgcn_update_dpp(0, x, 0xB1, 0xF, 0xF, true);
    else if (sel == 1) r = __builtin_amdgcn_update_dpp(0, x, 0x4E, 0xF, 0xF, true);
    else if (sel == 2) r = __builtin_amdgcn_update_dpp(0, x, 0x141, 0xF, 0xF, true);
    else r = __builtin_amdgcn_update_dpp(0, x, 0x140, 0xF, 0xF, true);
    return __int_as_float(r);
}
typedef unsigned u32x2_pl __attribute__((ext_vector_type(2)));
__device__ __forceinline__ float rows_sum(float v) {
    const unsigned x = __float_as_uint(v);
    const u32x2_pl a = __builtin_amdgcn_permlane16_swap(x, x, false, false);
    const float s = __uint_as_float(a[0]) + __uint_as_float(a[1]);
    const unsigned y = __float_as_uint(s);
    const u32x2_pl b = __builtin_amdgcn_permlane32_swap(y, y, false, false);
    return __uint_as_float(b[0]) + __uint_as_float(b[1]);
}
__device__ __forceinline__ float wave_sum(float v) {
    v += dppx(v, 0); v += dppx(v, 1); v += dppx(v, 2); v += dppx(v, 3);
    return rows_sum(v);
}

#define XB_TMO      128
#define XB_XCNT(j)  (256  + 64 * (j))
#define XB_XSUB(j)  (1280 + 64 * (j))
#define XB_XGEN(j)  (2304 + 64 * (j))
#define XB_TOP      3328
#define XB_TOPGEN   3392
#define XCD_BAR_WORDS 3456
#define XB_SPIN_CAP (1u << 23)
__device__ __forceinline__ unsigned xb_ld(unsigned* p)              { return __hip_atomic_load(p, __ATOMIC_RELAXED, __HIP_MEMORY_SCOPE_AGENT); }
__device__ __forceinline__ unsigned xb_add(unsigned* p, unsigned v) { return __hip_atomic_fetch_add(p, v, __ATOMIC_RELAXED, __HIP_MEMORY_SCOPE_AGENT); }
__device__ __forceinline__ unsigned xb_xcc_id() { return (unsigned)__builtin_amdgcn_s_getreg((3 << 11) | 20) & 0xFu; }
#define XB_SPIN(cond, bar) do { unsigned _sp = 0; while (cond) { __builtin_amdgcn_s_sleep(1); \
    if ((++_sp & 255u) == 0u) { if (xb_ld(&(bar)[XB_TMO])) break; if (_sp > XB_SPIN_CAP) { atomicAdd(&(bar)[XB_TMO], 1u); break; } } } } while (0)
struct XcdBarrier { unsigned* bar; unsigned x; volatile LAS unsigned* st; };
__device__ __forceinline__ XcdBarrier xcd_barrier_post(unsigned* bar, volatile LAS unsigned* st) {
    XcdBarrier b; b.bar = bar; b.x = xb_xcc_id(); b.st = st;
    if (threadIdx.x == 0) st[2] = xb_add(&bar[XB_XCNT(b.x)], 1u);
    return b;
}
__device__ __forceinline__ void xcd_barrier_complete(unsigned* bar, unsigned x, unsigned& nloc, unsigned& nx) {
    const unsigned G = gridDim.x * gridDim.y * gridDim.z;
    unsigned sum, cnt, mine, sp = 0u;
    for (;;) {
        sum = 0u; cnt = 0u; mine = 0u;
#pragma unroll
        for (unsigned j = 0; j < 16; ++j) { const unsigned c = xb_ld(&bar[XB_XCNT(j)]); sum += c; cnt += (c > 0u) ? 1u : 0u; mine = (j == x) ? c : mine; }
        if (sum == G) break;
        __builtin_amdgcn_s_sleep(1);
        if ((++sp & 255u) == 0u) { if (xb_ld(&bar[XB_TMO])) break; if (sp > XB_SPIN_CAP) { atomicAdd(&bar[XB_TMO], 1u); break; } }
    }
    nloc = mine > 0u ? mine : 1u; nx = cnt > 0u ? cnt : 1u;
}
__device__ __forceinline__ void xcd_barrier(const XcdBarrier& b) {
    asm volatile("s_waitcnt vmcnt(0)" ::: "memory");
    __syncthreads();
    if (threadIdx.x == 0) {
        unsigned* bar = b.bar;
        __builtin_amdgcn_s_waitcnt(0);
        unsigned nloc = b.st[0], nx = b.st[1];
        if (nloc == 0u) { xcd_barrier_complete(bar, b.x, nloc, nx); b.st[0] = nloc; b.st[1] = nx; }
        const unsigned old = xb_add(&bar[XB_XSUB(b.x)], 1u);
        const unsigned gen = old / nloc;
        if (old + 1u == (gen + 1u) * nloc) {
            __builtin_amdgcn_fence(__ATOMIC_RELEASE, "agent");
            asm volatile("s_waitcnt vmcnt(0)" ::: "memory");
            const unsigned og = xb_add(&bar[XB_TOP], 1u);
            const unsigned tg = og / nx;
            if (og + 1u == (tg + 1u) * nx) xb_add(&bar[XB_TOPGEN], 1u);
            else XB_SPIN(xb_ld(&bar[XB_TOPGEN]) == tg, bar);
            __builtin_amdgcn_fence(__ATOMIC_ACQUIRE, "agent");
            xb_add(&bar[XB_XGEN(b.x)], 1u);
            asm volatile("s_waitcnt vmcnt(0)" ::: "memory");
        } else {
            XB_SPIN(xb_ld(&bar[XB_XGEN(b.x)]) == gen, bar);
            __builtin_amdgcn_fence(__ATOMIC_ACQUIRE, "agent");
            asm volatile("s_waitcnt vmcnt(0)" ::: "memory");
        }
    }
    __syncthreads();
}

namespace pg8 {
constexpr int BM = 256, BK = 64, HALF = 128, HTB = HALF * BK * 2, STAGE_BYTES = 8 * HTB, NXCD = 8, WGM = 8;
__host__ __device__ __forceinline__ int lds_byte(int r, int c) { const int st = (r >> 4) * 2 + (c >> 5), rr = r & 15, cc = c & 31, ob = rr * 64 + cc * 2; return st * 1024 + (ob ^ (((ob >> 9) & 1) << 5)); }
__host__ __device__ __forceinline__ void stage_rc(int b, int& R, int& C) { const int st = b / 1024, sb = b % 1024, swz = sb ^ (((sb >> 9) & 1) << 5); R = (st >> 1) * 16 + swz / 64; C = (st & 1) * 32 + (swz % 64) / 2; }
__host__ __device__ __forceinline__ int perm32(int rho) { const int n = rho >> 4, i = rho & 15; return 8 * (i >> 2) + 4 * n + (i & 3); }

struct Unit { int pm, pn, aux; const char* A; const char* B; const int* rows; };

struct TileOrder {
    int nM, nN, nwg, G, c;
    __device__ __forceinline__ void init(int nM_, int nN_, int G_, int c_) { nM = nM_; nN = nN_; nwg = nM * nN; G = G_; c = c_; }
    __device__ __forceinline__ bool tile(int i, int& pm, int& pn) const {
        const long L = (long)i * G + c; if (L >= nwg) return false;
        int wgid = (int)L; { const int q = nwg / NXCD, r = nwg % NXCD, xcd = wgid % NXCD, off = wgid / NXCD; wgid = (xcd < r ? xcd * (q + 1) : r * (q + 1) + (xcd - r) * q) + off; }
        const int nig = WGM * nN, gid = wgid / nig, fm = gid * WGM, gsz = (nM - fm) < WGM ? (nM - fm) : WGM;
        pm = fm + ((wgid % nig) % gsz); pn = (wgid % nig) / gsz; return true;
    }
};

typedef int i32x4_ __attribute__((ext_vector_type(4)));
typedef int i32x8_ __attribute__((ext_vector_type(8)));
__device__ __forceinline__ i32x8_ cat8(bf16x8 a, bf16x8 b) { const i32x4_ x = __builtin_bit_cast(i32x4_, a), y = __builtin_bit_cast(i32x4_, b); return __builtin_shufflevector(x, y, 0, 1, 2, 3, 4, 5, 6, 7); }
template <class Epi, class Sched, bool GATHER, bool F8 = false>
__device__ __forceinline__ void gemm_phase(LAS unsigned char* lds, const int K, const int lda, const int ldb, const Sched& S, const Epi& E) {
    int tid = threadIdx.x; asm volatile("" : "+v"(tid));
    const int wid = __builtin_amdgcn_readfirstlane(tid >> 6), lane = tid & 63, wr = wid >> 2, wc = wid & 3, fr = lane & 15, fq = lane >> 4;
    const int nt = K / BK;
    unsigned voffA[2][2], nvA[2][2], voffB[2];
#pragma unroll
    for (int i = 0; i < 2; ++i) { int R, C; stage_rc(tid * 16 + i * 8192, R, C); const int Rb = Epi::PERM ? ((R & ~31) + perm32(R & 31)) : R;
        voffB[i] = (unsigned)(Rb * ldb + C) * 2u;
#pragma unroll
        for (int h = 0; h < 2; ++h) { voffA[h][i] = (unsigned)((R + h * HALF) * lda + C) * 2u; nvA[h][i] = voffA[h][i]; } }
    const size_t kstep = (size_t)(BK * 2);
    const size_t hstepB = (size_t)HALF * ldb * 2;
    const unsigned ldsw = (unsigned)wid * 1024u;
    const int aoff = lds_byte(wr * 64 + fr, fq * 8), boff = lds_byte(wc * 32 + fr, fq * 8);
#define PG8_SA(b, h) (((b) * 2 + (h)) * HTB)
#define PG8_SB(b, h) ((4 + (b) * 2 + (h)) * HTB)
#define PG8_STAGE(bufoff, gbase, voff) do { _Pragma("unroll") for (int _i = 0; _i < 2; ++_i) \
        __builtin_amdgcn_global_load_lds((const unsigned*)((const char*)(gbase) + (voff)[_i]), (LAS unsigned*)(lds + (bufoff) + ldsw + _i * 8192), 16, 0, 0); } while (0)
#define PG8_LDA(dst, b, h) do { _Pragma("unroll") for (int m = 0; m < 4; ++m) { if constexpr (F8) { const i32x4_ lo_ = *(const LAS i32x4_*)(lds + PG8_SA(b, h) + aoff + m * 2048), hi_ = *(const LAS i32x4_*)(lds + PG8_SA(b, h) + aoff + m * 2048 + 1024); \
            dst##8[m] = __builtin_shufflevector(lo_, hi_, 0, 1, 2, 3, 4, 5, 6, 7); } else { _Pragma("unroll") for (int k = 0; k < 2; ++k) dst[m][k] = *(const LAS bf16x8*)(lds + PG8_SA(b, h) + aoff + m * 2048 + k * 1024); } } } while (0)
#define PG8_LDB(dst, b, h) do { _Pragma("unroll") for (int n = 0; n < 2; ++n) { if constexpr (F8) { const i32x4_ lo_ = *(const LAS i32x4_*)(lds + PG8_SB(b, h) + boff + n * 2048), hi_ = *(const LAS i32x4_*)(lds + PG8_SB(b, h) + boff + n * 2048 + 1024); \
            dst##8[n] = __builtin_shufflevector(lo_, hi_, 0, 1, 2, 3, 4, 5, 6, 7); } else { _Pragma("unroll") for (int k = 0; k < 2; ++k) dst[n][k] = *(const LAS bf16x8*)(lds + PG8_SB(b, h) + boff + n * 2048 + k * 1024); } } } while (0)
#define PG8_MMA(ai, bj, At, Bt) do { __builtin_amdgcn_s_setprio(1); _Pragma("unroll") for (int m = 0; m < 4; ++m) _Pragma("unroll") for (int n = 0; n < 2; ++n) { \
        if constexpr (F8) asm volatile("v_mfma_scale_f32_16x16x128_f8f6f4 %0, %1, %2, %0, %3, %3 op_sel_hi:[0,0,0]" : "+v"(acc[ai][bj][m][n]) : "v"(Bt##8[n]), "v"(At##8[m]), "v"(f8scale));   \
        else { _Pragma("unroll") for (int k = 0; k < 2; ++k) acc[ai][bj][m][n] = __builtin_amdgcn_mfma_f32_16x16x32_bf16(Bt[n][k], At[m][k], acc[ai][bj][m][n], 0, 0, 0); } } \
        __builtin_amdgcn_s_setprio(0); } while (0)
#define PG8_WAIT_V(n) asm volatile("s_waitcnt vmcnt(" #n ")" ::: "memory")
#define PG8_WAIT_L(n) asm volatile("s_waitcnt lgkmcnt(" #n ")" ::: "memory")
#define PG8_BAR __builtin_amdgcn_s_barrier()
#define PG8_SCHED __builtin_amdgcn_sched_barrier(0)
#define PG8_GATHER(dst, u) do { if constexpr (GATHER) { _Pragma("unroll") for (int _i = 0; _i < 2; ++_i) { int _R, _C; stage_rc(tid * 16 + _i * 8192, _R, _C); _Pragma("unroll") for (int _h = 0; _h < 2; ++_h) \
        dst[_h][_i] = ((unsigned)(u).rows[_R + _h * HALF] * (unsigned)lda + (unsigned)_C) * 2u; } } } while (0)
    Unit cur, nxt; int ui = 0;
    if (!S.next(0, cur)) return;
    f32x4 acc[2][2][4][2];
#pragma unroll
    for (int a = 0; a < 2; ++a)
#pragma unroll
        for (int b = 0; b < 2; ++b)
#pragma unroll
            for (int m = 0; m < 4; ++m)
#pragma unroll
                for (int n = 0; n < 2; ++n) acc[a][b][m][n] = (f32x4){0.f, 0.f, 0.f, 0.f};
    bf16x8 At[4][2], B0[2][2], B1[2][2];
    const int f8scale = 0x7f7f7f7f;
    i32x8_ At8[4], B08[2], B18[2];
    const char* cA = cur.A; const char* cB = cur.B;
    PG8_GATHER(voffA, cur);
    PG8_STAGE(PG8_SB(0, 0), cB, voffB); PG8_STAGE(PG8_SA(0, 0), cA, voffA[0]); PG8_STAGE(PG8_SB(0, 1), cB + hstepB, voffB); PG8_STAGE(PG8_SA(0, 1), cA, voffA[1]);
    if (wr == 1) PG8_BAR;
    PG8_WAIT_V(4); PG8_BAR;
    PG8_STAGE(PG8_SB(1, 0), cB + kstep, voffB); PG8_STAGE(PG8_SA(1, 0), cA + kstep, voffA[0]); PG8_STAGE(PG8_SB(1, 1), cB + hstepB + kstep, voffB);
    PG8_WAIT_V(6); PG8_BAR;
    for (;;) {
        const bool has_next = S.next(ui + 1, nxt);
        const char* nA = has_next ? nxt.A : cA; const char* nB = has_next ? nxt.B : cB;
        if constexpr (GATHER) { if (has_next) { PG8_GATHER(nvA, nxt); } else {
#pragma unroll
            for (int h = 0; h < 2; ++h)
#pragma unroll
                for (int i = 0; i < 2; ++i) nvA[h][i] = voffA[h][i]; } }
        for (int t = 0; t < nt; t += 2) {
            const bool last = (t == nt - 2);
            const char* a1 = cA + (size_t)(t + 1) * kstep;
            const char* a2 = last ? nA : cA + (size_t)(t + 2) * kstep; const char* b2 = last ? nB : cB + (size_t)(t + 2) * kstep;
            const char* a3 = a2 + kstep; const char* b3 = b2 + kstep;
            unsigned vA0[2], vA1[2];
            if constexpr (GATHER) { vA0[0] = last ? nvA[0][0] : voffA[0][0]; vA0[1] = last ? nvA[0][1] : voffA[0][1]; vA1[0] = last ? nvA[1][0] : voffA[1][0]; vA1[1] = last ? nvA[1][1] : voffA[1][1]; }
            else { vA0[0] = voffA[0][0]; vA0[1] = voffA[0][1]; vA1[0] = voffA[1][0]; vA1[1] = voffA[1][1]; }
            PG8_LDB(B0, 0, 0); PG8_SCHED; PG8_LDA(At, 0, 0); PG8_STAGE(PG8_SA(1, 1), a1, voffA[1]);
            PG8_WAIT_L(8); PG8_BAR; PG8_WAIT_L(0); PG8_MMA(0, 0, At, B0); PG8_BAR; PG8_SCHED;
            PG8_LDB(B1, 0, 1); PG8_STAGE(PG8_SB(0, 0), b2, voffB);
            PG8_BAR; PG8_WAIT_L(0); PG8_MMA(0, 1, At, B1); PG8_BAR;
            PG8_LDA(At, 0, 1); PG8_STAGE(PG8_SA(0, 0), a2, vA0);
            PG8_BAR; PG8_WAIT_L(0); PG8_MMA(1, 0, At, B0); PG8_BAR; PG8_SCHED;
            PG8_STAGE(PG8_SB(0, 1), b2 + hstepB, voffB);
            PG8_WAIT_V(6); PG8_BAR; PG8_MMA(1, 1, At, B1); PG8_BAR;
            PG8_LDB(B0, 1, 0); PG8_SCHED; PG8_LDA(At, 1, 0); PG8_STAGE(PG8_SA(0, 1), a2, vA1);
            PG8_WAIT_L(8); PG8_BAR; PG8_WAIT_L(0); PG8_MMA(0, 0, At, B0); PG8_BAR; PG8_SCHED;
            PG8_LDB(B1, 1, 1); PG8_STAGE(PG8_SB(1, 0), b3, voffB);
            PG8_BAR; PG8_WAIT_L(0); PG8_MMA(0, 1, At, B1); PG8_BAR;
            PG8_LDA(At, 1, 1); PG8_STAGE(PG8_SA(1, 0), a3, vA0);
            PG8_BAR; PG8_WAIT_L(0); PG8_MMA(1, 0, At, B0); PG8_BAR; PG8_SCHED;
            PG8_STAGE(PG8_SB(1, 1), b3 + hstepB, voffB);
            PG8_WAIT_V(6); PG8_BAR; PG8_MMA(1, 1, At, B1); PG8_BAR;
        }
        if constexpr (F8) asm volatile("s_nop 15\n\ts_nop 7" ::: "memory");
        { int fr_e = fr, fq_e = fq; asm volatile("" : "+v"(fr_e), "+v"(fq_e));
          E(acc, cur, wr, wc, fr_e, fq_e); }
        if (!has_next) break;
#pragma unroll
        for (int a = 0; a < 2; ++a)
#pragma unroll
            for (int b = 0; b < 2; ++b)
#pragma unroll
                for (int m = 0; m < 4; ++m)
#pragma unroll
                    for (int n = 0; n < 2; ++n) acc[a][b][m][n] = (f32x4){0.f, 0.f, 0.f, 0.f};
        cur = nxt; cA = nA; cB = nB; ++ui;
        if constexpr (GATHER) {
#pragma unroll
            for (int h = 0; h < 2; ++h)
#pragma unroll
                for (int i = 0; i < 2; ++i) voffA[h][i] = nvA[h][i]; }
    }
    PG8_WAIT_V(0);
    if (wr == 0) PG8_BAR;
    PG8_BAR;
#undef PG8_SA
#undef PG8_SB
#undef PG8_STAGE
#undef PG8_LDA
#undef PG8_LDB
#undef PG8_MMA
#undef PG8_WAIT_V
#undef PG8_WAIT_L
#undef PG8_BAR
#undef PG8_SCHED
#undef PG8_GATHER
}
}
using pg8::Unit;

struct Args { const float* in[37]; float* out; unsigned char* ws; int ph_lo, ph_hi; };
enum { I_XP = 0, I_XS, I_META, I_LNEG, I_LNEB, I_HLB, I_WIN, I_CONVW, I_CONVB, I_WR, I_BR, I_WI, I_BI, I_LAM, I_MU, I_W0, I_W2, I_A0, I_A2, I_G2, I_KK, I_KA, I_RK,
       I_LNXG, I_LNXB, I_HNG, I_RDEC, I_WBR, I_WOUT, I_LN1G, I_LN1B, I_ROUTER, I_EW1, I_EW3, I_EW2, I_LN2G, I_LN2B };
struct Frame {
    const float* const* in; float* out; unsigned char* ws; LAS unsigned char* lds; unsigned char* ldsg;
    int tid, lane, wave, G, bid;
    __device__ __forceinline__ bf16_t* hbuf() const { return (bf16_t*)(ws + WS_HBUF); }
    __device__ __forceinline__ bf16_t* br() const { return (bf16_t*)(ws + R_BR); }
    __device__ __forceinline__ bf16_t* brx() const { return (bf16_t*)out; }
    __device__ __forceinline__ bf16_t* ubuf() const { return (bf16_t*)(ws + R_U); }
    __device__ __forceinline__ bf16_t* pb(int n) const { return n < 3 ? (bf16_t*)(ws + R_PB + (size_t)n * SZ_TD2) : (bf16_t*)out; }
};

struct SchedPlain {
    pg8::TileOrder T; const char* A; const char* B; size_t astep, bstep;
    __device__ __forceinline__ bool next(int i, Unit& u) const { int pm, pn; if (!T.tile(i, pm, pn)) return false; u.pm = pm; u.pn = pn; u.aux = 0; u.A = A + (size_t)pm * astep; u.B = B + (size_t)pn * bstep; u.rows = nullptr; return true; }
};
struct SchedP {
    pg8::TileOrder T; const char* A; const char* B;
    __device__ __forceinline__ bool next(int i, Unit& u) const { int pm, pn; if (!T.tile(i, pm, pn)) return false; const int nb = pn >> 2, pl = pn & 3; u.pm = pm; u.pn = pl; u.aux = nb;
        u.A = A + (size_t)pm * 256 * 2048 * 2 + (size_t)nb * 512 * 2; u.B = B + (size_t)nb * 1024 * 512 * 2 + (size_t)pl * 256 * 512 * 2; u.rows = nullptr; return true; }
};
struct SchedE1 {
    pg8::TileOrder T; const char* A; const char* B; const int* stok; int e0;
    __device__ __forceinline__ bool next(int i, Unit& u) const { int pm, pn; if (!T.tile(i, pm, pn)) return false; const int el = pm / ETILES, pl = pm - el * ETILES, e = e0 + el; u.pm = pl; u.pn = pn; u.aux = el;
        u.A = A; u.B = B + (size_t)e * 4096 * D + (size_t)pn * 256 * D; u.rows = stok + (size_t)e * EROWS + pl * 256; return true; }
};
struct SchedE2 {
    pg8::TileOrder T; const char* A; const char* B; int e0;
    __device__ __forceinline__ bool next(int i, Unit& u) const { int pm, pn; if (!T.tile(i, pm, pn)) return false; const int el = pm / ETILES, pl = pm - el * ETILES, e = e0 + el; u.pm = pl; u.pn = pn; u.aux = e;
        u.A = A + ((size_t)el * EROWS + (size_t)pl * 256) * DFF; u.B = B + (size_t)e * D * DFF + (size_t)pn * 256 * DFF; u.rows = nullptr; return true; }
};

#define EPI_LOOP_AM _Pragma("unroll") for (int ai = 0; ai < 2; ++ai) _Pragma("unroll") for (int m = 0; m < 4; ++m)
struct EpiStoreBf16 {
    static constexpr bool PERM = true;
    bf16_t* O0; bf16_t* O1; bf16_t* O2; bf16_t* O3; int ldo;
    __device__ __forceinline__ void operator()(const f32x4 (&acc)[2][2][4][2], const Unit& u, int wr, int wc, int fr, int fq) const {
        bf16_t* base = (u.aux == 0) ? O0 : ((u.aux == 1) ? O1 : ((u.aux == 2) ? O2 : O3));
        const int row0 = u.pm * 256 + wr * 64 + fr, col0 = u.pn * 256 + wc * 32 + 8 * fq;
        EPI_LOOP_AM { bf16_t* rowp = base + (size_t)(row0 + ai * 128 + m * 16) * ldo + col0;
#pragma unroll
            for (int bj = 0; bj < 2; ++bj) { const f32x4 v0 = acc[ai][bj][m][0], v1 = acc[ai][bj][m][1];
                u32x4 w; w.x = pk2(v0[0], v0[1]); w.y = pk2(v0[2], v0[3]); w.z = pk2(v1[0], v1[1]); w.w = pk2(v1[2], v1[3]);
                *(u32x4*)(rowp + bj * 128) = w; } }
    }
};
struct EpiGate {
    static constexpr bool PERM = true;
    bf16_t* BR;
    __device__ __forceinline__ void operator()(const f32x4 (&acc)[2][2][4][2], const Unit& u, int wr, int wc, int fr, int fq) const {
        const int sec = u.pn >> 1;
        const int cbase = (sec == 0 ? 0 : (sec == 1 ? 1024 : 1536)) + (u.pn & 1) * 256 + wc * 32 + 8 * fq;
        const int row0 = u.pm * 256 + wr * 64 + fr;
        u32x4 xv[2][4][2];
        EPI_LOOP_AM { const bf16_t* rowp = BR + (size_t)(row0 + ai * 128 + m * 16) * 2048 + cbase; xv[ai][m][0] = *(const u32x4*)rowp; xv[ai][m][1] = *(const u32x4*)(rowp + 128); }
        EPI_LOOP_AM { bf16_t* rowp = BR + (size_t)(row0 + ai * 128 + m * 16) * 2048 + cbase;
#pragma unroll
            for (int bj = 0; bj < 2; ++bj) {
                const u32x4 x = xv[ai][m][bj];
                float g[8];
#pragma unroll
                for (int j = 0; j < 4; ++j) { g[j] = acc[ai][bj][m][0][j]; g[4 + j] = acc[ai][bj][m][1][j]; }
#pragma unroll
                for (int j = 0; j < 8; ++j) g[j] = (sec == 0) ? gelu_tanh_(g[j]) : siluf_(g[j]);
                const unsigned xs[4] = {x.x, x.y, x.z, x.w}; unsigned ws_[4];
#pragma unroll
                for (int j = 0; j < 4; ++j) ws_[j] = pk2(bf2f((bf16_t)(xs[j] & 0xffffu)) * g[2 * j], bf2f((bf16_t)(xs[j] >> 16)) * g[2 * j + 1]);
                u32x4 w; w.x = ws_[0]; w.y = ws_[1]; w.z = ws_[2]; w.w = ws_[3];
                *(u32x4*)(rowp + bj * 128) = w; } }
    }
};
struct EpiMerge {
    static constexpr bool PERM = false;
    const bf16_t* PB0; const bf16_t* PB1; const bf16_t* PB2; const bf16_t* PB3; bf16_t* MG;
    __device__ __forceinline__ void operator()(const f32x4 (&acc)[2][2][4][2], const Unit& u, int wr, int wc, int fr, int fq) const {
        const int row0 = u.pm * 256 + wr * 64 + fr, d0 = u.pn * 64 + wc * 16 + 4 * fq;
        u32x2 pbv[2][4][4];
        EPI_LOOP_AM { const size_t off = (size_t)(row0 + ai * 128 + m * 16) * D + d0;
            pbv[ai][m][0] = *(const u32x2*)(PB0 + off); pbv[ai][m][1] = *(const u32x2*)(PB1 + off); pbv[ai][m][2] = *(const u32x2*)(PB2 + off); pbv[ai][m][3] = *(const u32x2*)(PB3 + off); }
        EPI_LOOP_AM { const size_t off = (size_t)(row0 + ai * 128 + m * 16) * D + d0;
            float s[4] = {0.f, 0.f, 0.f, 0.f};
#pragma unroll
            for (int bj = 0; bj < 2; ++bj)
#pragma unroll
                for (int n = 0; n < 2; ++n) { const u32x2 p = pbv[ai][m][2 * bj + n]; const f32x4 a = acc[ai][bj][m][n];
                    constexpr float IS = 1.0f / WM_SCALE;
                    s[0] += sigmoidf_(a[0] * IS) * bf2f((bf16_t)(p.x & 0xffffu)); s[1] += sigmoidf_(a[1] * IS) * bf2f((bf16_t)(p.x >> 16));
                    s[2] += sigmoidf_(a[2] * IS) * bf2f((bf16_t)(p.y & 0xffffu)); s[3] += sigmoidf_(a[3] * IS) * bf2f((bf16_t)(p.y >> 16)); }
            u32x2 w; w.x = pk2(s[0], s[1]); w.y = pk2(s[2], s[3]);
            *(u32x2*)(MG + off) = w; }
    }
};
struct EpiOut {
    static constexpr bool PERM = true;
    const bf16_t* H; bf16_t* X1;
    __device__ __forceinline__ void operator()(const f32x4 (&acc)[2][2][4][2], const Unit& u, int wr, int wc, int fr, int fq) const {
        const int row0 = u.pm * 256 + wr * 64 + fr, col0 = u.pn * 256 + wc * 32 + 8 * fq;
        u32x4 hv[2][4][2];
        EPI_LOOP_AM { const size_t off = (size_t)(row0 + ai * 128 + m * 16) * D + col0; hv[ai][m][0] = *(const u32x4*)(H + off); hv[ai][m][1] = *(const u32x4*)(H + off + 128); }
        EPI_LOOP_AM { const size_t off = (size_t)(row0 + ai * 128 + m * 16) * D + col0;
#pragma unroll
            for (int bj = 0; bj < 2; ++bj) { const u32x4 p = hv[ai][m][bj]; const f32x4 a0 = acc[ai][bj][m][0], a1 = acc[ai][bj][m][1];
                u32x4 w;
                w.x = pk2(ALPHA * bf2f((bf16_t)(p.x & 0xffffu)) + a0[0], ALPHA * bf2f((bf16_t)(p.x >> 16)) + a0[1]);
                w.y = pk2(ALPHA * bf2f((bf16_t)(p.y & 0xffffu)) + a0[2], ALPHA * bf2f((bf16_t)(p.y >> 16)) + a0[3]);
                w.z = pk2(ALPHA * bf2f((bf16_t)(p.z & 0xffffu)) + a1[0], ALPHA * bf2f((bf16_t)(p.z >> 16)) + a1[1]);
                w.w = pk2(ALPHA * bf2f((bf16_t)(p.w & 0xffffu)) + a1[2], ALPHA * bf2f((bf16_t)(p.w >> 16)) + a1[3]);
                *(u32x4*)(X1 + off + bj * 128) = w; } }
    }
};
struct EpiSwiglu {
    static constexpr bool PERM = true;
    unsigned char* HE;
    __device__ __forceinline__ void operator()(const f32x4 (&acc)[2][2][4][2], const Unit& u, int wr, int wc, int fr, int fq) const {
        const int row0 = u.pm * 256 + wr * 64 + fr, col0 = u.pn * 128 + wc * 32 + 8 * fq;
        unsigned char* base = HE + (size_t)u.aux * EROWS * DFF;
        constexpr float IS = 1.0f / W13_SCALE;
        EPI_LOOP_AM { unsigned char* rowp = base + (size_t)(row0 + ai * 128 + m * 16) * DFF + col0;
            float h[8];
#pragma unroll
            for (int n = 0; n < 2; ++n)
#pragma unroll
                for (int j = 0; j < 4; ++j) h[4 * n + j] = siluf_(acc[ai][0][m][n][j] * IS) * (acc[ai][1][m][n][j] * IS);
            u32x2 w; w.x = pk4_fp8(h[0], h[1], h[2], h[3]); w.y = pk4_fp8(h[4], h[5], h[6], h[7]);
            *(u32x2*)rowp = w; }
    }
};
struct EpiScale {
    static constexpr bool PERM = true;
    bf16_t* YE; const float* SG;
    __device__ __forceinline__ void operator()(const f32x4 (&acc)[2][2][4][2], const Unit& u, int wr, int wc, int fr, int fq) const {
        const int row0 = u.pm * 256 + wr * 64 + fr, col0 = u.pn * 256 + wc * 32 + 8 * fq;
        bf16_t* base = YE + (size_t)u.aux * EROWS * D; const float* sg = SG + (size_t)u.aux * EROWS;
        float gv[2][4];
        EPI_LOOP_AM { gv[ai][m] = sg[row0 + ai * 128 + m * 16]; }
        EPI_LOOP_AM { const int row = row0 + ai * 128 + m * 16; const float g = gv[ai][m] * (1.0f / W2_SCALE); bf16_t* rowp = base + (size_t)row * D + col0;
#pragma unroll
            for (int bj = 0; bj < 2; ++bj) { const f32x4 v0 = acc[ai][bj][m][0] * g, v1 = acc[ai][bj][m][1] * g;
                u32x4 w; w.x = pk2(v0[0], v0[1]); w.y = pk2(v0[2], v0[3]); w.z = pk2(v1[0], v1[1]); w.w = pk2(v1[2], v1[3]);
                *(u32x4*)(rowp + bj * 128) = w; } }
    }
};

template <class ColMap>
__device__ __forceinline__ void tr_tile(const Frame& F, const float* src, size_t ld_src, bf16_t* dst, size_t ldd, int n0, int k0, const ColMap& cm) {
    LAS float* tile = (LAS float*)F.lds;
    const int a = F.tid >> 6, b = F.tid & 63;
    const int col = cm(n0 + b);
#pragma unroll
    for (int j = 0; j < 8; ++j) { const int kk = a + 8 * j; tile[b * 65 + kk] = (col >= 0) ? src[(size_t)(k0 + kk) * ld_src + col] : 0.f; }
    __syncthreads();
#pragma unroll
    for (int j = 0; j < 8; ++j) { const int nn = a + 8 * j; dst[(size_t)(n0 + nn) * ldd + k0 + b] = f2bf(tile[nn * 65 + b]); }
    __syncthreads();
}
template <class ColMap>
__device__ __forceinline__ void tr_strip(const Frame& F, const float* src, size_t ld_src, bf16_t* dst, size_t ldd, int n0, int k0, const ColMap& cm) {
    LAS float* tile = (LAS float*)F.lds;
    const int a = F.tid >> 6, b = F.tid & 63;
    const int col = cm(n0 + b);
    float v[32];
#pragma unroll
    for (int j = 0; j < 32; ++j) v[j] = (col >= 0) ? src[(size_t)(k0 + a + 8 * j) * ld_src + col] : 0.f;
#pragma unroll
    for (int j = 0; j < 32; ++j) tile[b * 257 + a + 8 * j] = v[j];
    __syncthreads();
#pragma unroll
    for (int j = 0; j < 8; ++j) { const int nn = a + 8 * j;
#pragma unroll
        for (int m = 0; m < 2; ++m) { const int kk = 2 * b + 128 * m; *(unsigned*)(dst + (size_t)(n0 + nn) * ldd + k0 + kk) = pk2(tile[nn * 257 + kk], tile[nn * 257 + kk + 1]); } }
    __syncthreads();
}
template <class ColMap>
__device__ __forceinline__ void tr_strip8m(const Frame& F, const float* src, size_t ld_src, unsigned char* dst, size_t ldd, int n0, int k0, const ColMap& cm, float scale) {
    LAS float* tile = (LAS float*)F.lds;
    const int a = F.tid >> 6, b = F.tid & 63; const int col = cm(n0 + b);
    float v[32];
#pragma unroll
    for (int j = 0; j < 32; ++j) v[j] = src[(size_t)(k0 + a + 8 * j) * ld_src + col];
#pragma unroll
    for (int j = 0; j < 32; ++j) tile[b * 257 + a + 8 * j] = v[j] * scale;
    __syncthreads();
#pragma unroll
    for (int j = 0; j < 8; ++j) { const int nn = a + 8 * j; const LAS float* tp = tile + nn * 257 + 4 * b;
        *(unsigned*)(dst + (size_t)(n0 + nn) * ldd + k0 + 4 * b) = pk4_fp8(tp[0], tp[1], tp[2], tp[3]); }
    __syncthreads();
}
__device__ __forceinline__ void tr_strip8(const Frame& F, const float* src, size_t ld_src, unsigned char* dst, size_t ldd, int n0, int k0, int coff, float scale) {
    LAS float* tile = (LAS float*)F.lds;
    const int a = F.tid >> 6, b = F.tid & 63;
    float v[32];
#pragma unroll
    for (int j = 0; j < 32; ++j) v[j] = src[(size_t)(k0 + a + 8 * j) * ld_src + coff + n0 + b];
#pragma unroll
    for (int j = 0; j < 32; ++j) tile[b * 257 + a + 8 * j] = v[j] * scale;
    __syncthreads();
#pragma unroll
    for (int j = 0; j < 8; ++j) { const int nn = a + 8 * j; const LAS float* tp = tile + nn * 257 + 4 * b;
        *(unsigned*)(dst + (size_t)(n0 + nn) * ldd + k0 + 4 * b) = pk4_fp8(tp[0], tp[1], tp[2], tp[3]); }
    __syncthreads();
}
struct CmId { int off; __device__ __forceinline__ int operator()(int n) const { return off + n; } };
struct CmW1 { __device__ __forceinline__ int operator()(int n) const { return n < 512 ? n : (n < 2432 ? n + 512 : -1); } };
struct CmW2 { __device__ __forceinline__ int operator()(int n) const { return n < 2048 ? 2944 + n : 3456 + n; } };
struct CmWG { __device__ __forceinline__ int operator()(int n) const { return n < 512 ? 512 + n : (n < 1024 ? 4480 + n : 5504 + n); } };
struct CmWM { __device__ __forceinline__ int operator()(int n) const { const int pn = n >> 8, c = n & 255, bj = c >> 7, wc = (c >> 5) & 3, nn = (c >> 4) & 1, fq = (c >> 2) & 3, j = c & 3;
        return 7040 + (2 * bj + nn) * 1024 + 64 * pn + 16 * wc + 4 * fq + j; } };

__device__ __forceinline__ void phase_prep_weights(const Frame& F0) {
    Frame F = F0; { size_t z_ = 0; asm volatile("" : "+v"(F.tid), "+v"(F.lane), "+s"(z_), "+s"(F.bid), "+s"(F.G), "+s"(F.wave)); F.ws = F0.ws + z_; F.out = F0.out + z_; }
    for (int job = F.bid; job < 2 * 912; job += F.G) {
        const int li = job / 912; int j = job - li * 912;
        const float* win = F.in[I_WIN] + (size_t)li * D * N_IN;
        if (j < 160) { tr_strip(F, win, N_IN, (bf16_t*)(F.ws + WS_W1T) + (size_t)li * N1 * D, D, (j >> 2) * 64, (j & 3) * 256, CmW1()); continue; } j -= 160;
        if (j < 192) { tr_strip(F, win, N_IN, (bf16_t*)(F.ws + WS_W2T) + (size_t)li * N2 * D, D, (j >> 2) * 64, (j & 3) * 256, CmW2()); continue; } j -= 192;
        if (j < 96) { tr_strip(F, win, N_IN, (bf16_t*)(F.ws + WS_WGT) + (size_t)li * NG * D, D, (j >> 2) * 64, (j & 3) * 256, CmWG()); continue; } j -= 96;
        if (j < 256) { tr_strip8m(F, win, N_IN, (unsigned char*)(F.ws + WS_WMT) + (size_t)li * NM * D, D, (j >> 2) * 64, (j & 3) * 256, CmWM(), WM_SCALE); continue; } j -= 256;
        if (j < 128) { const int nb = j >> 5, r = j & 31;
            tr_strip(F, F.in[I_WBR] + ((size_t)li * 4 + nb) * 512 * D, D, (bf16_t*)(F.ws + WS_WBT) + ((size_t)li * 4 + nb) * D * 512, 512, (r >> 1) * 64, (r & 1) * 256, CmId{0}); continue; } j -= 128;
        if (j < 64) { tr_strip(F, F.in[I_WOUT] + (size_t)li * D * D, D, (bf16_t*)(F.ws + WS_WOT) + (size_t)li * D * D, D, (j >> 2) * 64, (j & 3) * 256, CmId{0}); continue; } j -= 64;
        tr_tile(F, F.in[I_G2] + (size_t)li * 128 * 512, 512, (bf16_t*)(F.ws + WS_G2T) + (size_t)li * 512 * 128, 128, (j >> 1) * 64, (j & 1) * 64, CmId{0});
    }
    for (int job = F.bid; job < 128; job += F.G) {
        if (job < 64) { const int li = job >> 5, d = (job >> 4) & 1, m = (job >> 3) & 1, nt = job & 7;
            tr_tile(F, F.in[m ? I_A2 : I_W2] + ((size_t)li * 2 + d) * 64 * 512, 512, (bf16_t*)(F.ws + WS_RW2T) + (((size_t)li * 2 + d) * 2 + m) * 512 * 64, 64, nt * 64, 0, CmId{0});
        } else { const int j = job - 64, li = j >> 5, d = (j >> 4) & 1, m = (j >> 3) & 1, g = j & 7;
            tr_tile(F, F.in[m ? I_WI : I_WR] + (((size_t)li * 2 + d) * 8 + g) * 64 * 64, 64, (bf16_t*)(F.ws + WS_LRUT) + ((((size_t)li * 2 + d) * 2 + m) * 8 + g) * 64 * 64, 64, 0, 0, CmId{0}); }
    }
    if (F.bid == 0) { float* lb = (float*)(F.ws + WS_LB); const float* h = F.in[I_HLB];
        for (int c = F.tid; c < 512; c += NTHREADS) { lb[c] = 0.f; lb[512 + c] = 1.0f / (1.0f + expf(h[c] - h[512 + c])); } }
}
__device__ __forceinline__ void phase_prep_experts(const Frame& F0, int li) {
    Frame F = F0; { size_t z_ = 0; asm volatile("" : "+v"(F.tid), "+v"(F.lane), "+s"(z_), "+s"(F.bid), "+s"(F.G), "+s"(F.wave)); F.ws = F0.ws + z_; F.out = F0.out + z_; }
    const int nskip = (4 * NTILE_M > F.G && F.G > 64) ? (4 * NTILE_M) % F.G : 0;
    if (F.bid < nskip) return;
    for (int job = F.bid - nskip; job < NE * 384; job += F.G - nskip) {
        const int e = job / 384; int j = job - e * 384;
        if (j < 256) { const int nt = j >> 2, ks = j & 3, p = nt >> 2, r = nt & 3, which = r >> 1, nsub = r & 1;
            const float* src = F.in[which ? I_EW3 : I_EW1] + ((size_t)li * NE + e) * D * DFF;
            const int n0 = 64 * nt;
            tr_strip8(F, src, DFF, (unsigned char*)F.out + (size_t)e * 4096 * D, D, n0, ks * 256, 128 * p + 64 * nsub - n0, W13_SCALE);
        } else { j -= 256;
            tr_strip8(F, F.in[I_EW2] + ((size_t)li * NE + e) * DFF * D, D, (unsigned char*)F.out + (size_t)NE * 4096 * D + (size_t)e * D * DFF, DFF, (j >> 3) * 64, (j & 7) * 256, 0, W2_SCALE); }
    }
}

__device__ __forceinline__ void ln_stats(const float (&x)[16], float& mu, float& rstd) {
    float s = 0.f;
#pragma unroll
    for (int i = 0; i < 16; ++i) s += x[i];
    mu = wave_sum(s) * (1.0f / 1024.0f);
    float q = 0.f;
#pragma unroll
    for (int i = 0; i < 16; ++i) { const float dlt = x[i] - mu; q += dlt * dlt; }
    rstd = rsqrtf(wave_sum(q) * (1.0f / 1024.0f) + 1e-5f);
}
__device__ __forceinline__ void ld16_f32(const float* p, int lane, float (&x)[16]) {
#pragma unroll
    for (int j = 0; j < 2; ++j) { const f32x4 a = *(const f32x4*)(p + 512 * j + 8 * lane), b = *(const f32x4*)(p + 512 * j + 8 * lane + 4);
#pragma unroll
        for (int i = 0; i < 4; ++i) { x[8 * j + i] = a[i]; x[8 * j + 4 + i] = b[i]; } }
}
__device__ __forceinline__ void ld16_bf16(const bf16_t* p, int lane, float (&x)[16]) {
#pragma unroll
    for (int j = 0; j < 2; ++j) { const u32x4 a = *(const u32x4*)(p + 512 * j + 8 * lane); const unsigned w[4] = {a.x, a.y, a.z, a.w};
#pragma unroll
        for (int i = 0; i < 4; ++i) { x[8 * j + 2 * i] = bf2f((bf16_t)(w[i] & 0xffffu)); x[8 * j + 2 * i + 1] = bf2f((bf16_t)(w[i] >> 16)); } }
}
__device__ __forceinline__ void unpack16(const u32x4 (&a)[2], float (&x)[16]) {
#pragma unroll
    for (int j = 0; j < 2; ++j) { const unsigned w[4] = {a[j].x, a[j].y, a[j].z, a[j].w};
#pragma unroll
        for (int i = 0; i < 4; ++i) { x[8 * j + 2 * i] = bf2f((bf16_t)(w[i] & 0xffffu)); x[8 * j + 2 * i + 1] = bf2f((bf16_t)(w[i] >> 16)); } }
}
__device__ __forceinline__ void ldraw16(const bf16_t* p, int lane, u32x4 (&a)[2]) { a[0] = __builtin_nontemporal_load((const u32x4*)(p + 8 * lane)); a[1] = __builtin_nontemporal_load((const u32x4*)(p + 512 + 8 * lane)); }
__device__ __forceinline__ void st16_bf16(bf16_t* p, int lane, const float (&x)[16]) {
#pragma unroll
    for (int j = 0; j < 2; ++j) { u32x4 w; w.x = pk2(x[8 * j], x[8 * j + 1]); w.y = pk2(x[8 * j + 2], x[8 * j + 3]); w.z = pk2(x[8 * j + 4], x[8 * j + 5]); w.w = pk2(x[8 * j + 6], x[8 * j + 7]);
        *(u32x4*)(p + 512 * j + 8 * lane) = w; }
}
__device__ __forceinline__ void st16_fp8(unsigned char* p, int lane, const float (&x)[16]) {
#pragma unroll
    for (int j = 0; j < 2; ++j) { u32x2 w8; w8.x = pk4_fp8(x[8 * j], x[8 * j + 1], x[8 * j + 2], x[8 * j + 3]); w8.y = pk4_fp8(x[8 * j + 4], x[8 * j + 5], x[8 * j + 6], x[8 * j + 7]); *(u32x2*)(p + 512 * j + 8 * lane) = w8; }
}
__device__ __forceinline__ void st16_f32(float* p, int lane, const float (&x)[16]) {
#pragma unroll
    for (int j = 0; j < 2; ++j) { *(f32x4*)(p + 512 * j + 8 * lane) = (f32x4){x[8 * j], x[8 * j + 1], x[8 * j + 2], x[8 * j + 3]}; *(f32x4*)(p + 512 * j + 8 * lane + 4) = (f32x4){x[8 * j + 4], x[8 * j + 5], x[8 * j + 6], x[8 * j + 7]}; }
}
__device__ __forceinline__ void ln_apply(float (&x)[16], float mu, float rstd, const float (&gg)[16], const float (&bb)[16]) {
#pragma unroll
    for (int i = 0; i < 16; ++i) x[i] = (x[i] - mu) * rstd * gg[i] + bb[i];
}

__device__ __forceinline__ void phase_embed(const Frame& F0) {
    Frame F = F0; { size_t z_ = 0; asm volatile("" : "+v"(F.tid), "+v"(F.lane), "+s"(z_), "+s"(F.bid), "+s"(F.G), "+s"(F.wave)); F.ws = F0.ws + z_; F.out = F0.out + z_; }
    const int gw = F.bid * NWAVES + F.wave, nw = F.G * NWAVES;
    float gg[16], bb[16]; ld16_f32(F.in[I_LNEG], F.lane, gg); ld16_f32(F.in[I_LNEB], F.lane, bb);
    for (int row0 = gw; row0 < NTOK; row0 += 2 * nw) {
        float xs[2][16];
#pragma unroll
        for (int j = 0; j < 2; ++j) { const int row = row0 + j * nw; if (row < NTOK) { const int s = row / LSEQ, t = row - s * LSEQ;
            const float* src = (t < NMETA) ? F.in[I_META] + (size_t)t * D : ((s < NSEQ0) ? F.in[I_XP] + ((size_t)s * SEQ + (t - NMETA)) * D : F.in[I_XS] + ((size_t)(s - NSEQ0) * SEQ + (t - NMETA)) * D);
            ld16_f32(src, F.lane, xs[j]); } }
#pragma unroll
        for (int j = 0; j < 2; ++j) { const int row = row0 + j * nw; if (row < NTOK) {
            float mu, rstd; ln_stats(xs[j], mu, rstd); ln_apply(xs[j], mu, rstd, gg, bb);
            st16_bf16(F.hbuf() + (size_t)row * D, F.lane, xs[j]); st16_fp8((unsigned char*)F.out + OUT_HIN8 + (size_t)row * D, F.lane, xs[j]); } }
    }
}

__device__ __forceinline__ void phase_ln1_router(const Frame& F0, int li) {
    Frame F = F0; { size_t z_ = 0; asm volatile("" : "+v"(F.tid), "+v"(F.lane), "+s"(z_), "+s"(F.bid), "+s"(F.G), "+s"(F.wave)); F.ws = F0.ws + z_; F.out = F0.out + z_; }
    LAS float* RW = (LAS float*)F.lds;
    LAS unsigned* hl0 = (LAS unsigned*)(F.lds + 65536);
    for (int i = F.tid; i < 32 * 512; i += NTHREADS) hl0[i] = 0u;
    const float* router = F.in[I_ROUTER] + (size_t)li * D * NE;
    for (int i = F.tid; i < D * NE; i += NTHREADS) RW[(i & 15) * D + (i >> 4)] = router[i];
    { unsigned* hist = (unsigned*)(F.ws + WS_HIST); for (int i = F.bid * NTHREADS + F.tid; i < 2 * 32 * 1024; i += F.G * NTHREADS) hist[32 * 1024 + i] = 0u;
      if (F.bid == 0 && F.tid < 64) { unsigned* ctl = (unsigned*)(F.ws + WS_CTL); ctl[CW_CNT + F.tid] = 0u; ctl[CW_TIE + F.tid] = 0u; }
      int* stok = (int*)(F.ws + WS_STOK); float* sg = (float*)(F.ws + WS_SGATE);
      for (int i = F.bid * NTHREADS + F.tid; i < NE * (EROWS - EVALID); i += F.G * NTHREADS) { const int e = i / (EROWS - EVALID), r = EVALID + i % (EROWS - EVALID); stok[e * EROWS + r] = 0; sg[e * EROWS + r] = 0.f; } }
    __syncthreads();
    const bf16_t* X1 = (const bf16_t*)(F.ws + R_X1); float* aff = (float*)(F.ws + WS_AFF);
    float gg[16], bb[16]; ld16_f32(F.in[I_LN1G] + (size_t)li * D, F.lane, gg); ld16_f32(F.in[I_LN1B] + (size_t)li * D, F.lane, bb);
    const int gw = F.bid * NWAVES + F.wave, nw = F.G * NWAVES;
    for (int row0 = gw; row0 < NTOK; row0 += 4 * nw) {
      u32x4 XR[4][2];
#pragma unroll
      for (int jr = 0; jr < 4; ++jr) { const int row = row0 + jr * nw; if (row < NTOK) ldraw16(X1 + (size_t)row * D, F.lane, XR[jr]); }
#pragma unroll
      for (int jr = 0; jr < 4; ++jr) { const int row = row0 + jr * nw; if (row < NTOK) {
        float x[16]; unpack16(XR[jr], x);
        float mu, rstd; ln_stats(x, mu, rstd); ln_apply(x, mu, rstd, gg, bb);
        st16_bf16(F.hbuf() + (size_t)row * D, F.lane, x);
        { unsigned char* h8 = F.ws + R_H8 + (size_t)row * D;
#pragma unroll
          for (int j = 0; j < 2; ++j) { u32x2 w8; w8.x = pk4_fp8(x[8 * j], x[8 * j + 1], x[8 * j + 2], x[8 * j + 3]); w8.y = pk4_fp8(x[8 * j + 4], x[8 * j + 5], x[8 * j + 6], x[8 * j + 7]); *(u32x2*)(h8 + 512 * j + 8 * F.lane) = w8; } }
        float lg[16];
#pragma unroll
        for (int e = 0; e < 16; ++e) lg[e] = 0.f;
#pragma unroll 4
        for (int e = 0; e < 16; ++e) { float a = 0.f;
#pragma unroll
            for (int j = 0; j < 2; ++j) { const f32x4 w0 = *(const LAS f32x4*)(RW + e * D + 512 * j + 8 * F.lane), w1 = *(const LAS f32x4*)(RW + e * D + 512 * j + 8 * F.lane + 4);
                a += x[8 * j] * w0[0] + x[8 * j + 1] * w0[1] + x[8 * j + 2] * w0[2] + x[8 * j + 3] * w0[3] + x[8 * j + 4] * w1[0] + x[8 * j + 5] * w1[1] + x[8 * j + 6] * w1[2] + x[8 * j + 7] * w1[3]; }
            lg[e] = a; }
        float mx = -1e30f;
#pragma unroll
        for (int e = 0; e < 16; ++e) { lg[e] = wave_sum(lg[e]); mx = fmaxf(mx, lg[e]); }
        float den = 0.f;
#pragma unroll
        for (int e = 0; e < 16; ++e) { lg[e] = __expf(lg[e] - mx); den += lg[e]; }
        const float inv = __builtin_amdgcn_rcpf(den);
        float mine = 0.f;
#pragma unroll
        for (int e = 0; e < 16; ++e) mine = (F.lane == e) ? lg[e] * inv : mine;
        if (F.lane < 16) { aff[(size_t)row * 16 + F.lane] = mine;
            unsigned bin = __float_as_uint(mine) >> 20; if (bin > 1023u) bin = 1023u;
            (void)__hip_atomic_fetch_add(hl0 + ((row >= TOK0 ? 16 : 0) + F.lane) * 512 + (bin >> 1), 1u << (16 * (bin & 1u)), __ATOMIC_RELAXED, __HIP_MEMORY_SCOPE_WORKGROUP); }
      } }
    }
    __syncthreads();
    { unsigned* gh = (unsigned*)(F.ws + WS_HIST); for (int i = F.tid; i < 32 * 512; i += NTHREADS) { const unsigned v = hl0[i]; if (v & 0xffffu) atomicAdd(gh + 2 * i, v & 0xffffu); if (v >> 16) atomicAdd(gh + 2 * i + 1, v >> 16); } }
    __syncthreads();
}

__device__ __forceinline__ void find_bin(const unsigned* h, unsigned target, int lane, unsigned& bin, unsigned& rem, unsigned& bincnt) {
    unsigned c[16]; unsigned ls = 0;
#pragma unroll
    for (int i = 0; i < 16; ++i) { c[i] = __hip_atomic_load(h + 16 * lane + i, __ATOMIC_RELAXED, __HIP_MEMORY_SCOPE_AGENT); ls += c[i]; }
    unsigned x = ls;
#pragma unroll
    for (int o = 1; o < 64; o <<= 1) { const unsigned v = __shfl_down(x, o); if (lane + o < 64) x += v; }
    const unsigned above = x - ls;
    const bool own = (above < target) && (target <= above + ls);
    unsigned b = 0, r = 1, bc = 1;
    if (own) { unsigned cum = above; bool done = false;
#pragma unroll
        for (int i = 15; i >= 0; --i) { if (!done && target <= cum + c[i]) { b = 16 * lane + i; r = target - cum; bc = c[i]; done = true; } cum += c[i]; } }
    const unsigned long long m = __ballot(own);
    const int src = m ? (int)__builtin_ctzll(m) : 0;
    bin = __shfl(b, src); rem = __shfl(r, src); bincnt = __shfl(bc, src);
}
__device__ __forceinline__ void phase_topk(const Frame& F0, int pass) {
    Frame F = F0; { size_t z_ = 0; asm volatile("" : "+v"(F.tid), "+v"(F.lane), "+s"(z_), "+s"(F.bid), "+s"(F.G), "+s"(F.wave)); F.ws = F0.ws + z_; F.out = F0.out + z_; }
    LAS unsigned* hl = (LAS unsigned*)F.lds;
    LAS unsigned* selp = (LAS unsigned*)(F.lds + 131072);
    unsigned* hist = (unsigned*)(F.ws + WS_HIST);
    const float* aff = (const float*)(F.ws + WS_AFF);
    for (int i = F.tid; i < 32 * 1024; i += NTHREADS) hl[i] = 0u;
    for (int q = F.wave; q < 32; q += NWAVES) {
        const unsigned cap = (q < 16) ? CAP0 : CAP1; unsigned prefix = 0, rem = cap, bcnt = 0;
        for (int p = 0; p < pass; ++p) { unsigned bin, r; find_bin(hist + ((size_t)p * 32 + q) * 1024, rem, F.lane, bin, r, bcnt); prefix = (p == 0) ? bin : ((prefix << 10) | bin); rem = r; }
        if (F.lane == 0) { selp[q] = prefix; selp[32 + q] = rem; selp[64 + q] = bcnt; }
    }
    __syncthreads();
    if (pass < 3) {
        for (int tb0 = F.bid; tb0 < NTOK / 32; tb0 += 4 * F.G) {
            unsigned bv[4];
#pragma unroll
            for (int u = 0; u < 4; ++u) { const int tb = tb0 + u * F.G, tbc = tb < NTOK / 32 ? tb : NTOK / 32 - 1; bv[u] = __float_as_uint(aff[((size_t)tbc * 32 + (F.tid >> 4)) * 16 + (F.tid & 15)]); }
#pragma unroll
            for (int u = 0; u < 4; ++u) { const int tb = tb0 + u * F.G;
                const int t = tb * 32 + (F.tid >> 4), e = F.tid & 15, q = (t >= TOK0 ? 16 : 0) + e;
                const unsigned bits = bv[u];
                unsigned bin; bool ok;
                if (pass == 0) { bin = bits >> 20; ok = true; }
                else if (pass == 1) { bin = (bits >> 10) & 1023u; ok = (bits >> 20) == selp[q]; }
                else { bin = bits & 1023u; ok = (bits >> 10) == selp[q]; }
                if (bin > 1023u) bin = 1023u;
                if (ok && tb < NTOK / 32) (void)__hip_atomic_fetch_add(hl + q * 1024 + bin, 1u, __ATOMIC_RELAXED, __HIP_MEMORY_SCOPE_WORKGROUP); }
        }
        __syncthreads();
        unsigned* gh = hist + (size_t)pass * 32 * 1024;
        for (int i = F.tid; i < 32 * 1024; i += NTHREADS) { const unsigned v = hl[i]; if (v) atomicAdd(gh + i, v); }
    } else {
        unsigned* ctl = (unsigned*)(F.ws + WS_CTL); int* stok = (int*)(F.ws + WS_STOK); float* sg = (float*)(F.ws + WS_SGATE); int* inv = (int*)(F.ws + WS_INV);
        LAS unsigned* lcnt = selp + 96;
        LAS unsigned* lbase = selp + 128;
        if (F.tid < 32) lcnt[F.tid] = 0u;
        __syncthreads();
        auto selected = [&](int t, int e, int set, int q, unsigned bits) -> bool {
            const unsigned thr = selp[q]; bool sel = bits > thr; const bool tie = (bits == thr); if (tie) sel = true;
            unsigned long long need = __ballot(tie && (selp[64 + q] != selp[32 + q]));
            while (need) { const int src = (int)__builtin_ctzll(need); need &= need - 1;
                const int t_s = __shfl(t, src), e_s = __shfl(e, src), set_s = __shfl(set, src); const unsigned thr_s = __shfl(thr, src);
                unsigned c = 0; for (int t2 = (set_s ? TOK0 : 0) + F.lane; t2 < t_s; t2 += 64) c += (__float_as_uint(aff[(size_t)t2 * 16 + e_s]) == thr_s) ? 1u : 0u;
#pragma unroll
                for (int o = 32; o > 0; o >>= 1) c += __shfl_xor(c, o);
                if (F.lane == src) sel = c < selp[32 + q]; }
            return sel; };
        for (int tb = F.bid; tb < NTOK / 32; tb += F.G) {
            const int t = tb * 32 + (F.tid >> 4), e = F.tid & 15, set = (t >= TOK0) ? 1 : 0, q = set * 16 + e;
            if (selected(t, e, set, q, __float_as_uint(aff[(size_t)t * 16 + e]))) (void)__hip_atomic_fetch_add(lcnt + q, 1u, __ATOMIC_RELAXED, __HIP_MEMORY_SCOPE_WORKGROUP); }
        __syncthreads();
        if (F.tid < 32) { const unsigned n = lcnt[F.tid]; lbase[F.tid] = n ? atomicAdd(ctl + CW_CNT + F.tid, n) : 0u; lcnt[F.tid] = 0u; }
        __syncthreads();
        for (int tb = F.bid; tb < NTOK / 32; tb += F.G) {
            const int t = tb * 32 + (F.tid >> 4), e = F.tid & 15, set = (t >= TOK0) ? 1 : 0, q = set * 16 + e;
            const float a = aff[(size_t)t * 16 + e];
            int pos = -1;
            if (selected(t, e, set, q, __float_as_uint(a))) { const unsigned sl = lbase[q] + __hip_atomic_fetch_add(lcnt + q, 1u, __ATOMIC_RELAXED, __HIP_MEMORY_SCOPE_WORKGROUP); const unsigned cap = set ? CAP1 : CAP0;
                if (sl < cap) { pos = (int)(set ? CAP0 + sl : sl); stok[e * EROWS + pos] = t; sg[e * EROWS + pos] = a; } }
            inv[(size_t)t * 16 + e] = pos;
        }
    }
    __syncthreads();
}

__device__ __forceinline__ void phase_combine(const Frame& F0, int li) {
    Frame F = F0; { size_t z_ = 0; asm volatile("" : "+v"(F.tid), "+v"(F.lane), "+s"(z_), "+s"(F.bid), "+s"(F.G), "+s"(F.wave)); F.ws = F0.ws + z_; F.out = F0.out + z_; }
    const bf16_t* ye = (const bf16_t*)(F.ws + R_YE); const int* inv = (const int*)(F.ws + WS_INV);
    float gg[16], bb[16]; ld16_f32(F.in[I_LN2G] + (size_t)li * D, F.lane, gg); ld16_f32(F.in[I_LN2B] + (size_t)li * D, F.lane, bb);
    const int gw = F.bid * NWAVES + F.wave, nw = F.G * NWAVES;
    for (int row0 = gw; row0 < NTOK; row0 += 4 * nw) {
        u32x4 HR[4][2]; int iv[4];
#pragma unroll
        for (int j = 0; j < 4; ++j) { const int row = row0 + j * nw; iv[j] = -1; if (row < NTOK) { ldraw16(F.hbuf() + (size_t)row * D, F.lane, HR[j]); if (F.lane < 16) iv[j] = inv[(size_t)row * 16 + F.lane]; } }
        u32x4 Y0[4][2], Y1[4][2]; unsigned long long rest[4]; bool h0[4], h1[4];
#pragma unroll
        for (int j = 0; j < 4; ++j) { unsigned long long em = __ballot(iv[j] >= 0) & 0xFFFFull; h0[j] = false; h1[j] = false;
            if (em) { const int e = (int)__builtin_ctzll(em); em &= em - 1; const int p = __shfl(iv[j], e); ldraw16(ye + ((size_t)e * EROWS + p) * D, F.lane, Y0[j]); h0[j] = true; }
            if (em) { const int e = (int)__builtin_ctzll(em); em &= em - 1; const int p = __shfl(iv[j], e); ldraw16(ye + ((size_t)e * EROWS + p) * D, F.lane, Y1[j]); h1[j] = true; }
            rest[j] = em; }
#pragma unroll
        for (int j = 0; j < 4; ++j) { const int row = row0 + j * nw; if (row < NTOK) {
            float x[16]; unpack16(HR[j], x);
#pragma unroll
            for (int i = 0; i < 16; ++i) x[i] *= ALPHA;
            if (h0[j]) { float y[16]; unpack16(Y0[j], y);
#pragma unroll
                for (int i = 0; i < 16; ++i) x[i] += y[i]; }
            if (h1[j]) { float y[16]; unpack16(Y1[j], y);
#pragma unroll
                for (int i = 0; i < 16; ++i) x[i] += y[i]; }
            unsigned long long em = rest[j];
            while (em) { const int e = (int)__builtin_ctzll(em); em &= em - 1; const int p = __shfl(iv[j], e); float y[16]; ld16_bf16(ye + ((size_t)e * EROWS + p) * D, F.lane, y);
#pragma unroll
                for (int i = 0; i < 16; ++i) x[i] += y[i]; }
            float mu, rstd; ln_stats(x, mu, rstd); ln_apply(x, mu, rstd, gg, bb);
            if (li == NLAYER - 1) { const int s = row / LSEQ, t = row - s * LSEQ; if (t >= NMETA) st16_f32(F.out + ((size_t)s * SEQ + (t - NMETA)) * D, F.lane, x); }
            else { st16_bf16(F.hbuf() + (size_t)row * D, F.lane, x); st16_fp8((unsigned char*)F.out + OUT_HIN8 + (size_t)row * D, F.lane, x); } } }
    }
}

__device__ __forceinline__ f32x4 mfma16(bf16x8 x, bf16x8 y, f32x4 c) { return __builtin_amdgcn_mfma_f32_16x16x32_bf16(x, y, c, 0, 0, 0); }
__device__ __forceinline__ float dpp_f(float v, int ctrl_sel) {
    const int x = __float_as_int(v); int r;
    if (ctrl_sel == 0) r = __builtin_amdgcn_update_dpp(0, x, 0xB1, 0xF, 0xF, true);
    else if (ctrl_sel == 1) r = __builtin_amdgcn_update_dpp(0, x, 0x4E, 0xF, 0xF, true);
    else r = __builtin_amdgcn_update_dpp(0, x, 0x141, 0xF, 0xF, true);
    return __int_as_float(r);
}
__device__ __forceinline__ float red8(float v) { v += dpp_f(v, 0); v += dpp_f(v, 1); v += dpp_f(v, 2); return v; }
__device__ __forceinline__ float ldbf(const bf16_t* p) { return bf2f(*p); }

__device__ __forceinline__ bf16x8 pack4_(f32x4 a) { u32x4 r; r.x = pk2(a[0], a[1]); r.y = pk2(a[2], a[3]); r.z = 0u; r.w = 0u; return __builtin_bit_cast(bf16x8, r); }
__device__ __forceinline__ bf16x8 pack8_(f32x4 a, f32x4 b) { u32x4 r; r.x = pk2(a[0], a[1]); r.y = pk2(a[2], a[3]); r.z = pk2(b[0], b[1]); r.w = pk2(b[2], b[3]); return __builtin_bit_cast(bf16x8, r); }
__device__ __forceinline__ bf16x8 ld4_(const LAS bf16_t* p) { const u32x2 v = *(const LAS u32x2*)p; u32x4 r; r.x = v.x; r.y = v.y; r.z = 0u; r.w = 0u; return __builtin_bit_cast(bf16x8, r); }
__device__ __forceinline__ bf16x8 ld44_(const LAS bf16_t* p, const LAS bf16_t* q) { const u32x2 v = *(const LAS u32x2*)p, w = *(const LAS u32x2*)q; u32x4 r; r.x = v.x; r.y = v.y; r.z = w.x; r.w = w.y; return __builtin_bit_cast(bf16x8, r); }
__device__ __forceinline__ void rwkv_task(const Frame& F1, int li, int s, int d, int hg) {
    Frame F = F1; asm volatile("" : "+v"(F.tid), "+v"(F.lane));
    constexpr int DER = 17152;
    LAS float* ST = (LAS float*)(F.lds + 4 * DER);
    constexpr int STS = 260, STB = 2 * 16 * STS * 4;
    LAS bf16_t* TW = (LAS bf16_t*)(F.lds + 4 * DER + STB);
    LAS bf16_t* AD = TW + 16 * 72;
    LAS float* HS = (LAS float*)(F.lds + 4 * DER + STB + 4608);
    const int w = F.wave, hl = w >> 1, half = w & 1, h = 4 * hg + hl, lane = F.lane, fr = lane & 15, fq = lane >> 4, c = 64 * h + lane;
    LAS bf16_t* KAP = (LAS bf16_t*)(F.lds + hl * DER);
    LAS bf16_t* BH = KAP + 16 * 72; LAS bf16_t* KH = BH + 16 * 72; LAS bf16_t* RTL = KH + 16 * 72;
    LAS bf16_t* KBT = RTL + 16 * 72;
    LAS bf16_t* BBT = KBT + 64 * 20; LAS bf16_t* VT = BBT + 64 * 20;
    LAS float* GC = (LAS float*)(VT + 64 * 20);
    const bf16_t* U = F.ubuf();
    const float* mu = F.in[I_MU] + (size_t)li * 1920;
    const bf16_t* W2T = (const bf16_t*)(F.ws + WS_RW2T) + (((size_t)li * 2 + d) * 2 + 0) * 512 * 64 + (size_t)(64 * h + 32 * half + fr) * 64 + fq * 8; const bf16_t* A2T = W2T + (size_t)512 * 64;
    const float mu_r = mu[c], mu_k = mu[512 + c], mu_v = mu[1024 + c];
    const float w0c = F.in[I_W0][((size_t)li * 2 + d) * 512 + c], a0c = F.in[I_A0][((size_t)li * 2 + d) * 512 + c];
    const float kkc = F.in[I_KK][(size_t)li * 512 + c], kac = F.in[I_KA][(size_t)li * 512 + c], rkc = F.in[I_RK][(size_t)li * 512 + c];
    const int p_tt = F.tid >> 5, p_j = (F.tid & 31) * 2;
    const float mu_wd0 = mu[1536 + d * 64 + p_j], mu_wd1 = mu[1537 + d * 64 + p_j], mu_ad0 = mu[1664 + d * 64 + p_j], mu_ad1 = mu[1665 + d * 64 + p_j];
    float* bon = (float*)(F.ws + WS_BON);
    bf16_t* yout = (d == 0 ? F.br() : F.brx());
    const int ldy = (d == 0 ? 2048 : 1024);
    f32x4 Sacc[2][4];
#pragma unroll
    for (int it = 0; it < 2; ++it)
#pragma unroll
        for (int jt = 0; jt < 4; ++jt) Sacc[it][jt] = (f32x4){0.f, 0.f, 0.f, 0.f};
    const size_t rowbase = (size_t)s * LSEQ;
    const bool second = (d == 0) ? (half == 1) : (half == 0);
    unsigned pw[3], pa[3]; unsigned short pr[10], pk_[10], pv[10];
    auto prefetchA = [&](int t0) __attribute__((always_inline)) {
        { const int t = t0 + p_tt; const bf16_t* up = U + (rowbase + t) * N1 + 64 * d + p_j;
          const bf16_t* um = up - ((t > 0) ? N1 : 0); const bf16_t* upl = up + ((t < LSEQ - 1) ? N1 : 0);
          pw[1] = *(const unsigned*)(up + U1_WDN); pa[1] = *(const unsigned*)(up + U1_ADN);
          pw[0] = *(const unsigned*)(um + U1_WDN); pa[0] = *(const unsigned*)(um + U1_ADN);
          pw[2] = *(const unsigned*)(upl + U1_WDN); pa[2] = *(const unsigned*)(upl + U1_ADN); }
    };
    auto prefetchB = [&](int t0) __attribute__((always_inline)) {
        { const int tb = t0 + 8 * half - 1;
#pragma unroll
          for (int i = 0; i < 10; ++i) { int t = tb + i; t = t < 0 ? 0 : (t > LSEQ - 1 ? LSEQ - 1 : t); const bf16_t* up = U + (rowbase + t) * N1 + c;
            pr[i] = up[U1_R]; pk_[i] = up[U1_K]; pv[i] = up[U1_V]; } }
    };
    bf16x8 Xw[2][2], Xa[2][2];
#pragma unroll
    for (int ct = 0; ct < 2; ++ct)
#pragma unroll
        for (int ks = 0; ks < 2; ++ks) { Xw[ct][ks] = *(const bf16x8*)(W2T + ct * 16 * 64 + ks * 32); Xa[ct][ks] = *(const bf16x8*)(A2T + ct * 16 * 64 + ks * 32);
            asm volatile("" : "+v"(Xw[ct][ks]), "+v"(Xa[ct][ks])); }
    auto do_p1 = [&](int t0) __attribute__((always_inline)) {
        { float x[2], y[2];
          const unsigned mkm = (t0 + p_tt > 0) ? 0xffffffffu : 0u, mkp = (t0 + p_tt < LSEQ - 1) ? 0xffffffffu : 0u;
          const unsigned pw0 = pw[0] & mkm, pw2 = pw[2] & mkp, pa0 = pa[0] & mkm, pa2 = pa[2] & mkp;
#pragma unroll
          for (int e = 0; e < 2; ++e) { const int sh = 16 * e;
            const float x0 = bf2f((bf16_t)((pw[1] >> sh) & 0xffffu)), xm = bf2f((bf16_t)((pw0 >> sh) & 0xffffu)), xp = bf2f((bf16_t)((pw2 >> sh) & 0xffffu));
            const float y0 = bf2f((bf16_t)((pa[1] >> sh) & 0xffffu)), ym = bf2f((bf16_t)((pa0 >> sh) & 0xffffu)), yp = bf2f((bf16_t)((pa2 >> sh) & 0xffffu));
            { const float xa_ = x0 + (e ? mu_wd1 : mu_wd0) * (0.5f * (xm + xp) - x0); x[e] = 1.0f - 2.0f * __builtin_amdgcn_rcpf(1.0f + __expf(2.0f * xa_)); } y[e] = y0 + (e ? mu_ad1 : mu_ad0) * (0.5f * (ym + yp) - y0); }
          *(LAS unsigned*)(TW + p_tt * 72 + p_j) = pk2(x[0], x[1]); *(LAS unsigned*)(AD + p_tt * 72 + p_j) = pk2(y[0], y[1]); }
    };
    { const int t00 = (d == 0) ? 0 : LSEQ - 16, t01 = (d == 0) ? 16 : LSEQ - 32;
      prefetchA(t00); prefetchB(t00); do_p1(t00); prefetchA(t01); }
    __syncthreads();
    for (int ci = 0; ci < LSEQ / 16; ++ci) {
        const int t0 = (d == 0) ? 16 * ci : LSEQ - 16 - 16 * ci;
        { bf16x8 Yt[2], Ya[2];
#pragma unroll
          for (int ks = 0; ks < 2; ++ks) { Yt[ks] = *(const LAS bf16x8*)(TW + fr * 72 + ks * 32 + fq * 8); Ya[ks] = *(const LAS bf16x8*)(AD + fr * 72 + ks * 32 + fq * 8); }
#pragma unroll
          for (int ct = 0; ct < 2; ++ct) { f32x4 aw = (f32x4){0.f, 0.f, 0.f, 0.f}, aa = aw;
            aw = mfma16(Xw[ct][0], Yt[0], aw); aw = mfma16(Xw[ct][1], Yt[1], aw); aa = mfma16(Xa[ct][0], Ya[0], aa); aa = mfma16(Xa[ct][1], Ya[1], aa);
            *(LAS f32x4*)(ST + fr * STS + 64 * hl + 32 * half + ct * 16 + 4 * fq) = aw; *(LAS f32x4*)(ST + 16 * STS + fr * STS + 64 * hl + 32 * half + ct * 16 + 4 * fq) = aa; } }
        __syncthreads();
        { const bool lo_ok = (t0 + 8 * half - 1 >= 0), hi_ok = (t0 + 8 * half + 8 < LSEQ);
          if (!lo_ok) { pr[0] = 0; pk_[0] = 0; pv[0] = 0; }
          if (!hi_ok) { pr[9] = 0; pk_[9] = 0; pv[9] = 0; } }
        float lwv[8]; float tot = 0.f, other = 0.f;
#pragma unroll
        for (int i = 0; i < 8; ++i) { lwv[i] = -0.60653065971f * sigmoidf_(ST[(8 * half + i) * STS + 64 * hl + lane] + w0c); tot += lwv[i];
            other += -0.60653065971f * sigmoidf_(ST[(8 * (half ^ 1) + i) * STS + 64 * hl + lane] + w0c); }
        { const float off = second ? other : 0.f, glast = tot + other, eglast = __expf(glast);
          float run = 0.f, bsel = 0.f;
#pragma unroll
          for (int i = 0; i < 8; i += 2) {
            const int tt0 = 8 * half + i;
            const f32x2 rm = (f32x2){bf2f(pr[i]), bf2f(pr[i + 1])}, r1 = (f32x2){bf2f(pr[i + 1]), bf2f(pr[i + 2])}, rp = (f32x2){bf2f(pr[i + 2]), bf2f(pr[i + 3])};
            const f32x2 km = (f32x2){bf2f(pk_[i]), bf2f(pk_[i + 1])}, k1 = (f32x2){bf2f(pk_[i + 1]), bf2f(pk_[i + 2])}, kp = (f32x2){bf2f(pk_[i + 2]), bf2f(pk_[i + 3])};
            const f32x2 vm = (f32x2){bf2f(pv[i]), bf2f(pv[i + 1])}, v1 = (f32x2){bf2f(pv[i + 1]), bf2f(pv[i + 2])}, vp = (f32x2){bf2f(pv[i + 2]), bf2f(pv[i + 3])};
            const f32x2 r = r1 + mu_r * (0.5f * (rm + rp) - r1), k = k1 + mu_k * (0.5f * (km + kp) - k1), v = v1 + mu_v * (0.5f * (vm + vp) - v1);
            const f32x2 al = (f32x2){ST[16 * STS + tt0 * STS + 64 * hl + lane], ST[16 * STS + (tt0 + 1) * STS + 64 * hl + lane]} + a0c;
            const f32x2 a = (f32x2){sigmoidf_(al.x), sigmoidf_(al.y)};
            const f32x2 kd = k * (1.0f + (a - 1.0f) * kac), kk = k * kkc, sq = kk * kk, bs = r * kd * rkc;
            const f32x2 inrm = (f32x2){__builtin_amdgcn_rsqf(fmaxf(wave_sum(sq.x), 1e-24f)), __builtin_amdgcn_rsqf(fmaxf(wave_sum(sq.y), 1e-24f))};
            const float b0 = wave_sum(bs.x), b1 = wave_sum(bs.y);
            bsel = ((lane & 7) == i) ? b0 : (((lane & 7) == i + 1) ? b1 : bsel);
            const f32x2 kkn = kk * inrm, bt = kkn * a;
            run += lwv[i]; const float g0 = off + ((d == 0) ? run : (tot - run + lwv[i]));
            run += lwv[i + 1]; const float g1 = off + ((d == 0) ? run : (tot - run + lwv[i + 1]));
            const f32x2 eg = (f32x2){__expf(g0), __expf(g1)}, eng = (f32x2){__builtin_amdgcn_rcpf(eg.x), __builtin_amdgcn_rcpf(eg.y)}, ebar = eglast * eng;
            const f32x2 egm1 = (f32x2){__expf(g0 - lwv[i]), __expf(g1 - lwv[i + 1])};
            const f32x2 kap = kkn * egm1, bh = bt * eng, kh = kd * eng, rt = r * eg, kb = kd * ebar, bbn = -(bt * ebar);
            const int u0 = (d == 0) ? tt0 : 15 - tt0, u1 = (d == 0) ? u0 + 1 : u0 - 1, ulo = (d == 0) ? u0 : u1;
            { const unsigned p = pk2(kap.x, kap.y); KAP[u0 * 72 + lane] = (bf16_t)(p & 0xffffu); KAP[u1 * 72 + lane] = (bf16_t)(p >> 16); }
            { const unsigned p = pk2(bh.x, bh.y); BH[u0 * 72 + lane] = (bf16_t)(p & 0xffffu); BH[u1 * 72 + lane] = (bf16_t)(p >> 16); }
            { const unsigned p = pk2(kh.x, kh.y); KH[u0 * 72 + lane] = (bf16_t)(p & 0xffffu); KH[u1 * 72 + lane] = (bf16_t)(p >> 16); }
            { const unsigned p = pk2(rt.x, rt.y); RTL[u0 * 72 + lane] = (bf16_t)(p & 0xffffu); RTL[u1 * 72 + lane] = (bf16_t)(p >> 16); }
            { unsigned p = pk2(kb.x, kb.y); if (d) p = (p >> 16) | (p << 16); *(LAS unsigned*)(KBT + lane * 20 + ulo) = p; }
            { unsigned p = pk2(bbn.x, bbn.y); if (d) p = (p >> 16) | (p << 16); *(LAS unsigned*)(BBT + lane * 20 + ulo) = p; }
            { unsigned p = pk2(v.x, v.y); if (d) p = (p >> 16) | (p << 16); *(LAS unsigned*)(VT + lane * 20 + ulo) = p; } }
          bon[(rowbase + t0 + 8 * half + (lane & 7)) * 16 + d * 8 + h] = bsel;
          if (half == 0) GC[lane] = eglast; }
        if (ci + 1 < LSEQ / 16) { const int t1 = (d == 0) ? t0 + 16 : t0 - 16;
            prefetchB(t1);
            do_p1(t1);
            if (ci + 2 < LSEQ / 16) prefetchA((d == 0) ? t0 + 32 : t0 - 32); }
        __syncthreads();
        f32x4 aA = (f32x4){0.f, 0.f, 0.f, 0.f}, aAT = aA, aBT = aA, aC1 = aA, aC2 = aA;
#pragma unroll
        for (int ks = 0; ks < 2; ++ks) { const int o = fr * 72 + 32 * ks + 8 * fq;
            const bf16x8 fK = *(const LAS bf16x8*)(KAP + o), fB = *(const LAS bf16x8*)(BH + o), fH = *(const LAS bf16x8*)(KH + o), fR = *(const LAS bf16x8*)(RTL + o);
            aA = mfma16(fK, fB, aA); aAT = mfma16(fB, fK, aAT); aBT = mfma16(fH, fK, aBT); aC1 = mfma16(fH, fR, aC1); aC2 = mfma16(fB, fR, aC2); }
        f32x4 N, NT, H1;
#pragma unroll
        for (int e = 0; e < 4; ++e) { const int row = 4 * fq + e;
            N[e] = (fr < row) ? -aA[e] : 0.f; NT[e] = (row < fr) ? -aAT[e] : 0.f; aBT[e] = (row < fr) ? aBT[e] : 0.f;
            aC1[e] = (row <= fr) ? aC1[e] : 0.f; aC2[e] = (row <= fr) ? aC2[e] : 0.f; H1[e] = NT[e] + ((row == fr) ? 1.0f : 0.f); }
        const f32x4 Z4 = (f32x4){0.f, 0.f, 0.f, 0.f};
        const bf16x8 pN = pack4_(N), pNT = pack4_(NT);
        const f32x4 N2 = mfma16(pNT, pN, Z4), N2T = mfma16(pN, pNT, Z4);
        const bf16x8 pN2 = pack4_(N2), pN2T = pack4_(N2T);
        const f32x4 N4 = mfma16(pN2T, pN2, Z4), N4T = mfma16(pN2, pN2T, Z4);
        const bf16x8 pN4 = pack4_(N4);
        const f32x4 N8 = mfma16(pack4_(N4T), pN4, Z4);
        const f32x4 G1T = mfma16(pN2, pack4_(H1), H1);
        const f32x4 G2T = mfma16(pN4, pack4_(G1T), G1T);
        const f32x4 TT = mfma16(pack4_(N8), pack4_(G2T), G2T);
        const bf16x8 pTT = pack4_(TT), pBT = pack4_(aBT), pC1 = pack4_(aC1), pC2 = pack4_(aC2);
#pragma unroll
        for (int it = 0; it < 2; ++it) {
            const int i0 = 32 * half + 16 * it;
            const bf16x8 Vf = ld4_(VT + (i0 + fr) * 20 + 4 * fq);
            const bf16x8 Sf0 = pack8_(Sacc[it][0], Sacc[it][1]), Sf1 = pack8_(Sacc[it][2], Sacc[it][3]);
            f32x4 R = mfma16(ld44_(KAP + fr * 72 + 4 * fq, KAP + fr * 72 + 16 + 4 * fq), Sf0, Z4);
            R = mfma16(ld44_(KAP + fr * 72 + 32 + 4 * fq, KAP + fr * 72 + 48 + 4 * fq), Sf1, R);
            R = mfma16(pBT, Vf, R);
            const f32x4 Uu = mfma16(pTT, pack4_(R), Z4);
            f32x4 y = mfma16(Sf0, ld44_(RTL + fr * 72 + 4 * fq, RTL + fr * 72 + 16 + 4 * fq), Z4);
            y = mfma16(Sf1, ld44_(RTL + fr * 72 + 32 + 4 * fq, RTL + fr * 72 + 48 + 4 * fq), y);
            y = mfma16(Vf, pC1, y);
            const bf16x8 pU = pack4_(Uu), pUn = pack4_(-Uu);
            y = mfma16(pUn, pC2, y);
            { const int t = (d == 0) ? (t0 + fr) : (t0 + 15 - fr); u32x2 o; o.x = pk2(y[0], y[1]); o.y = pk2(y[2], y[3]);
              *(u32x2*)(yout + (rowbase + t) * ldy + 512 + 64 * h + i0 + 4 * fq) = o; }
#pragma unroll
            for (int jt = 0; jt < 4; ++jt) { const f32x4 dc = *(const LAS f32x4*)(GC + 16 * jt + 4 * fq);
                f32x4 acc = Sacc[it][jt] * dc;
                acc = mfma16(ld4_(KBT + (16 * jt + fr) * 20 + 4 * fq), Vf, acc);
                acc = mfma16(ld4_(BBT + (16 * jt + fr) * 20 + 4 * fq), pU, acc);
                Sacc[it][jt] = acc; }
            __builtin_amdgcn_sched_barrier(0);
        }
    }
    __syncthreads();
}

__device__ __forceinline__ void lru_block(const Frame& F1, int li, int s, int d, int g) {
    Frame F = F1; asm volatile("" : "+v"(F.tid), "+v"(F.lane));
    const int lane = F.lane, fr = lane & 15, fq = lane >> 4, c = 64 * g + lane;
    LAS bf16_t* XCT = (LAS bf16_t*)F.lds + F.wave * (16 * 72);
    constexpr int RSS = 68;
    LAS float* RS = (LAS float*)(F.lds + 18432) + F.wave * (3 * 16 * RSS);
    const bf16_t* U = F.ubuf();
    bf16x8 Xr[4][2], Xi[4][2];
    { const bf16_t* wrt = (const bf16_t*)(F.ws + WS_LRUT) + ((((size_t)li * 2 + d) * 2 + 0) * 8 + g) * 64 * 64; const bf16_t* wit = wrt + (size_t)8 * 64 * 64;
#pragma unroll
      for (int ct = 0; ct < 4; ++ct)
#pragma unroll
        for (int ks = 0; ks < 2; ++ks) { Xr[ct][ks] = *(const bf16x8*)(wrt + (ct * 16 + fr) * 64 + ks * 32 + fq * 8); Xi[ct][ks] = *(const bf16x8*)(wit + (ct * 16 + fr) * 64 + ks * 32 + fq * 8); } }
    const float* cw = F.in[I_CONVW] + (size_t)li * 4 * 512;
    const float cw0 = cw[c], cw1 = cw[512 + c], cw2 = cw[1024 + c], cw3 = cw[1536 + c], cb = F.in[I_CONVB][(size_t)li * 512 + c];
    const float brc = F.in[I_BR][((size_t)li * 2 + d) * 512 + c], bic = F.in[I_BI][((size_t)li * 2 + d) * 512 + c];
    const float lamfac = -8.0f * softplusf_(-F.in[I_LAM][((size_t)li * 2 + d) * 512 + c]);
    bf16_t* hout = (d == 0 ? F.br() : F.brx()); const int ldy = (d == 0 ? 2048 : 1024);
    const size_t rowbase = (size_t)s * LSEQ;
    float hs = 0.f;
    unsigned short px[19];
    auto lru_prefetch = [&](int t0) {
#pragma unroll
        for (int i = 0; i < 19; ++i) { int t = t0 - 2 + i; t = t < 0 ? 0 : (t > LSEQ - 1 ? LSEQ - 1 : t); px[i] = U[(rowbase + t) * N1 + U1_AX + c]; } };
    lru_prefetch((d == 0) ? 0 : LSEQ - 16);
    for (int ci = 0; ci < LSEQ / 16; ++ci) {
        const int t0 = (d == 0) ? 16 * ci : LSEQ - 16 - 16 * ci;
        { float xa[19];
#pragma unroll
          for (int i = 0; i < 19; ++i) { const int t = t0 - 2 + i; xa[i] = (t >= 0 && t < LSEQ) ? bf2f(px[i]) : 0.f; }
          if (ci + 1 < LSEQ / 16) lru_prefetch((d == 0) ? t0 + 16 : t0 - 16);
#pragma unroll
          for (int tt = 0; tt < 16; ++tt) { const float xc = cb + cw0 * xa[tt] + cw1 * xa[tt + 1] + cw2 * xa[tt + 2] + cw3 * xa[tt + 3];
            XCT[tt * 72 + lane] = f2bf(xc); RS[32 * RSS + tt * RSS + lane] = xc; } }
        { bf16x8 Y[2];
#pragma unroll
          for (int ks = 0; ks < 2; ++ks) Y[ks] = *(const LAS bf16x8*)(XCT + fr * 72 + ks * 32 + fq * 8);
#pragma unroll
          for (int ct = 0; ct < 4; ++ct) { f32x4 ar = (f32x4){0.f, 0.f, 0.f, 0.f}, ai = ar;
            ar = mfma16(Xr[ct][0], Y[0], ar); ar = mfma16(Xr[ct][1], Y[1], ar); ai = mfma16(Xi[ct][0], Y[0], ai); ai = mfma16(Xi[ct][1], Y[1], ai);
            *(LAS f32x4*)(RS + fr * RSS + ct * 16 + 4 * fq) = ar; *(LAS f32x4*)(RS + 16 * RSS + fr * RSS + ct * 16 + 4 * fq) = ai; } }
        { float av[16], bbv[16];
#pragma unroll
          for (int i = 0; i < 16; ++i) { const int tt = (d == 0) ? i : 15 - i;
            const float r = sigmoidf_(RS[tt * RSS + lane] + brc), ig = sigmoidf_(RS[16 * RSS + tt * RSS + lane] + bic), xc = RS[32 * RSS + tt * RSS + lane];
            const float a = __expf(lamfac * r); av[i] = a; bbv[i] = __builtin_amdgcn_sqrtf(fmaxf(1.0f - a * a, 0.f)) * ig * xc; }
#pragma unroll
          for (int i = 0; i < 16; ++i) { const int tt = (d == 0) ? i : 15 - i; hs = av[i] * hs + bbv[i]; hout[(rowbase + t0 + tt) * ldy + c] = f2bf(hs); } }
    }
}
__device__ __forceinline__ void lru_task(const Frame& F, int li, int s, int d) { lru_block(F, li, s, d, F.wave); __syncthreads(); }

__device__ __forceinline__ void phase_scan1(const Frame& F0, int li) {
    Frame F = F0; { size_t z_ = 0; asm volatile("" : "+v"(F.tid), "+v"(F.lane), "+s"(z_), "+s"(F.bid), "+s"(F.G), "+s"(F.wave)); F.ws = F0.ws + z_; F.out = F0.out + z_; }
    if (F.G == 256) {
        if (F.bid < 192) rwkv_task(F, li, F.bid >> 2, (F.bid >> 1) & 1, F.bid & 1);
        else {
            const int j = F.bid - 192, b0 = 12 * j + F.wave;
            lru_block(F, li, b0 >> 4, (b0 >> 3) & 1, b0 & 7);
            if (F.wave < 4) { const int b1 = 12 * j + 8 + F.wave; lru_block(F, li, b1 >> 4, (b1 >> 3) & 1, b1 & 7); }
            __syncthreads(); }
    } else {
        for (int task = F.bid; task < 288; task += F.G) {
            if (task < 192) rwkv_task(F, li, task >> 2, (task >> 1) & 1, task & 1);
            else lru_task(F, li, (task - 192) >> 1, (task - 192) & 1);
        }
    }
}

__device__ __forceinline__ void phase_post1(const Frame& F0, int li) {
    Frame F = F0; { size_t z_ = 0; asm volatile("" : "+v"(F.tid), "+v"(F.lane), "+s"(z_), "+s"(F.bid), "+s"(F.G), "+s"(F.wave)); F.ws = F0.ws + z_; F.out = F0.out + z_; }
    const int lane = F.lane, fr = lane & 15, fq = lane >> 4;
    LAS bf16_t* SG = (LAS bf16_t*)F.lds + F.wave * (16 * 136);
    const bf16_t* U = F.ubuf(); const bf16_t* G2T = (const bf16_t*)(F.ws + WS_G2T) + (size_t)li * 512 * 128;
    const float* mu = F.in[I_MU] + (size_t)li * 1920; const float* bon = (const float*)(F.ws + WS_BON);
    const float* lng = F.in[I_LNXG] + (size_t)li * 512; const float* lnb = F.in[I_LNXB] + (size_t)li * 512;
    bf16_t* BR = F.br(); const bf16_t* BRX = F.brx();
    LAS float* PM = (LAS float*)(F.lds + 40960);
    for (int i = F.tid; i < 512; i += NTHREADS) { PM[i] = mu[1024 + i]; PM[512 + i] = lng[i]; PM[1024 + i] = lnb[i]; }
    __syncthreads();
    const int gw = F.bid * NWAVES + F.wave, nw = F.G * NWAVES;
    for (int tile = gw; tile < NTOK / 16; tile += nw) {
        const int row0 = tile * 16;
#pragma unroll 4
        for (int r = 0; r < 16; ++r) { bf16_t* p = BR + (size_t)(row0 + r) * 2048 + 8 * lane; const u32x4 a = *(const u32x4*)p, b = *(const u32x4*)(BRX + (size_t)(row0 + r) * 1024 + 8 * lane);
            const unsigned aw[4] = {a.x, a.y, a.z, a.w}, bw[4] = {b.x, b.y, b.z, b.w}; unsigned o[4];
#pragma unroll
            for (int j = 0; j < 4; ++j) o[j] = pk2(bf2f((bf16_t)(aw[j] & 0xffffu)) + bf2f((bf16_t)(bw[j] & 0xffffu)), bf2f((bf16_t)(aw[j] >> 16)) + bf2f((bf16_t)(bw[j] >> 16)));
            u32x4 w; w.x = o[0]; w.y = o[1]; w.z = o[2]; w.w = o[3]; *(u32x4*)p = w; }
#pragma unroll 4
        for (int r = 0; r < 16; ++r) { const int row = row0 + r, s = row / LSEQ, t = row - s * LSEQ; const bf16_t* up = U + (size_t)row * N1 + U1_GDN + 2 * lane;
            const unsigned x0 = *(const unsigned*)up, xm = (t > 0) ? *(const unsigned*)(up - N1) : 0u, xp = (t < LSEQ - 1) ? *(const unsigned*)(up + N1) : 0u;
            const float m0 = mu[1792 + 2 * lane], m1 = mu[1793 + 2 * lane];
            const float a0 = bf2f((bf16_t)(x0 & 0xffffu)), a1 = bf2f((bf16_t)(x0 >> 16));
            const float g0 = a0 + m0 * (0.5f * (bf2f((bf16_t)(xm & 0xffffu)) + bf2f((bf16_t)(xp & 0xffffu))) - a0), g1 = a1 + m1 * (0.5f * (bf2f((bf16_t)(xm >> 16)) + bf2f((bf16_t)(xp >> 16))) - a1);
            *(LAS unsigned*)(SG + r * 136 + 2 * lane) = pk2(sigmoidf_(g0), sigmoidf_(g1)); }
        bf16x8 Y[4];
#pragma unroll
        for (int ks = 0; ks < 4; ++ks) Y[ks] = *(const LAS bf16x8*)(SG + fr * 136 + ks * 32 + fq * 8);
        const int row = row0 + fr, s = row / LSEQ, t = row - s * LSEQ;
        struct HIn { u32x2 a[4], b[4], v0[4], vm[4], vp[4]; float b0, b1; };
        auto hload = [&](int h, HIn& I) __attribute__((always_inline)) {
#pragma unroll
            for (int ct = 0; ct < 4; ++ct) { const int col = 512 + 64 * h + ct * 16 + 4 * fq; I.a[ct] = *(const u32x2*)(BR + (size_t)row * 2048 + col); I.b[ct] = *(const u32x2*)(BRX + (size_t)row * 1024 + col);
                const bf16_t* up = U + (size_t)row * N1 + U1_V + 64 * h + ct * 16 + 4 * fq;
                I.v0[ct] = *(const u32x2*)up; I.vm[ct] = *(const u32x2*)(up - ((t > 0) ? N1 : 0)); I.vp[ct] = *(const u32x2*)(up + ((t < LSEQ - 1) ? N1 : 0)); }
            I.b0 = bon[(size_t)row * 16 + h]; I.b1 = bon[(size_t)row * 16 + 8 + h]; };
        auto hcomp = [&](int h, const HIn& I) __attribute__((always_inline)) {
            f32x4 gacc[4];
#pragma unroll
            for (int ct = 0; ct < 4; ++ct) { gacc[ct] = (f32x4){0.f, 0.f, 0.f, 0.f};
#pragma unroll
                for (int ks = 0; ks < 4; ++ks) { const bf16x8 X = *(const bf16x8*)(G2T + (size_t)(64 * h + ct * 16 + fr) * 128 + ks * 32 + fq * 8); gacc[ct] = mfma16(X, Y[ks], gacc[ct]); } }
            float y[16]; float sm = 0.f;
#pragma unroll
            for (int ct = 0; ct < 4; ++ct) { const u32x2 a = I.a[ct], b = I.b[ct];
                y[4 * ct] = bf2f((bf16_t)(a.x & 0xffffu)) + bf2f((bf16_t)(b.x & 0xffffu)); y[4 * ct + 1] = bf2f((bf16_t)(a.x >> 16)) + bf2f((bf16_t)(b.x >> 16));
                y[4 * ct + 2] = bf2f((bf16_t)(a.y & 0xffffu)) + bf2f((bf16_t)(b.y & 0xffffu)); y[4 * ct + 3] = bf2f((bf16_t)(a.y >> 16)) + bf2f((bf16_t)(b.y >> 16)); }
#pragma unroll
            for (int i = 0; i < 16; ++i) sm += y[i];
            sm = rows_sum(sm);
            const float mean = sm * (1.0f / 64.0f); float q = 0.f;
#pragma unroll
            for (int i = 0; i < 16; ++i) { const float dl = y[i] - mean; q += dl * dl; }
            q = rows_sum(q);
            const float rstd = rsqrtf(q * (1.0f / 64.0f) + 64e-5f);
            const float bsum = I.b0 + I.b1;
            const unsigned mkm = (t > 0) ? 0xffffffffu : 0u, mkp = (t < LSEQ - 1) ? 0xffffffffu : 0u;
#pragma unroll
            for (int ct = 0; ct < 4; ++ct) { const int cc = 64 * h + ct * 16 + 4 * fq;
                const f32x4 pmu = *(const LAS f32x4*)(PM + cc), pg = *(const LAS f32x4*)(PM + 512 + cc), pb = *(const LAS f32x4*)(PM + 1024 + cc);
                const unsigned v0w[2] = {I.v0[ct].x, I.v0[ct].y}, vmw[2] = {I.vm[ct].x & mkm, I.vm[ct].y & mkm}, vpw[2] = {I.vp[ct].x & mkp, I.vp[ct].y & mkp}; float o[4];
#pragma unroll
                for (int e = 0; e < 4; ++e) { const int sh = (e & 1) * 16; const float x0 = bf2f((bf16_t)((v0w[e >> 1] >> sh) & 0xffffu)), xm = bf2f((bf16_t)((vmw[e >> 1] >> sh) & 0xffffu)), xp = bf2f((bf16_t)((vpw[e >> 1] >> sh) & 0xffffu));
                    const float v = x0 + pmu[e] * (0.5f * (xm + xp) - x0);
                    const float yn = (y[4 * ct + e] - mean) * rstd * pg[e] + pb[e];
                    o[e] = (yn + bsum * v) * gacc[ct][e]; }
                u32x2 w; w.x = pk2(o[0], o[1]); w.y = pk2(o[2], o[3]);
                *(u32x2*)(BR + (size_t)row * 2048 + 512 + cc) = w; } };
        HIn hN, hC;
        hload(0, hN);
#pragma unroll 1
        for (int h = 0; h < 8; ++h) { hC = hN;
            if (h + 1 < 8) hload(h + 1, hN);
            hcomp(h, hC); }
    }
    __syncthreads();
}

template <int DK>
__device__ __forceinline__ void gla_task(const Frame& F1, int li, int s, int hd, int d) {
    Frame F = F1; asm volatile("" : "+v"(F.tid), "+v"(F.lane));
    constexpr bool RET = (DK == 64); constexpr int QS = DK + 8, TS = 72, NDT = DK / 16, NKS = DK / 32;
    LAS bf16_t* QT = (LAS bf16_t*)F.lds;
    LAS bf16_t* KT = QT + 64 * QS;
    LAS bf16_t* KBT = KT + 64 * QS;
    LAS bf16_t* VT = KBT + DK * TS;
    LAS float* DEC = (LAS float*)(VT + 128 * TS);
    const int lane = F.lane, w = F.wave, fr = lane & 15, fq = lane >> 4, tid = F.tid;
    const bf16_t* U = F.ubuf();
    bf16_t* oout = (d == 0 ? F.br() : F.brx()); const int ldy = (d == 0 ? 2048 : 1024);
    const int ocol = (d == 0 ? (RET ? 1536 : 1024) : (RET ? 512 : 0)) + 128 * hd;
    const size_t rowbase = (size_t)s * LSEQ;
    const int pd = tid & 127, pg = tid >> 7;
    float lbv = 0.f, lgam = 0.f, invf = 0.f, cth = 1.f, sth = 0.f;
    if constexpr (!RET) lbv = ((const float*)(F.ws + WS_LB))[(size_t)li * 512 + 128 * hd + pd];
    else { const float gam = sigmoidf_(F.in[I_RDEC][((size_t)li * 2 + d) * 4 + hd]); lgam = __logf(gam);
           invf = expf(-(float)(tid & 31) * (9.210340371976184f / 32.0f)); cth = cosf(invf); sth = (d == 0) ? sinf(invf) : -sinf(invf); }
    f32x4 Sacc[NDT];
#pragma unroll
    for (int i = 0; i < NDT; ++i) Sacc[i] = (f32x4){0.f, 0.f, 0.f, 0.f};
    unsigned short ra[16], rb[16], rc[16];
    const int ri = tid & 31; const bool risk = (tid & 32) != 0; const int rg2 = tid >> 6;
    auto prefetch = [&](int sc) { const int nt = (sc < 32) ? 64 : 16, tau0 = 64 * sc;
        if (16 * pg < nt) { const int tb = tau0 + 16 * pg;
#pragma unroll
            for (int i = 0; i < 16; ++i) { const int t = d ? (LSEQ - 1 - (tb + i)) : (tb + i); const bf16_t* up = U + (rowbase + t) * N2 + 128 * hd + pd;
                if constexpr (!RET) { ra[i] = up[U2_CQ]; rb[i] = up[U2_CF + 512 * d]; rc[i] = up[U2_CI]; } else rc[i] = up[U2_DV]; } }
        if constexpr (RET) { if (8 * rg2 < nt) { const int tb = tau0 + 8 * rg2; const int tfirst = d ? (LSEQ - 1 - tb) : tb;
#pragma unroll
            for (int j = 0; j < 8; ++j) { const int t = d ? (tfirst - j) : (tfirst + j); const bf16_t* up = U + (rowbase + t) * N2 + (risk ? U2_DK : U2_DQ) + 64 * hd + ri; ra[j] = up[0]; rb[j] = up[32]; } } } };
    prefetch(0);
    for (int sc = 0; sc < 33; ++sc) {
        const int nt = (sc < 32) ? 64 : 16, nsub = nt >> 4, tau0 = 64 * sc;
        if (16 * pg < nt) {
            if constexpr (!RET) {
                float kk[16]; float eb = 1.0f;
#pragma unroll
                for (int i = 0; i < 16; ++i) { const float fr_ = bf2f(rb[i]), sg = sigmoidf_(fr_); const float f = lbv + (1.0f - lbv) * sg, k = (1.0f - lbv) * (1.0f - sg);
                    eb *= f; const float enb = __builtin_amdgcn_rcpf(eb); const float q = siluf_(bf2f(ra[i])) * 0.08838834764831845f;
                    QT[(16 * pg + i) * QS + pd] = f2bf(q * eb); KT[(16 * pg + i) * QS + pd] = f2bf(k * enb); kk[i] = k * enb;
                    VT[pd * TS + 16 * pg + i] = rc[i]; }
#pragma unroll
                for (int i = 0; i < 16; i += 2) *(LAS unsigned*)(KBT + pd * TS + 16 * pg + i) = pk2(kk[i] * eb, kk[i + 1] * eb);
                DEC[pg * DK + pd] = eb;
            } else {
#pragma unroll
                for (int i = 0; i < 16; ++i) VT[pd * TS + 16 * pg + i] = rc[i];
                if (pd < 64) DEC[pg * DK + pd] = __expf(16.0f * lgam);
            }
        }
        if constexpr (RET) {
            if (8 * rg2 < nt) {
                const int tb = tau0 + 8 * rg2; const int tfirst = d ? (LSEQ - 1 - tb) : tb;
                const float ang = (float)tfirst * invf; float cs = cosf(ang), sn = sinf(ang);
#pragma unroll
                for (int j = 0; j < 8; ++j) { const int tl = 8 * rg2 + j, il = tl & 15; const float x1 = bf2f(ra[j]), x2 = bf2f(rb[j]);
                    const float o1 = x1 * cs - x2 * sn, o2 = x1 * sn + x2 * cs;
                    if (!risk) { const float sc_ = __expf((float)(il + 1) * lgam); QT[tl * QS + ri] = f2bf(o1 * sc_); QT[tl * QS + ri + 32] = f2bf(o2 * sc_); }
                    else { const float s1 = 0.125f * __expf(-(float)(il + 1) * lgam), s2 = 0.125f * __expf((float)(15 - il) * lgam);
                        KT[tl * QS + ri] = f2bf(o1 * s1); KT[tl * QS + ri + 32] = f2bf(o2 * s1); KBT[ri * TS + tl] = f2bf(o1 * s2); KBT[(ri + 32) * TS + tl] = f2bf(o2 * s2); }
                    const float cn = cs * cth - sn * sth; sn = sn * cth + cs * sth; cs = cn; }
            }
        }
        if (sc + 1 < 33) prefetch(sc + 1);
        __syncthreads();
#pragma unroll 2
        for (int g = 0; g < nsub; ++g) {
            const int r0 = 16 * g;
            f32x4 aacc = (f32x4){0.f, 0.f, 0.f, 0.f};
#pragma unroll
            for (int ks = 0; ks < NKS; ++ks) { const bf16x8 X = *(const LAS bf16x8*)(KT + (r0 + fr) * QS + 32 * ks + 8 * fq), Y = *(const LAS bf16x8*)(QT + (r0 + fr) * QS + 32 * ks + 8 * fq); aacc = mfma16(X, Y, aacc); }
#pragma unroll
            for (int e = 0; e < 4; ++e) aacc[e] = (4 * fq + e <= fr) ? aacc[e] : 0.f;
            u32x4 ya; ya.x = pk2(aacc[0], aacc[1]); ya.y = pk2(aacc[2], aacc[3]); ya.z = 0u; ya.w = 0u;
            const u32x2 vv = *(const LAS u32x2*)(VT + (16 * w + fr) * TS + r0 + 4 * fq);
            u32x4 xv; xv.x = vv.x; xv.y = vv.y; xv.z = 0u; xv.w = 0u;
            f32x4 o = (f32x4){0.f, 0.f, 0.f, 0.f};
            o = mfma16(__builtin_bit_cast(bf16x8, xv), __builtin_bit_cast(bf16x8, ya), o);
#pragma unroll
            for (int ks = 0; ks < NKS; ++ks) { u32x4 xs; xs.x = pk2(Sacc[2 * ks][0], Sacc[2 * ks][1]); xs.y = pk2(Sacc[2 * ks][2], Sacc[2 * ks][3]); xs.z = pk2(Sacc[2 * ks + 1][0], Sacc[2 * ks + 1][1]); xs.w = pk2(Sacc[2 * ks + 1][2], Sacc[2 * ks + 1][3]);
                const u32x2 q0 = *(const LAS u32x2*)(QT + (r0 + fr) * QS + 32 * ks + 4 * fq), q1 = *(const LAS u32x2*)(QT + (r0 + fr) * QS + 32 * ks + 16 + 4 * fq);
                u32x4 yq; yq.x = q0.x; yq.y = q0.y; yq.z = q1.x; yq.w = q1.y;
                o = mfma16(__builtin_bit_cast(bf16x8, xs), __builtin_bit_cast(bf16x8, yq), o); }
            { const int tau = tau0 + r0 + fr, t = d ? (LSEQ - 1 - tau) : tau; u32x2 ov; ov.x = pk2(o[0], o[1]); ov.y = pk2(o[2], o[3]);
              *(u32x2*)(oout + (rowbase + t) * ldy + ocol + 16 * w + 4 * fq) = ov; }
#pragma unroll
            for (int dt = 0; dt < NDT; ++dt) { const f32x4 dc = *(const LAS f32x4*)(DEC + g * DK + 16 * dt + 4 * fq);
                const u32x2 kb = *(const LAS u32x2*)(KBT + (16 * dt + fr) * TS + r0 + 4 * fq); u32x4 xk; xk.x = kb.x; xk.y = kb.y; xk.z = 0u; xk.w = 0u;
                Sacc[dt] = mfma16(__builtin_bit_cast(bf16x8, xk), __builtin_bit_cast(bf16x8, xv), Sacc[dt] * dc); }
        }
        __syncthreads();
    }
}
__device__ __forceinline__ void phase_scan2(const Frame& F0, int li) {
    Frame F = F0; { size_t z_ = 0; asm volatile("" : "+v"(F.tid), "+v"(F.lane), "+s"(z_), "+s"(F.bid), "+s"(F.G), "+s"(F.wave)); F.ws = F0.ws + z_; F.out = F0.out + z_; }
    for (int task = F.bid; task < 768; task += F.G) {
        const int k = task % 384, s = k >> 3, hd = (k >> 1) & 3, d = k & 1;
                if (task < 384) gla_task<128>(F, li, s, hd, d); else gla_task<64>(F, li, s, hd, d);
    }
}
__device__ __forceinline__ void phase_post2(const Frame& F0, int li) {
    Frame F = F0; { size_t z_ = 0; asm volatile("" : "+v"(F.tid), "+v"(F.lane), "+s"(z_), "+s"(F.bid), "+s"(F.G), "+s"(F.wave)); F.ws = F0.ws + z_; F.out = F0.out + z_; }
    const int lane = F.lane; bf16_t* BR = F.br(); const bf16_t* BRX = F.brx();
    { unsigned* hist = (unsigned*)(F.ws + WS_HIST); for (int i = F.bid * NTHREADS + F.tid; i < 32 * 1024; i += F.G * NTHREADS) hist[i] = 0u; }
    const float* ng = F.in[I_HNG] + (size_t)li * 512 + 8 * lane;
    float g8[8];
#pragma unroll
    for (int i = 0; i < 8; ++i) g8[i] = ng[i];
    const int gw = F.bid * NWAVES + F.wave, nw = F.G * NWAVES;
    for (int row0 = gw; row0 < NTOK; row0 += 4 * nw) {
        u32x4 A[4][2], B[4][2];
#pragma unroll
        for (int j = 0; j < 4; ++j) { const int row = row0 + j * nw; if (row < NTOK) {
#pragma unroll
            for (int sec = 0; sec < 2; ++sec) { A[j][sec] = __builtin_nontemporal_load((const u32x4*)(BR + (size_t)row * 2048 + 1024 + 512 * sec + 8 * lane)); B[j][sec] = __builtin_nontemporal_load((const u32x4*)(BRX + (size_t)row * 1024 + 512 * sec + 8 * lane)); } } }
#pragma unroll
        for (int j = 0; j < 4; ++j) { const int row = row0 + j * nw; if (row < NTOK) {
#pragma unroll
            for (int sec = 0; sec < 2; ++sec) {
                const unsigned aw[4] = {A[j][sec].x, A[j][sec].y, A[j][sec].z, A[j][sec].w}, bw[4] = {B[j][sec].x, B[j][sec].y, B[j][sec].z, B[j][sec].w}; float o[8];
#pragma unroll
                for (int i = 0; i < 4; ++i) { o[2 * i] = bf2f((bf16_t)(aw[i] & 0xffffu)) + bf2f((bf16_t)(bw[i] & 0xffffu)); o[2 * i + 1] = bf2f((bf16_t)(aw[i] >> 16)) + bf2f((bf16_t)(bw[i] >> 16)); }
                float sm = 0.f;
                if (sec == 1) {
#pragma unroll
                    for (int i = 0; i < 8; ++i) sm += o[i];
                    sm += dppx(sm, 0); sm += dppx(sm, 1); sm += dppx(sm, 2); sm += dppx(sm, 3);
                    sm *= (1.0f / 128.0f); }
                float q = 0.f;
#pragma unroll
                for (int i = 0; i < 8; ++i) { o[i] -= sm; q += o[i] * o[i]; }
                q += dppx(q, 0); q += dppx(q, 1); q += dppx(q, 2); q += dppx(q, 3);
                const float rs = rsqrtf(q * (1.0f / 128.0f) + 1e-6f);
#pragma unroll
                for (int i = 0; i < 8; ++i) o[i] = o[i] * rs * (sec == 0 ? g8[i] : 1.0f);
                u32x4 wv; wv.x = pk2(o[0], o[1]); wv.y = pk2(o[2], o[3]); wv.z = pk2(o[4], o[5]); wv.w = pk2(o[6], o[7]);
                *(u32x4*)(BR + (size_t)row * 2048 + 1024 + 512 * sec + 8 * lane) = wv; } } }
    }
}

constexpr int NPL = 17, NPHASE = 1 + NLAYER * NPL;
__global__ void __launch_bounds__(NTHREADS, 2) mega(Args args) {
    extern __shared__ __attribute__((aligned(16))) unsigned char lds_raw[];
    Frame F; F.in = args.in; F.out = args.out; F.ws = args.ws; F.lds = (LAS unsigned char*)lds_raw; F.ldsg = lds_raw;
    F.tid = threadIdx.x; F.lane = F.tid & 63; F.wave = __builtin_amdgcn_readfirstlane(F.tid >> 6); F.G = gridDim.x; F.bid = blockIdx.x;
    const int lo = args.ph_lo, hi = args.ph_hi;
    const bool single = (hi - lo) > 1;
    volatile LAS unsigned* misc = (volatile LAS unsigned*)(F.lds + LDS_MISC);
    if (F.tid < 8) misc[F.tid] = 0u;
    __syncthreads();
    XcdBarrier bar; bar.bar = (unsigned*)(F.ws + WS_CTL) + CW_BAR; bar.x = 0; bar.st = misc;
    if (single) bar = xcd_barrier_post((unsigned*)(F.ws + WS_CTL) + CW_BAR, misc);
#ifndef PH_MASK
#define PH_MASK 0xFFFFFFu
#endif
#define PHON(o) (((PH_MASK) >> (o)) & 1u)
#ifndef DUP_MASK
#define DUP_MASK 0u
#endif
#define DUPN(o) (1 + (int)(((DUP_MASK) >> (o)) & 1u))
#define IN(k) (lo <= (k) && (k) < hi)
#define SEAM(k) do { if (IN(k) && IN((k) + 1)) xcd_barrier(bar); } while (0)
    LAS unsigned char* glds = F.lds;
    if (PHON(20) && IN(0)) { phase_prep_weights(F); phase_embed(F); }
    SEAM(0);
    if (single) {
        if (F.tid == 0) { unsigned ok = ((F.G & 7) == 0) ? 1u : 0u;
            for (int j = 0; j < 16; ++j) { const unsigned cj = xb_ld(bar.bar + XB_XCNT(j)); if (j < 8 ? (cj != (unsigned)F.G / 8u) : (cj != 0u)) ok = 0u; }
            const unsigned r = misc[2]; misc[3] = (ok && bar.x < 8u && r < (unsigned)F.G / 8u) ? (r * 8u + bar.x) : (unsigned)F.bid; }
        __syncthreads();
        F.bid = __builtin_amdgcn_readfirstlane((int)misc[3]);
    }
    for (int li = 0; li < NLAYER; ++li) {
        const int pb = 1 + li * NPL;
        for (int rep = 0; rep < DUPN(0); ++rep) if (PHON(0) && IN(pb + 0)) { Frame Fq = F; { size_t z_ = 0; asm volatile("" : "+s"(z_), "+s"(Fq.bid), "+s"(Fq.G)); Fq.ws = F.ws + z_; Fq.out = F.out + z_; } const Frame& F = Fq;
            SchedPlain S; S.T.init(NTILE_M, N1 / 256, F.G, F.bid); S.A = (const char*)F.hbuf(); S.B = (const char*)(F.ws + WS_W1T + (size_t)li * N1 * D * 2); S.astep = (size_t)256 * D * 2; S.bstep = (size_t)256 * D * 2;
            EpiStoreBf16 E; E.O0 = E.O1 = E.O2 = E.O3 = F.ubuf(); E.ldo = N1;
            pg8::gemm_phase<EpiStoreBf16, SchedPlain, false>(glds, D, D, D, S, E); }
        SEAM(pb + 0);
        for (int rep = 0; rep < DUPN(1); ++rep) if (PHON(1) && IN(pb + 1)) phase_scan1(F, li);
        SEAM(pb + 1);
        if (PHON(2) && IN(pb + 2)) phase_post1(F, li);
        SEAM(pb + 2);
        for (int rep = 0; rep < DUPN(3); ++rep) if (PHON(3) && IN(pb + 3)) { Frame Fq = F; { size_t z_ = 0; asm volatile("" : "+s"(z_), "+s"(Fq.bid), "+s"(Fq.G)); Fq.ws = F.ws + z_; Fq.out = F.out + z_; } const Frame& F = Fq;
            SchedPlain S; S.T.init(NTILE_M, N2 / 256, F.G, F.bid); S.A = (const char*)F.hbuf(); S.B = (const char*)(F.ws + WS_W2T + (size_t)li * N2 * D * 2); S.astep = (size_t)256 * D * 2; S.bstep = (size_t)256 * D * 2;
            EpiStoreBf16 E; E.O0 = E.O1 = E.O2 = E.O3 = F.ubuf(); E.ldo = N2;
            pg8::gemm_phase<EpiStoreBf16, SchedPlain, false>(glds, D, D, D, S, E); }
        SEAM(pb + 3);
        for (int rep = 0; rep < DUPN(4); ++rep) if (PHON(4) && IN(pb + 4)) phase_scan2(F, li);
        SEAM(pb + 4);
        if (PHON(5) && IN(pb + 5)) phase_post2(F, li);
        SEAM(pb + 5);
        if (PHON(6) && IN(pb + 6)) { Frame Fq = F; { size_t z_ = 0; asm volatile("" : "+s"(z_), "+s"(Fq.bid), "+s"(Fq.G)); Fq.ws = F.ws + z_; Fq.out = F.out + z_; } const Frame& F = Fq;
            SchedPlain S; S.T.init(NTILE_M, NG / 256, F.G, F.bid); S.A = (const char*)F.hbuf(); S.B = (const char*)(F.ws + WS_WGT + (size_t)li * NG * D * 2); S.astep = (size_t)256 * D * 2; S.bstep = (size_t)256 * D * 2;
            EpiGate E; E.BR = F.br();
            pg8::gemm_phase<EpiGate, SchedPlain, false>(glds, D, D, D, S, E); }
        SEAM(pb + 6);
        for (int rep = 0; rep < DUPN(7); ++rep) if (PHON(7) && IN(pb + 7)) { Frame Fq = F; { size_t z_ = 0; asm volatile("" : "+s"(z_), "+s"(Fq.bid), "+s"(Fq.G)); Fq.ws = F.ws + z_; Fq.out = F.out + z_; } const Frame& F = Fq;
            SchedP S; S.T.init(NTILE_M, 16, F.G, F.bid); S.A = (const char*)F.br(); S.B = (const char*)(F.ws + WS_WBT + (size_t)li * 4 * D * 512 * 2);
            EpiStoreBf16 E; E.O0 = F.pb(0); E.O1 = F.pb(1); E.O2 = F.pb(2); E.O3 = F.pb(3); E.ldo = D;
            pg8::gemm_phase<EpiStoreBf16, SchedP, false>(glds, 512, 2048, 512, S, E); }
        SEAM(pb + 7);
        for (int rep = 0; rep < DUPN(8); ++rep) if (PHON(8) && IN(pb + 8)) { Frame Fq = F; { size_t z_ = 0; asm volatile("" : "+s"(z_), "+s"(Fq.bid), "+s"(Fq.G)); Fq.ws = F.ws + z_; Fq.out = F.out + z_; } const Frame& F = Fq;
            SchedPlain S; S.T.init(NTILE_M, NM / 256, F.G, F.bid); S.A = (const char*)F.out + OUT_HIN8; S.B = (const char*)(F.ws + WS_WMT + (size_t)li * NM * D); S.astep = (size_t)256 * D; S.bstep = (size_t)256 * D;
            EpiMerge E; E.PB0 = F.pb(0); E.PB1 = F.pb(1); E.PB2 = F.pb(2); E.PB3 = F.pb(3); E.MG = (bf16_t*)(F.ws + R_MERGED);
            pg8::gemm_phase<EpiMerge, SchedPlain, false, true>(glds, D / 2, D / 2, D / 2, S, E); }
        SEAM(pb + 8);
        if (PHON(9) && IN(pb + 9) && ((F.bid & 1) == 0)) phase_prep_experts(F, li);
        for (int rep = 0; rep < DUPN(9); ++rep) if (PHON(9) && IN(pb + 9)) { Frame Fq = F; { size_t z_ = 0; asm volatile("" : "+s"(z_), "+s"(Fq.bid), "+s"(Fq.G)); Fq.ws = F.ws + z_; Fq.out = F.out + z_; } const Frame& F = Fq;
            SchedPlain S; S.T.init(NTILE_M, D / 256, F.G, F.bid); S.A = (const char*)(F.ws + R_MERGED); S.B = (const char*)(F.ws + WS_WOT + (size_t)li * D * D * 2); S.astep = (size_t)256 * D * 2; S.bstep = (size_t)256 * D * 2;
            EpiOut E; E.H = F.hbuf(); E.X1 = (bf16_t*)(F.ws + R_X1);
            pg8::gemm_phase<EpiOut, SchedPlain, false>(glds, D, D, D, S, E); }
        if (PHON(9) && IN(pb + 9) && ((F.bid & 1) == 1)) phase_prep_experts(F, li);
        SEAM(pb + 9);
        if (PHON(10) && IN(pb + 10)) phase_ln1_router(F, li);
        SEAM(pb + 10);
        for (int p = 1; p < 4; ++p) { if (PHON(11) && IN(pb + 10 + p)) phase_topk(F, p); SEAM(pb + 10 + p); }
        for (int rnd = 0; rnd < 1; ++rnd) {
            for (int rep = 0; rep < DUPN(15); ++rep) if (PHON(15) && IN(pb + 14 + 2 * rnd)) { Frame Fq = F; { size_t z_ = 0; asm volatile("" : "+s"(z_), "+s"(Fq.bid), "+s"(Fq.G)); Fq.ws = F.ws + z_; Fq.out = F.out + z_; } const Frame& F = Fq;
                SchedE1 S; S.T.init(NE * ETILES, 16, F.G, F.bid); S.A = (const char*)(F.ws + R_H8); S.B = (const char*)F.out; S.stok = (const int*)(F.ws + WS_STOK); S.e0 = 0;
                EpiSwiglu E; E.HE = (unsigned char*)(F.ws + R_HE);
                pg8::gemm_phase<EpiSwiglu, SchedE1, true, true>(glds, D / 2, D / 2, D / 2, S, E); }
            SEAM(pb + 14 + 2 * rnd);
            for (int rep = 0; rep < DUPN(16); ++rep) if (PHON(16) && IN(pb + 15 + 2 * rnd)) { Frame Fq = F; { size_t z_ = 0; asm volatile("" : "+s"(z_), "+s"(Fq.bid), "+s"(Fq.G)); Fq.ws = F.ws + z_; Fq.out = F.out + z_; } const Frame& F = Fq;
                SchedE2 S; S.T.init(NE * ETILES, 4, F.G, F.bid); S.A = (const char*)(F.ws + R_HE); S.B = (const char*)F.out + (size_t)NE * 4096 * D; S.e0 = 0;
                EpiScale E; E.YE = (bf16_t*)(F.ws + R_YE); E.SG = (const float*)(F.ws + WS_SGATE);
                pg8::gemm_phase<EpiScale, SchedE2, false, true>(glds, DFF / 2, DFF / 2, DFF / 2, S, E); }
            SEAM(pb + 15 + 2 * rnd);
        }
        if (PHON(19) && IN(pb + 16)) phase_combine(F, li);
        SEAM(pb + 16);
    }
}

#ifndef MK_SINGLE
#define MK_SINGLE 1
#endif
extern "C" void kernel_launch(void* const* d_in, const int* in_sizes, int n_in, void* d_out, int out_size, void* d_ws, size_t ws_size, hipStream_t stream) {
    static int grid = 0;
    if (grid == 0) {
        if (n_in != 37 || in_sizes[0] != NSEQ0 * SEQ * D || out_size != NSEQ * SEQ * D || ws_size < WS_END) {
            fprintf(stderr, "kernel_launch: unexpected shapes: n_in %d in0 %d out %d ws %zu (need %zu); nothing launched\n", n_in, n_in > 0 ? in_sizes[0] : -1, out_size, ws_size, (size_t)WS_END); grid = -1; return; }
        int dev = 0, cus = 0, per_cu = 0;
        if (hipGetDevice(&dev) != hipSuccess || hipDeviceGetAttribute(&cus, hipDeviceAttributeMultiprocessorCount, dev) != hipSuccess) { grid = -1; return; }
        if (hipFuncSetAttribute((const void*)mega, hipFuncAttributeMaxDynamicSharedMemorySize, LDS_BYTES) != hipSuccess) { fprintf(stderr, "kernel_launch: hipFuncSetAttribute failed\n"); grid = -1; return; }
        if (hipOccupancyMaxActiveBlocksPerMultiprocessor(&per_cu, (const void*)mega, NTHREADS, LDS_BYTES) != hipSuccess || per_cu < 1) fprintf(stderr, "kernel_launch: occupancy query reports %d\n", per_cu);
        (void)hipGetLastError();
        grid = cus;
    }
    if (grid < 0) return;
    if (hipMemsetAsync((char*)d_ws + WS_CTL, 0, CTL_BYTES, stream) != hipSuccess) return;
    Args a{};
    for (int i = 0; i < 37; ++i) a.in[i] = (const float*)d_in[i];
    a.out = (float*)d_out; a.ws = (unsigned char*)d_ws;
#if MK_SINGLE
    a.ph_lo = 0; a.ph_hi = NPHASE;
    hipLaunchKernelGGL(mega, dim3(grid), dim3(NTHREADS), LDS_BYTES, stream, a);
#else
    for (int p = 0; p < NPHASE; ++p) { a.ph_lo = p; a.ph_hi = p + 1; hipLaunchKernelGGL(mega, dim3(grid), dim3(NTHREADS), LDS_BYTES, stream, a); }
#endif
}
```

```cpp
#include <hip/hip_runtime.h>
#include <cstdio>
#include <cstdint>
#include <cstddef>

#define LAS __attribute__((address_space(3)))
typedef unsigned short bf16_t;
typedef short bf16x8 __attribute__((ext_vector_type(8)));
typedef float f32x4 __attribute__((ext_vector_type(4)));
typedef float f32x2 __attribute__((ext_vector_type(2)));
typedef unsigned u32x4 __attribute__((ext_vector_type(4)));
typedef unsigned u32x2 __attribute__((ext_vector_type(2)));

constexpr int D = 1024, LSEQ = 2064, NSEQ = 48, NTOK = NSEQ * LSEQ, NMETA = 16, SEQ = 2048, NSEQ0 = 32, TOK0 = NSEQ0 * LSEQ;
constexpr int N_IN = 11136, NLAYER = 2;
constexpr int N1 = 2560, N2 = 3072, NG = 1536, NM = 4096;
constexpr int NE = 16, DFF = 2048, CAP0 = 8256, CAP1 = 4128, EVALID = CAP0 + CAP1, EROWS = 12544, ETILES = EROWS / 256;
constexpr int NTILE_M = NTOK / 256;
static_assert(NTOK % 256 == 0, "token tiling");
constexpr float ALPHA = 1.41421356237f;
constexpr int NTHREADS = 512, NWAVES = 8;
constexpr int LDS_BYTES = 147456;
constexpr int LDS_MISC = LDS_BYTES - 64;

constexpr int U1_AX = 0, U1_R = 512, U1_K = 1024, U1_V = 1536, U1_WDN = 2048, U1_ADN = 2176, U1_GDN = 2304;
constexpr int U2_CQ = 0, U2_CF = 512, U2_CI = 1536, U2_DQ = 2048, U2_DK = 2304, U2_DV = 2560;

constexpr size_t al256(size_t x) { return (x + 255) & ~(size_t)255; }
constexpr size_t WS_CTL = 0, CTL_BYTES = 65536;
constexpr size_t WS_AFF = WS_CTL + CTL_BYTES;
constexpr size_t WS_INV = WS_AFF + al256((size_t)NTOK * 16 * 4);
constexpr size_t WS_STOK = WS_INV + al256((size_t)NTOK * 16 * 4);
constexpr size_t WS_SGATE = WS_STOK + al256((size_t)NE * EROWS * 4);
constexpr size_t WS_HIST = WS_SGATE + al256((size_t)NE * EROWS * 4);
constexpr size_t WS_BON = WS_HIST + al256((size_t)3 * 32 * 1024 * 4);
constexpr size_t WS_G2T = WS_BON + al256((size_t)NTOK * 16 * 4);
constexpr size_t WS_LB = WS_G2T + al256((size_t)2 * 512 * 128 * 2);
constexpr size_t WS_RW2T = WS_LB + al256((size_t)2 * 512 * 4);
constexpr size_t WS_LRUT = WS_RW2T + al256((size_t)2 * 2 * 2 * 512 * 64 * 2);
constexpr size_t WS_HBUF = WS_LRUT + al256((size_t)2 * 2 * 2 * 8 * 64 * 64 * 2);
constexpr size_t WS_W1T = WS_HBUF + al256((size_t)NTOK * D * 2);
constexpr size_t WS_W2T = WS_W1T + al256((size_t)2 * N1 * D * 2);
constexpr size_t WS_WGT = WS_W2T + al256((size_t)2 * N2 * D * 2);
constexpr size_t WS_WMT = WS_WGT + al256((size_t)2 * NG * D * 2);
constexpr size_t WS_WBT = WS_WMT + al256((size_t)2 * NM * D * 2);
constexpr size_t WS_WOT = WS_WBT + al256((size_t)2 * 4 * D * 512 * 2);
constexpr size_t WS_R = WS_WOT + al256((size_t)2 * D * D * 2);
constexpr size_t SZ_TD2 = (size_t)NTOK * D * 2;
constexpr size_t R_BR = WS_R;
constexpr size_t R_U = WS_R + 2 * SZ_TD2;
constexpr size_t R_PB = R_U;
constexpr size_t R_MERGED = WS_R;
constexpr size_t R_H8 = WS_R;
constexpr size_t OUT_HIN8 = SZ_TD2;
constexpr size_t OUT_W13 = OUT_HIN8 + (size_t)NTOK * D;
constexpr size_t OUT_W2 = (size_t)NE * 4096 * D;
static_assert(OUT_W13 + (size_t)NE * 4096 * D <= (size_t)NSEQ * SEQ * D * 4, "W13t must fit in d_out");
constexpr float WM_SCALE = 32.0f;
constexpr float W13_SCALE = 32.0f, W2_SCALE = 64.0f;
constexpr size_t R_X1 = R_U;
constexpr size_t R_WEXP = WS_R;
constexpr size_t SZ_W13 = (size_t)NE * 4096 * D * 2, SZ_W2E = (size_t)NE * D * DFF * 2;
constexpr size_t R_YE = R_WEXP + SZ_W13 + SZ_W2E;
constexpr size_t SZ_YE = (size_t)NE * EROWS * D * 2;
constexpr size_t R_HE = R_YE + SZ_YE;
constexpr size_t SZ_HE = (size_t)8 * EROWS * DFF * 2;
constexpr size_t WS_END_A = R_U + (size_t)NTOK * N2 * 2;
constexpr size_t WS_END_B = R_HE + SZ_HE;
constexpr size_t WS_END = WS_END_A > WS_END_B ? WS_END_A : WS_END_B;

constexpr int CW_BAR = 0;
constexpr int CW_CNT = 4096;
constexpr int CW_TIE = 4160;

__device__ __forceinline__ float bf2f(bf16_t v) { return __uint_as_float(((unsigned)v) << 16); }
typedef __bf16 bf16n2 __attribute__((ext_vector_type(2)));
__device__ __forceinline__ unsigned pk2(float lo, float hi) { const f32x2 v = {lo, hi}; return __builtin_bit_cast(unsigned, __builtin_convertvector(v, bf16n2)); }
__device__ __forceinline__ bf16_t f2bf(float f) { return (bf16_t)(pk2(f, 0.f) & 0xffffu); }
__device__ __forceinline__ unsigned pk4_fp8(float a, float b, float c, float d) { int p = __builtin_amdgcn_cvt_pk_fp8_f32(a, b, 0, false); p = __builtin_amdgcn_cvt_pk_fp8_f32(c, d, p, true); return (unsigned)p; }
__device__ __forceinline__ float sigmoidf_(float x) { return __builtin_amdgcn_rcpf(1.0f + __expf(-x)); }
__device__ __forceinline__ float siluf_(float x) { return x * __builtin_amdgcn_rcpf(1.0f + __expf(-x)); }
__device__ __forceinline__ float gelu_tanh_(float x) { const float u = 1.5957691216f * (x + 0.044715f * x * x * x); return x * __builtin_amdgcn_rcpf(1.0f + __expf(-u)); }
__device__ __forceinline__ float softplusf_(float x) { return fmaxf(x, 0.f) + log1pf(__expf(-fabsf(x))); }
__device__ __forceinline__ float dppx(float v, int sel) {
    const int x = __float_as_int(v); int r;
    if (sel == 0) r = __builtin_amdgcn_update_dpp(0, x, 0xB1, 0xF, 0xF, true);
    else if (sel == 1) r = __builtin_amdgcn_update_dpp(0, x, 0x4E, 0xF, 0xF, true);
    else if (sel == 2) r = __builtin_amdgcn_update_dpp(0, x, 0x141, 0xF, 0xF, true);
    else r = __builtin_amdgcn_update_dpp(0, x, 0x140, 0xF, 0xF, true);
    return __int_as_float(r);
}
typedef unsigned u32x2_pl __attribute__((ext_vector_type(2)));
__device__ __forceinline__ float rows_sum(float v) {
    const unsigned x = __float_as_uint(v);
    const u32x2_pl a = __builtin_amdgcn_permlane16_swap(x, x, false, false);
    const float s = __uint_as_float(a[0]) + __uint_as_float(a[1]);
    const unsigned y = __float_as_uint(s);
    const u32x2_pl b = __builtin_amdgcn_permlane32_swap(y, y, false, false);
    return __uint_as_float(b[0]) + __uint_as_float(b[1]);
}
__device__ __forceinline__ float wave_sum(float v) {
    v += dppx(v, 0); v += dppx(v, 1); v += dppx(v, 2); v += dppx(v, 3);
    return rows_sum(v);
}

#define XB_TMO      128
#define XB_XCNT(j)  (256  + 64 * (j))
#define XB_XSUB(j)  (1280 + 64 * (j))
#define XB_XGEN(j)  (2304 + 64 * (j))
#define XB_TOP      3328
#define XB_TOPGEN   3392
#define XCD_BAR_WORDS 3456
#define XB_SPIN_CAP (1u << 23)
__device__ __forceinline__ unsigned xb_ld(unsigned* p)              { return __hip_atomic_load(p, __ATOMIC_RELAXED, __HIP_MEMORY_SCOPE_AGENT); }
__device__ __forceinline__ unsigned xb_add(unsigned* p, unsigned v) { return __hip_atomic_fetch_add(p, v, __ATOMIC_RELAXED, __HIP_MEMORY_SCOPE_AGENT); }
__device__ __forceinline__ unsigned xb_xcc_id() { return (unsigned)__builtin_amdgcn_s_getreg((3 << 11) | 20) & 0xFu; }
#define XB_SPIN(cond, bar) do { unsigned _sp = 0; while (cond) { __builtin_amdgcn_s_sleep(1); \
    if ((++_sp & 255u) == 0u) { if (xb_ld(&(bar)[XB_TMO])) break; if (_sp > XB_SPIN_CAP) { atomicAdd(&(bar)[XB_TMO], 1u); break; } } } } while (0)
struct XcdBarrier { unsigned* bar; unsigned x; volatile LAS unsigned* st; };
__device__ __forceinline__ XcdBarrier xcd_barrier_post(unsigned* bar, volatile LAS unsigned* st) {
    XcdBarrier b; b.bar = bar; b.x = xb_xcc_id(); b.st = st;
    if (threadIdx.x == 0) st[2] = xb_add(&bar[XB_XCNT(b.x)], 1u);
    return b;
}
__device__ __forceinline__ void xcd_barrier_complete(unsigned* bar, unsigned x, unsigned& nloc, unsigned& nx) {
    const unsigned G = gridDim.x * gridDim.y * gridDim.z;
    unsigned sum, cnt, mine, sp = 0u;
    for (;;) {
        sum = 0u; cnt = 0u; mine = 0u;
#pragma unroll
        for (unsigned j = 0; j < 16; ++j) { const unsigned c = xb_ld(&bar[XB_XCNT(j)]); sum += c; cnt += (c > 0u) ? 1u : 0u; mine = (j == x) ? c : mine; }
        if (sum == G) break;
        __builtin_amdgcn_s_sleep(1);
        if ((++sp & 255u) == 0u) { if (xb_ld(&bar[XB_TMO])) break; if (sp > XB_SPIN_CAP) { atomicAdd(&bar[XB_TMO], 1u); break; } }
    }
    nloc = mine > 0u ? mine : 1u; nx = cnt > 0u ? cnt : 1u;
}
__device__ __forceinline__ void xcd_barrier(const XcdBarrier& b) {
    asm volatile("s_waitcnt vmcnt(0)" ::: "memory");
    __syncthreads();
    if (threadIdx.x == 0) {
        unsigned* bar = b.bar;
        __builtin_amdgcn_s_waitcnt(0);
        unsigned nloc = b.st[0], nx = b.st[1];
        if (nloc == 0u) { xcd_barrier_complete(bar, b.x, nloc, nx); b.st[0] = nloc; b.st[1] = nx; }
        const unsigned old = xb_add(&bar[XB_XSUB(b.x)], 1u);
        const unsigned gen = old / nloc;
        if (old + 1u == (gen + 1u) * nloc) {
            __builtin_amdgcn_fence(__ATOMIC_RELEASE, "agent");
            asm volatile("s_waitcnt vmcnt(0)" ::: "memory");
            const unsigned og = xb_add(&bar[XB_TOP], 1u);
            const unsigned tg = og / nx;
            if (og + 1u == (tg + 1u) * nx) xb_add(&bar[XB_TOPGEN], 1u);
            else XB_SPIN(xb_ld(&bar[XB_TOPGEN]) == tg, bar);
            __builtin_amdgcn_fence(__ATOMIC_ACQUIRE, "agent");
            xb_add(&bar[XB_XGEN(b.x)], 1u);
            asm volatile("s_waitcnt vmcnt(0)" ::: "memory");
        } else {
            XB_SPIN(xb_ld(&bar[XB_XGEN(b.x)]) == gen, bar);
            __builtin_amdgcn_fence(__ATOMIC_ACQUIRE, "agent");
            asm volatile("s_waitcnt vmcnt(0)" ::: "memory");
        }
    }
    __syncthreads();
}

namespace pg8 {
constexpr int BM = 256, BK = 64, HALF = 128, HTB = HALF * BK * 2, STAGE_BYTES = 8 * HTB, NXCD = 8, WGM = 8;
__host__ __device__ __forceinline__ int lds_byte(int r, int c) { const int st = (r >> 4) * 2 + (c >> 5), rr = r & 15, cc = c & 31, ob = rr * 64 + cc * 2; return st * 1024 + (ob ^ (((ob >> 9) & 1) << 5)); }
__host__ __device__ __forceinline__ void stage_rc(int b, int& R, int& C) { const int st = b / 1024, sb = b % 1024, swz = sb ^ (((sb >> 9) & 1) << 5); R = (st >> 1) * 16 + swz / 64; C = (st & 1) * 32 + (swz % 64) / 2; }
__host__ __device__ __forceinline__ int perm32(int rho) { const int n = rho >> 4, i = rho & 15; return 8 * (i >> 2) + 4 * n + (i & 3); }

struct Unit { int pm, pn, aux; const char* A; const char* B; const int* rows; };

struct TileOrder {
    int nM, nN, nwg, G, c;
    __device__ __forceinline__ void init(int nM_, int nN_, int G_, int c_) { nM = nM_; nN = nN_; nwg = nM * nN; G = G_; c = c_; }
    __device__ __forceinline__ bool tile(int i, int& pm, int& pn) const {
        const long L = (long)i * G + c; if (L >= nwg) return false;
        int wgid = (int)L; { const int q = nwg / NXCD, r = nwg % NXCD, xcd = wgid % NXCD, off = wgid / NXCD; wgid = (xcd < r ? xcd * (q + 1) : r * (q + 1) + (xcd - r) * q) + off; }
        const int nig = WGM * nN, gid = wgid / nig, fm = gid * WGM, gsz = (nM - fm) < WGM ? (nM - fm) : WGM;
        pm = fm + ((wgid % nig) % gsz); pn = (wgid % nig) / gsz; return true;
    }
};

typedef int i32x4_ __attribute__((ext_vector_type(4)));
typedef int i32x8_ __attribute__((ext_vector_type(8)));
__device__ __forceinline__ i32x8_ cat8(bf16x8 a, bf16x8 b) { const i32x4_ x = __builtin_bit_cast(i32x4_, a), y = __builtin_bit_cast(i32x4_, b); return __builtin_shufflevector(x, y, 0, 1, 2, 3, 4, 5, 6, 7); }
template <class Epi, class Sched, bool GATHER, bool F8 = false>
__device__ __forceinline__ void gemm_phase(LAS unsigned char* lds, const int K, const int lda, const int ldb, const Sched& S, const Epi& E) {
    int tid = threadIdx.x; asm volatile("" : "+v"(tid));
    const int wid = __builtin_amdgcn_readfirstlane(tid >> 6), lane = tid & 63, wr = wid >> 2, wc = wid & 3, fr = lane & 15, fq = lane >> 4;
    const int nt = K / BK;
    unsigned voffA[2][2], nvA[2][2], voffB[2];
#pragma unroll
    for (int i = 0; i < 2; ++i) { int R, C; stage_rc(tid * 16 + i * 8192, R, C); const int Rb = Epi::PERM ? ((R & ~31) + perm32(R & 31)) : R;
        voffB[i] = (unsigned)(Rb * ldb + C) * 2u;
#pragma unroll
        for (int h = 0; h < 2; ++h) { voffA[h][i] = (unsigned)((R + h * HALF) * lda + C) * 2u; nvA[h][i] = voffA[h][i]; } }
    const size_t kstep = (size_t)(BK * 2);
    const size_t hstepB = (size_t)HALF * ldb * 2;
    const unsigned ldsw = (unsigned)wid * 1024u;
    const int aoff = lds_byte(wr * 64 + fr, fq * 8), boff = lds_byte(wc * 32 + fr, fq * 8);
#define PG8_SA(b, h) (((b) * 2 + (h)) * HTB)
#define PG8_SB(b, h) ((4 + (b) * 2 + (h)) * HTB)
#define PG8_STAGE(bufoff, gbase, voff) do { _Pragma("unroll") for (int _i = 0; _i < 2; ++_i) \
        __builtin_amdgcn_global_load_lds((const unsigned*)((const char*)(gbase) + (voff)[_i]), (LAS unsigned*)(lds + (bufoff) + ldsw + _i * 8192), 16, 0, 0); } while (0)
#define PG8_LDA(dst, b, h) do { _Pragma("unroll") for (int m = 0; m < 4; ++m) { if constexpr (F8) { const i32x4_ lo_ = *(const LAS i32x4_*)(lds + PG8_SA(b, h) + aoff + m * 2048), hi_ = *(const LAS i32x4_*)(lds + PG8_SA(b, h) + aoff + m * 2048 + 1024); \
            dst##8[m] = __builtin_shufflevector(lo_, hi_, 0, 1, 2, 3, 4, 5, 6, 7); } else { _Pragma("unroll") for (int k = 0; k < 2; ++k) dst[m][k] = *(const LAS bf16x8*)(lds + PG8_SA(b, h) + aoff + m * 2048 + k * 1024); } } } while (0)
#define PG8_LDB(dst, b, h) do { _Pragma("unroll") for (int n = 0; n < 2; ++n) { if constexpr (F8) { const i32x4_ lo_ = *(const LAS i32x4_*)(lds + PG8_SB(b, h) + boff + n * 2048), hi_ = *(const LAS i32x4_*)(lds + PG8_SB(b, h) + boff + n * 2048 + 1024); \
            dst##8[n] = __builtin_shufflevector(lo_, hi_, 0, 1, 2, 3, 4, 5, 6, 7); } else { _Pragma("unroll") for (int k = 0; k < 2; ++k) dst[n][k] = *(const LAS bf16x8*)(lds + PG8_SB(b, h) + boff + n * 2048 + k * 1024); } } } while (0)
#define PG8_MMA(ai, bj, At, Bt) do { __builtin_amdgcn_s_setprio(1); _Pragma("unroll") for (int m = 0; m < 4; ++m) _Pragma("unroll") for (int n = 0; n < 2; ++n) { \
        if constexpr (F8) asm volatile("v_mfma_scale_f32_16x16x128_f8f6f4 %0, %1, %2, %0, %3, %3 op_sel_hi:[0,0,0]" : "+v"(acc[ai][bj][m][n]) : "v"(Bt##8[n]), "v"(At##8[m]), "v"(f8scale));   \
        else { _Pragma("unroll") for (int k = 0; k < 2; ++k) acc[ai][bj][m][n] = __builtin_amdgcn_mfma_f32_16x16x32_bf16(Bt[n][k], At[m][k], acc[ai][bj][m][n], 0, 0, 0); } } \
        __builtin_amdgcn_s_setprio(0); } while (0)
#define PG8_WAIT_V(n) asm volatile("s_waitcnt vmcnt(" #n ")" ::: "memory")
#define PG8_WAIT_L(n) asm volatile("s_waitcnt lgkmcnt(" #n ")" ::: "memory")
#define PG8_BAR __builtin_amdgcn_s_barrier()
#define PG8_SCHED __builtin_amdgcn_sched_barrier(0)
#define PG8_GATHER(dst, u) do { if constexpr (GATHER) { _Pragma("unroll") for (int _i = 0; _i < 2; ++_i) { int _R, _C; stage_rc(tid * 16 + _i * 8192, _R, _C); _Pragma("unroll") for (int _h = 0; _h < 2; ++_h) \
        dst[_h][_i] = ((unsigned)(u).rows[_R + _h * HALF] * (unsigned)lda + (unsigned)_C) * 2u; } } } while (0)
    Unit cur, nxt; int ui = 0;
    if (!S.next(0, cur)) return;
    f32x4 acc[2][2][4][2];
#pragma unroll
    for (int a = 0; a < 2; ++a)
#pragma unroll
        for (int b = 0; b < 2; ++b)
#pragma unroll
            for (int m = 0; m < 4; ++m)
#pragma unroll
                for (int n = 0; n < 2; ++n) acc[a][b][m][n] = (f32x4){0.f, 0.f, 0.f, 0.f};
    bf16x8 At[4][2], B0[2][2], B1[2][2];
    const int f8scale = 0x7f7f7f7f;
    i32x8_ At8[4], B08[2], B18[2];
    const char* cA = cur.A; const char* cB = cur.B;
    PG8_GATHER(voffA, cur);
    PG8_STAGE(PG8_SB(0, 0), cB, voffB); PG8_STAGE(PG8_SA(0, 0), cA, voffA[0]); PG8_STAGE(PG8_SB(0, 1), cB + hstepB, voffB); PG8_STAGE(PG8_SA(0, 1), cA, voffA[1]);
    if (wr == 1) PG8_BAR;
    PG8_WAIT_V(4); PG8_BAR;
    PG8_STAGE(PG8_SB(1, 0), cB + kstep, voffB); PG8_STAGE(PG8_SA(1, 0), cA + kstep, voffA[0]); PG8_STAGE(PG8_SB(1, 1), cB + hstepB + kstep, voffB);
    PG8_WAIT_V(6); PG8_BAR;
    for (;;) {
        const bool has_next = S.next(ui + 1, nxt);
        const char* nA = has_next ? nxt.A : cA; const char* nB = has_next ? nxt.B : cB;
        if constexpr (GATHER) { if (has_next) { PG8_GATHER(nvA, nxt); } else {
#pragma unroll
            for (int h = 0; h < 2; ++h)
#pragma unroll
                for (int i = 0; i < 2; ++i) nvA[h][i] = voffA[h][i]; } }
        for (int t = 0; t < nt; t += 2) {
            const bool last = (t == nt - 2);
            const char* a1 = cA + (size_t)(t + 1) * kstep;
            const char* a2 = last ? nA : cA + (size_t)(t + 2) * kstep; const char* b2 = last ? nB : cB + (size_t)(t + 2) * kstep;
            const char* a3 = a2 + kstep; const char* b3 = b2 + kstep;
            unsigned vA0[2], vA1[2];
            if constexpr (GATHER) { vA0[0] = last ? nvA[0][0] : voffA[0][0]; vA0[1] = last ? nvA[0][1] : voffA[0][1]; vA1[0] = last ? nvA[1][0] : voffA[1][0]; vA1[1] = last ? nvA[1][1] : voffA[1][1]; }
            else { vA0[0] = voffA[0][0]; vA0[1] = voffA[0][1]; vA1[0] = voffA[1][0]; vA1[1] = voffA[1][1]; }
            PG8_LDB(B0, 0, 0); PG8_SCHED; PG8_LDA(At, 0, 0); PG8_STAGE(PG8_SA(1, 1), a1, voffA[1]);
            PG8_WAIT_L(8); PG8_BAR; PG8_WAIT_L(0); PG8_MMA(0, 0, At, B0); PG8_BAR; PG8_SCHED;
            PG8_LDB(B1, 0, 1); PG8_STAGE(PG8_SB(0, 0), b2, voffB);
            PG8_BAR; PG8_WAIT_L(0); PG8_MMA(0, 1, At, B1); PG8_BAR;
            PG8_LDA(At, 0, 1); PG8_STAGE(PG8_SA(0, 0), a2, vA0);
            PG8_BAR; PG8_WAIT_L(0); PG8_MMA(1, 0, At, B0); PG8_BAR; PG8_SCHED;
            PG8_STAGE(PG8_SB(0, 1), b2 + hstepB, voffB);
            PG8_WAIT_V(6); PG8_BAR; PG8_MMA(1, 1, At, B1); PG8_BAR;
            PG8_LDB(B0, 1, 0); PG8_SCHED; PG8_LDA(At, 1, 0); PG8_STAGE(PG8_SA(0, 1), a2, vA1);
            PG8_WAIT_L(8); PG8_BAR; PG8_WAIT_L(0); PG8_MMA(0, 0, At, B0); PG8_BAR; PG8_SCHED;
            PG8_LDB(B1, 1, 1); PG8_STAGE(PG8_SB(1, 0), b3, voffB);
            PG8_BAR; PG8_WAIT_L(0); PG8_MMA(0, 1, At, B1); PG8_BAR;
            PG8_LDA(At, 1, 1); PG8_STAGE(PG8_SA(1, 0), a3, vA0);
            PG8_BAR; PG8_WAIT_L(0); PG8_MMA(1, 0, At, B0); PG8_BAR; PG8_SCHED;
            PG8_STAGE(PG8_SB(1, 1), b3 + hstepB, voffB);
            PG8_WAIT_V(6); PG8_BAR; PG8_MMA(1, 1, At, B1); PG8_BAR;
        }
        if constexpr (F8) asm volatile("s_nop 15\n\ts_nop 7" ::: "memory");
        { int fr_e = fr, fq_e = fq; asm volatile("" : "+v"(fr_e), "+v"(fq_e));
          E(acc, cur, wr, wc, fr_e, fq_e); }
        if (!has_next) break;
#pragma unroll
        for (int a = 0; a < 2; ++a)
#pragma unroll
            for (int b = 0; b < 2; ++b)
#pragma unroll
                for (int m = 0; m < 4; ++m)
#pragma unroll
                    for (int n = 0; n < 2; ++n) acc[a][b][m][n] = (f32x4){0.f, 0.f, 0.f, 0.f};
        cur = nxt; cA = nA; cB = nB; ++ui;
        if constexpr (GATHER) {
#pragma unroll
            for (int h = 0; h < 2; ++h)
#pragma unroll
                for (int i = 0; i < 2; ++i) voffA[h][i] = nvA[h][i]; }
    }
    PG8_WAIT_V(0);
    if (wr == 0) PG8_BAR;
    PG8_BAR;
#undef PG8_SA
#undef PG8_SB
#undef PG8_STAGE
#undef PG8_LDA
#undef PG8_LDB
#undef PG8_MMA
#undef PG8_WAIT_V
#undef PG8_WAIT_L
#undef PG8_BAR
#undef PG8_SCHED
#undef PG8_GATHER
}
}
using pg8::Unit;

struct Args { const float* in[37]; float* out; unsigned char* ws; int ph_lo, ph_hi; };
enum { I_XP = 0, I_XS, I_META, I_LNEG, I_LNEB, I_HLB, I_WIN, I_CONVW, I_CONVB, I_WR, I_BR, I_WI, I_BI, I_LAM, I_MU, I_W0, I_W2, I_A0, I_A2, I_G2, I_KK, I_KA, I_RK,
       I_LNXG, I_LNXB, I_HNG, I_RDEC, I_WBR, I_WOUT, I_LN1G, I_LN1B, I_ROUTER, I_EW1, I_EW3, I_EW2, I_LN2G, I_LN2B };
struct Frame {
    const float* const* in; float* out; unsigned char* ws; LAS unsigned char* lds; unsigned char* ldsg;
    int tid, lane, wave, G, bid;
    __device__ __forceinline__ bf16_t* hbuf() const { return (bf16_t*)(ws + WS_HBUF); }
    __device__ __forceinline__ bf16_t* br() const { return (bf16_t*)(ws + R_BR); }
    __device__ __forceinline__ bf16_t* brx() const { return (bf16_t*)out; }
    __device__ __forceinline__ bf16_t* ubuf() const { return (bf16_t*)(ws + R_U); }
    __device__ __forceinline__ bf16_t* pb(int n) const { return n < 3 ? (bf16_t*)(ws + R_PB + (size_t)n * SZ_TD2) : (bf16_t*)out; }
};

struct SchedPlain {
    pg8::TileOrder T; const char* A; const char* B; size_t astep, bstep;
    __device__ __forceinline__ bool next(int i, Unit& u) const { int pm, pn; if (!T.tile(i, pm, pn)) return false; u.pm = pm; u.pn = pn; u.aux = 0; u.A = A + (size_t)pm * astep; u.B = B + (size_t)pn * bstep; u.rows = nullptr; return true; }
};
struct SchedP {
    pg8::TileOrder T; const char* A; const char* B;
    __device__ __forceinline__ bool next(int i, Unit& u) const { int pm, pn; if (!T.tile(i, pm, pn)) return false; const int nb = pn >> 2, pl = pn & 3; u.pm = pm; u.pn = pl; u.aux = nb;
        u.A = A + (size_t)pm * 256 * 2048 * 2 + (size_t)nb * 512 * 2; u.B = B + (size_t)nb * 1024 * 512 * 2 + (size_t)pl * 256 * 512 * 2; u.rows = nullptr; return true; }
};
struct SchedE1 {
    pg8::TileOrder T; const char* A; const char* B; const int* stok; int e0;
    __device__ __forceinline__ bool next(int i, Unit& u) const { int pm, pn; if (!T.tile(i, pm, pn)) return false; const int el = pm / ETILES, pl = pm - el * ETILES, e = e0 + el; u.pm = pl; u.pn = pn; u.aux = el;
        u.A = A; u.B = B + (size_t)e * 4096 * D + (size_t)pn * 256 * D; u.rows = stok + (size_t)e * EROWS + pl * 256; return true; }
};
struct SchedE2 {
    pg8::TileOrder T; const char* A; const char* B; int e0;
    __device__ __forceinline__ bool next(int i, Unit& u) const { int pm, pn; if (!T.tile(i, pm, pn)) return false; const int el = pm / ETILES, pl = pm - el * ETILES, e = e0 + el; u.pm = pl; u.pn = pn; u.aux = e;
        u.A = A + ((size_t)el * EROWS + (size_t)pl * 256) * DFF; u.B = B + (size_t)e * D * DFF + (size_t)pn * 256 * DFF; u.rows = nullptr; return true; }
};

#define EPI_LOOP_AM _Pragma("unroll") for (int ai = 0; ai < 2; ++ai) _Pragma("unroll") for (int m = 0; m < 4; ++m)
struct EpiStoreBf16 {
    static constexpr bool PERM = true;
    bf16_t* O0; bf16_t* O1; bf16_t* O2; bf16_t* O3; int ldo;
    __device__ __forceinline__ void operator()(const f32x4 (&acc)[2][2][4][2], const Unit& u, int wr, int wc, int fr, int fq) const {
        bf16_t* base = (u.aux == 0) ? O0 : ((u.aux == 1) ? O1 : ((u.aux == 2) ? O2 : O3));
        const int row0 = u.pm * 256 + wr * 64 + fr, col0 = u.pn * 256 + wc * 32 + 8 * fq;
        EPI_LOOP_AM { bf16_t* rowp = base + (size_t)(row0 + ai * 128 + m * 16) * ldo + col0;
#pragma unroll
            for (int bj = 0; bj < 2; ++bj) { const f32x4 v0 = acc[ai][bj][m][0], v1 = acc[ai][bj][m][1];
                u32x4 w; w.x = pk2(v0[0], v0[1]); w.y = pk2(v0[2], v0[3]); w.z = pk2(v1[0], v1[1]); w.w = pk2(v1[2], v1[3]);
                *(u32x4*)(rowp + bj * 128) = w; } }
    }
};
struct EpiGate {
    static constexpr bool PERM = true;
    bf16_t* BR;
    __device__ __forceinline__ void operator()(const f32x4 (&acc)[2][2][4][2], const Unit& u, int wr, int wc, int fr, int fq) const {
        const int sec = u.pn >> 1;
        const int cbase = (sec == 0 ? 0 : (sec == 1 ? 1024 : 1536)) + (u.pn & 1) * 256 + wc * 32 + 8 * fq;
        const int row0 = u.pm * 256 + wr * 64 + fr;
        u32x4 xv[2][4][2];
        EPI_LOOP_AM { const bf16_t* rowp = BR + (size_t)(row0 + ai * 128 + m * 16) * 2048 + cbase; xv[ai][m][0] = *(const u32x4*)rowp; xv[ai][m][1] = *(const u32x4*)(rowp + 128); }
        EPI_LOOP_AM { bf16_t* rowp = BR + (size_t)(row0 + ai * 128 + m * 16) * 2048 + cbase;
#pragma unroll
            for (int bj = 0; bj < 2; ++bj) {
                const u32x4 x = xv[ai][m][bj];
                float g[8];
#pragma unroll
                for (int j = 0; j < 4; ++j) { g[j] = acc[ai][bj][m][0][j]; g[4 + j] = acc[ai][bj][m][1][j]; }
#pragma unroll
                for (int j = 0; j < 8; ++j) g[j] = (sec == 0) ? gelu_tanh_(g[j]) : siluf_(g[j]);
                const unsigned xs[4] = {x.x, x.y, x.z, x.w}; unsigned ws_[4];
#pragma unroll
                for (int j = 0; j < 4; ++j) ws_[j] = pk2(bf2f((bf16_t)(xs[j] & 0xffffu)) * g[2 * j], bf2f((bf16_t)(xs[j] >> 16)) * g[2 * j + 1]);
                u32x4 w; w.x = ws_[0]; w.y = ws_[1]; w.z = ws_[2]; w.w = ws_[3];
                *(u32x4*)(rowp + bj * 128) = w; } }
    }
};
struct EpiMerge {
    static constexpr bool PERM = false;
    const bf16_t* PB0; const bf16_t* PB1; const bf16_t* PB2; const bf16_t* PB3; bf16_t* MG;
    __device__ __forceinline__ void operator()(const f32x4 (&acc)[2][2][4][2], const Unit& u, int wr, int wc, int fr, int fq) const {
        const int row0 = u.pm * 256 + wr * 64 + fr, d0 = u.pn * 64 + wc * 16 + 4 * fq;
        u32x2 pbv[2][4][4];
        EPI_LOOP_AM { const size_t off = (size_t)(row0 + ai * 128 + m * 16) * D + d0;
            pbv[ai][m][0] = *(const u32x2*)(PB0 + off); pbv[ai][m][1] = *(const u32x2*)(PB1 + off); pbv[ai][m][2] = *(const u32x2*)(PB2 + off); pbv[ai][m][3] = *(const u32x2*)(PB3 + off); }
        EPI_LOOP_AM { const size_t off = (size_t)(row0 + ai * 128 + m * 16) * D + d0;
            float s[4] = {0.f, 0.f, 0.f, 0.f};
#pragma unroll
            for (int bj = 0; bj < 2; ++bj)
#pragma unroll
                for (int n = 0; n < 2; ++n) { const u32x2 p = pbv[ai][m][2 * bj + n]; const f32x4 a = acc[ai][bj][m][n];
                    constexpr float IS = 1.0f / WM_SCALE;
                    s[0] += sigmoidf_(a[0] * IS) * bf2f((bf16_t)(p.x & 0xffffu)); s[1] += sigmoidf_(a[1] * IS) * bf2f((bf16_t)(p.x >> 16));
                    s[2] += sigmoidf_(a[2] * IS) * bf2f((bf16_t)(p.y & 0xffffu)); s[3] += sigmoidf_(a[3] * IS) * bf2f((bf16_t)(p.y >> 16)); }
            u32x2 w; w.x = pk2(s[0], s[1]); w.y = pk2(s[2], s[3]);
            *(u32x2*)(MG + off) = w; }
    }
};
struct EpiOut {
    static constexpr bool PERM = true;
    const bf16_t* H; bf16_t* X1;
    __device__ __forceinline__ void operator()(const f32x4 (&acc)[2][2][4][2], const Unit& u, int wr, int wc, int fr, int fq) const {
        const int row0 = u.pm * 256 + wr * 64 + fr, col0 = u.pn * 256 + wc * 32 + 8 * fq;
        u32x4 hv[2][4][2];
        EPI_LOOP_AM { const size_t off = (size_t)(row0 + ai * 128 + m * 16) * D + col0; hv[ai][m][0] = *(const u32x4*)(H + off); hv[ai][m][1] = *(const u32x4*)(H + off + 128); }
        EPI_LOOP_AM { const size_t off = (size_t)(row0 + ai * 128 + m * 16) * D + col0;
#pragma unroll
            for (int bj = 0; bj < 2; ++bj) { const u32x4 p = hv[ai][m][bj]; const f32x4 a0 = acc[ai][bj][m][0], a1 = acc[ai][bj][m][1];
                u32x4 w;
                w.x = pk2(ALPHA * bf2f((bf16_t)(p.x & 0xffffu)) + a0[0], ALPHA * bf2f((bf16_t)(p.x >> 16)) + a0[1]);
                w.y = pk2(ALPHA * bf2f((bf16_t)(p.y & 0xffffu)) + a0[2], ALPHA * bf2f((bf16_t)(p.y >> 16)) + a0[3]);
                w.z = pk2(ALPHA * bf2f((bf16_t)(p.z & 0xffffu)) + a1[0], ALPHA * bf2f((bf16_t)(p.z >> 16)) + a1[1]);
                w.w = pk2(ALPHA * bf2f((bf16_t)(p.w & 0xffffu)) + a1[2], ALPHA * bf2f((bf16_t)(p.w >> 16)) + a1[3]);
                *(u32x4*)(X1 + off + bj * 128) = w; } }
    }
};
struct EpiSwiglu {
    static constexpr bool PERM = true;
    unsigned char* HE;
    __device__ __forceinline__ void operator()(const f32x4 (&acc)[2][2][4][2], const Unit& u, int wr, int wc, int fr, int fq) const {
        const int row0 = u.pm * 256 + wr * 64 + fr, col0 = u.pn * 128 + wc * 32 + 8 * fq;
        unsigned char* base = HE + (size_t)u.aux * EROWS * DFF;
        constexpr float IS = 1.0f / W13_SCALE;
        EPI_LOOP_AM { unsigned char* rowp = base + (size_t)(row0 + ai * 128 + m * 16) * DFF + col0;
            float h[8];
#pragma unroll
            for (int n = 0; n < 2; ++n)
#pragma unroll
                for (int j = 0; j < 4; ++j) h[4 * n + j] = siluf_(acc[ai][0][m][n][j] * IS) * (acc[ai][1][m][n][j] * IS);
            u32x2 w; w.x = pk4_fp8(h[0], h[1], h[2], h[3]); w.y = pk4_fp8(h[4], h[5], h[6], h[7]);
            *(u32x2*)rowp = w; }
    }
};
struct EpiScale {
    static constexpr bool PERM = true;
    bf16_t* YE; const float* SG;
    __device__ __forceinline__ void operator()(const f32x4 (&acc)[2][2][4][2], const Unit& u, int wr, int wc, int fr, int fq) const {
        const int row0 = u.pm * 256 + wr * 64 + fr, col0 = u.pn * 256 + wc * 32 + 8 * fq;
        bf16_t* base = YE + (size_t)u.aux * EROWS * D; const float* sg = SG + (size_t)u.aux * EROWS;
        float gv[2][4];
        EPI_LOOP_AM { gv[ai][m] = sg[row0 + ai * 128 + m * 16]; }
        EPI_LOOP_AM { const int row = row0 + ai * 128 + m * 16; const float g = gv[ai][m] * (1.0f / W2_SCALE); bf16_t* rowp = base + (size_t)row * D + col0;
#pragma unroll
            for (int bj = 0; bj < 2; ++bj) { const f32x4 v0 = acc[ai][bj][m][0] * g, v1 = acc[ai][bj][m][1] * g;
                u32x4 w; w.x = pk2(v0[0], v0[1]); w.y = pk2(v0[2], v0[3]); w.z = pk2(v1[0], v1[1]); w.w = pk2(v1[2], v1[3]);
                *(u32x4*)(rowp + bj * 128) = w; } }
    }
};

template <class ColMap>
__device__ __forceinline__ void tr_tile(const Frame& F, const float* src, size_t ld_src, bf16_t* dst, size_t ldd, int n0, int k0, const ColMap& cm) {
    LAS float* tile = (LAS float*)F.lds;
    const int a = F.tid >> 6, b = F.tid & 63;
    const int col = cm(n0 + b);
#pragma unroll
    for (int j = 0; j < 8; ++j) { const int kk = a + 8 * j; tile[b * 65 + kk] = (col >= 0) ? src[(size_t)(k0 + kk) * ld_src + col] : 0.f; }
    __syncthreads();
#pragma unroll
    for (int j = 0; j < 8; ++j) { const int nn = a + 8 * j; dst[(size_t)(n0 + nn) * ldd + k0 + b] = f2bf(tile[nn * 65 + b]); }
    __syncthreads();
}
template <class ColMap>
__device__ __forceinline__ void tr_strip(const Frame& F, const float* src, size_t ld_src, bf16_t* dst, size_t ldd, int n0, int k0, const ColMap& cm) {
    LAS float* tile = (LAS float*)F.lds;
    const int a = F.tid >> 6, b = F.tid & 63;
    const int col = cm(n0 + b);
    float v[32];
#pragma unroll
    for (int j = 0; j < 32; ++j) v[j] = (col >= 0) ? src[(size_t)(k0 + a + 8 * j) * ld_src + col] : 0.f;
#pragma unroll
    for (int j = 0; j < 32; ++j) tile[b * 257 + a + 8 * j] = v[j];
    __syncthreads();
#pragma unroll
    for (int j = 0; j < 8; ++j) { const int nn = a + 8 * j;
#pragma unroll
        for (int m = 0; m < 2; ++m) { const int kk = 2 * b + 128 * m; *(unsigned*)(dst + (size_t)(n0 + nn) * ldd + k0 + kk) = pk2(tile[nn * 257 + kk], tile[nn * 257 + kk + 1]); } }
    __syncthreads();
}
template <class ColMap>
__device__ __forceinline__ void tr_strip8m(const Frame& F, const float* src, size_t ld_src, unsigned char* dst, size_t ldd, int n0, int k0, const ColMap& cm, float scale) {
    LAS float* tile = (LAS float*)F.lds;
    const int a = F.tid >> 6, b = F.tid & 63; const int col = cm(n0 + b);
    float v[32];
#pragma unroll
    for (int j = 0; j < 32; ++j) v[j] = src[(size_t)(k0 + a + 8 * j) * ld_src + col];
#pragma unroll
    for (int j = 0; j < 32; ++j) tile[b * 257 + a + 8 * j] = v[j] * scale;
    __syncthreads();
#pragma unroll
    for (int j = 0; j < 8; ++j) { const int nn = a + 8 * j; const LAS float* tp = tile + nn * 257 + 4 * b;
        *(unsigned*)(dst + (size_t)(n0 + nn) * ldd + k0 + 4 * b) = pk4_fp8(tp[0], tp[1], tp[2], tp[3]); }
    __syncthreads();
}
__device__ __forceinline__ void tr_strip8(const Frame& F, const float* src, size_t ld_src, unsigned char* dst, size_t ldd, int n0, int k0, int coff, float scale) {
    LAS float* tile = (LAS float*)F.lds;
    const int a = F.tid >> 6, b = F.tid & 63;
    float v[32];
#pragma unroll
    for (int j = 0; j < 32; ++j) v[j] = src[(size_t)(k0 + a + 8 * j) * ld_src + coff + n0 + b];
#pragma unroll
    for (int j = 0; j < 32; ++j) tile[b * 257 + a + 8 * j] = v[j] * scale;
    __syncthreads();
#pragma unroll
    for (int j = 0; j < 8; ++j) { const int nn = a + 8 * j; const LAS float* tp = tile + nn * 257 + 4 * b;
        *(unsigned*)(dst + (size_t)(n0 + nn) * ldd + k0 + 4 * b) = pk4_fp8(tp[0], tp[1], tp[2], tp[3]); }
    __syncthreads();
}
struct CmId { int off; __device__ __forceinline__ int operator()(int n) const { return off + n; } };
struct CmW1 { __device__ __forceinline__ int operator()(int n) const { return n < 512 ? n : (n < 2432 ? n + 512 : -1); } };
struct CmW2 { __device__ __forceinline__ int operator()(int n) const { return n < 2048 ? 2944 + n : 3456 + n; } };
struct CmWG { __device__ __forceinline__ int operator()(int n) const { return n < 512 ? 512 + n : (n < 1024 ? 4480 + n : 5504 + n); } };
struct CmWM { __device__ __forceinline__ int operator()(int n) const { const int pn = n >> 8, c = n & 255, bj = c >> 7, wc = (c >> 5) & 3, nn = (c >> 4) & 1, fq = (c >> 2) & 3, j = c & 3;
        return 7040 + (2 * bj + nn) * 1024 + 64 * pn + 16 * wc + 4 * fq + j; } };

__device__ __forceinline__ void phase_prep_weights(const Frame& F0) {
    Frame F = F0; { size_t z_ = 0; asm volatile("" : "+v"(F.tid), "+v"(F.lane), "+s"(z_), "+s"(F.bid), "+s"(F.G), "+s"(F.wave)); F.ws = F0.ws + z_; F.out = F0.out + z_; }
    for (int job = F.bid; job < 2 * 912; job += F.G) {
        const int li = job / 912; int j = job - li * 912;
        const float* win = F.in[I_WIN] + (size_t)li * D * N_IN;
        if (j < 160) { tr_strip(F, win, N_IN, (bf16_t*)(F.ws + WS_W1T) + (size_t)li * N1 * D, D, (j >> 2) * 64, (j & 3) * 256, CmW1()); continue; } j -= 160;
        if (j < 192) { tr_strip(F, win, N_IN, (bf16_t*)(F.ws + WS_W2T) + (size_t)li * N2 * D, D, (j >> 2) * 64, (j & 3) * 256, CmW2()); continue; } j -= 192;
        if (j < 96) { tr_strip(F, win, N_IN, (bf16_t*)(F.ws + WS_WGT) + (size_t)li * NG * D, D, (j >> 2) * 64, (j & 3) * 256, CmWG()); continue; } j -= 96;
        if (j < 256) { tr_strip8m(F, win, N_IN, (unsigned char*)(F.ws + WS_WMT) + (size_t)li * NM * D, D, (j >> 2) * 64, (j & 3) * 256, CmWM(), WM_SCALE); continue; } j -= 256;
        if (j < 128) { const int nb = j >> 5, r = j & 31;
            tr_strip(F, F.in[I_WBR] + ((size_t)li * 4 + nb) * 512 * D, D, (bf16_t*)(F.ws + WS_WBT) + ((size_t)li * 4 + nb) * D * 512, 512, (r >> 1) * 64, (r & 1) * 256, CmId{0}); continue; } j -= 128;
        if (j < 64) { tr_strip(F, F.in[I_WOUT] + (size_t)li * D * D, D, (bf16_t*)(F.ws + WS_WOT) + (size_t)li * D * D, D, (j >> 2) * 64, (j & 3) * 256, CmId{0}); continue; } j -= 64;
        tr_tile(F, F.in[I_G2] + (size_t)li * 128 * 512, 512, (bf16_t*)(F.ws + WS_G2T) + (size_t)li * 512 * 128, 128, (j >> 1) * 64, (j & 1) * 64, CmId{0});
    }
    for (int job = F.bid; job < 128; job += F.G) {
        if (job < 64) { const int li = job >> 5, d = (job >> 4) & 1, m = (job >> 3) & 1, nt = job & 7;
            tr_tile(F, F.in[m ? I_A2 : I_W2] + ((size_t)li * 2 + d) * 64 * 512, 512, (bf16_t*)(F.ws + WS_RW2T) + (((size_t)li * 2 + d) * 2 + m) * 512 * 64, 64, nt * 64, 0, CmId{0});
        } else { const int j = job - 64, li = j >> 5, d = (j >> 4) & 1, m = (j >> 3) & 1, g = j & 7;
            tr_tile(F, F.in[m ? I_WI : I_WR] + (((size_t)li * 2 + d) * 8 + g) * 64 * 64, 64, (bf16_t*)(F.ws + WS_LRUT) + ((((size_t)li * 2 + d) * 2 + m) * 8 + g) * 64 * 64, 64, 0, 0, CmId{0}); }
    }
    if (F.bid == 0) { float* lb = (float*)(F.ws + WS_LB); const float* h = F.in[I_HLB];
        for (int c = F.tid; c < 512; c += NTHREADS) { lb[c] = 0.f; lb[512 + c] = 1.0f / (1.0f + expf(h[c] - h[512 + c])); } }
}
__device__ __forceinline__ void phase_prep_experts(const Frame& F0, int li, int jlo, int jhi, int units) {
    Frame F = F0; { size_t z_ = 0; asm volatile("" : "+v"(F.tid), "+v"(F.lane), "+s"(z_), "+s"(F.bid), "+s"(F.G), "+s"(F.wave)); F.ws = F0.ws + z_; F.out = F0.out + z_; }
    const int nskip = (units > F.G && F.G > 64) ? units % F.G : 0;
    if (F.bid < nskip) return;
    for (int job = jlo + F.bid - nskip; job < jhi; job += F.G - nskip) {
        const bool is13 = job < NE * 256; const int e = is13 ? (job >> 8) : ((job - NE * 256) >> 7); int j = is13 ? (job & 255) : 256 + ((job - NE * 256) & 127);
        if (j < 256) { const int nt = j >> 2, ks = j & 3, p = nt >> 2, r = nt & 3, which = r >> 1, nsub = r & 1;
            const float* src = F.in[which ? I_EW3 : I_EW1] + ((size_t)li * NE + e) * D * DFF;
            const int n0 = 64 * nt;
            tr_strip8(F, src, DFF, (unsigned char*)F.out + OUT_W13 + (size_t)e * 4096 * D, D, n0, ks * 256, 128 * p + 64 * nsub - n0, W13_SCALE);
        } else { j -= 256;
            tr_strip8(F, F.in[I_EW2] + ((size_t)li * NE + e) * DFF * D, D, (unsigned char*)F.out + OUT_W2 + (size_t)e * D * DFF, DFF, (j >> 3) * 64, (j & 7) * 256, 0, W2_SCALE); }
    }
}

__device__ __forceinline__ void ln_stats(const float (&x)[16], float& mu, float& rstd) {
    float s = 0.f;
#pragma unroll
    for (int i = 0; i < 16; ++i) s += x[i];
    mu = wave_sum(s) * (1.0f / 1024.0f);
    float q = 0.f;
#pragma unroll
    for (int i = 0; i < 16; ++i) { const float dlt = x[i] - mu; q += dlt * dlt; }
    rstd = rsqrtf(wave_sum(q) * (1.0f / 1024.0f) + 1e-5f);
}
__device__ __forceinline__ void ld16_f32(const float* p, int lane, float (&x)[16]) {
#pragma unroll
    for (int j = 0; j < 2; ++j) { const f32x4 a = *(const f32x4*)(p + 512 * j + 8 * lane), b = *(const f32x4*)(p + 512 * j + 8 * lane + 4);
#pragma unroll
        for (int i = 0; i < 4; ++i) { x[8 * j + i] = a[i]; x[8 * j + 4 + i] = b[i]; } }
}
__device__ __forceinline__ void ld16_bf16(const bf16_t* p, int lane, float (&x)[16]) {
#pragma unroll
    for (int j = 0; j < 2; ++j) { const u32x4 a = *(const u32x4*)(p + 512 * j + 8 * lane); const unsigned w[4] = {a.x, a.y, a.z, a.w};
#pragma unroll
        for (int i = 0; i < 4; ++i) { x[8 * j + 2 * i] = bf2f((bf16_t)(w[i] & 0xffffu)); x[8 * j + 2 * i + 1] = bf2f((bf16_t)(w[i] >> 16)); } }
}
__device__ __forceinline__ void unpack16(const u32x4 (&a)[2], float (&x)[16]) {
#pragma unroll
    for (int j = 0; j < 2; ++j) { const unsigned w[4] = {a[j].x, a[j].y, a[j].z, a[j].w};
#pragma unroll
        for (int i = 0; i < 4; ++i) { x[8 * j + 2 * i] = bf2f((bf16_t)(w[i] & 0xffffu)); x[8 * j + 2 * i + 1] = bf2f((bf16_t)(w[i] >> 16)); } }
}
__device__ __forceinline__ void ldraw16(const bf16_t* p, int lane, u32x4 (&a)[2]) { a[0] = __builtin_nontemporal_load((const u32x4*)(p + 8 * lane)); a[1] = __builtin_nontemporal_load((const u32x4*)(p + 512 + 8 * lane)); }
__device__ __forceinline__ void st16_bf16(bf16_t* p, int lane, const float (&x)[16]) {
#pragma unroll
    for (int j = 0; j < 2; ++j) { u32x4 w; w.x = pk2(x[8 * j], x[8 * j + 1]); w.y = pk2(x[8 * j + 2], x[8 * j + 3]); w.z = pk2(x[8 * j + 4], x[8 * j + 5]); w.w = pk2(x[8 * j + 6], x[8 * j + 7]);
        *(u32x4*)(p + 512 * j + 8 * lane) = w; }
}
__device__ __forceinline__ void st16_fp8(unsigned char* p, int lane, const float (&x)[16]) {
#pragma unroll
    for (int j = 0; j < 2; ++j) { u32x2 w8; w8.x = pk4_fp8(x[8 * j], x[8 * j + 1], x[8 * j + 2], x[8 * j + 3]); w8.y = pk4_fp8(x[8 * j + 4], x[8 * j + 5], x[8 * j + 6], x[8 * j + 7]); *(u32x2*)(p + 512 * j + 8 * lane) = w8; }
}
__device__ __forceinline__ void st16_f32(float* p, int lane, const float (&x)[16]) {
#pragma unroll
    for (int j = 0; j < 2; ++j) { *(f32x4*)(p + 512 * j + 8 * lane) = (f32x4){x[8 * j], x[8 * j + 1], x[8 * j + 2], x[8 * j + 3]}; *(f32x4*)(p + 512 * j + 8 * lane + 4) = (f32x4){x[8 * j + 4], x[8 * j + 5], x[8 * j + 6], x[8 * j + 7]}; }
}
__device__ __forceinline__ void ln_apply(float (&x)[16], float mu, float rstd, const float (&gg)[16], const float (&bb)[16]) {
#pragma unroll
    for (int i = 0; i < 16; ++i) x[i] = (x[i] - mu) * rstd * gg[i] + bb[i];
}

__device__ __forceinline__ void phase_embed(const Frame& F0) {
    Frame F = F0; { size_t z_ = 0; asm volatile("" : "+v"(F.tid), "+v"(F.lane), "+s"(z_), "+s"(F.bid), "+s"(F.G), "+s"(F.wave)); F.ws = F0.ws + z_; F.out = F0.out + z_; }
    const int gw = F.bid * NWAVES + F.wave, nw = F.G * NWAVES;
    float gg[16], bb[16]; ld16_f32(F.in[I_LNEG], F.lane, gg); ld16_f32(F.in[I_LNEB], F.lane, bb);
    for (int row0 = gw; row0 < NTOK; row0 += 2 * nw) {
        float xs[2][16];
#pragma unroll
        for (int j = 0; j < 2; ++j) { const int row = row0 + j * nw; if (row < NTOK) { const int s = row / LSEQ, t = row - s * LSEQ;
            const float* src = (t < NMETA) ? F.in[I_META] + (size_t)t * D : ((s < NSEQ0) ? F.in[I_XP] + ((size_t)s * SEQ + (t - NMETA)) * D : F.in[I_XS] + ((size_t)(s - NSEQ0) * SEQ + (t - NMETA)) * D);
            ld16_f32(src, F.lane, xs[j]); } }
#pragma unroll
        for (int j = 0; j < 2; ++j) { const int row = row0 + j * nw; if (row < NTOK) {
            float mu, rstd; ln_stats(xs[j], mu, rstd); ln_apply(xs[j], mu, rstd, gg, bb);
            st16_bf16(F.hbuf() + (size_t)row * D, F.lane, xs[j]); st16_fp8((unsigned char*)F.out + OUT_HIN8 + (size_t)row * D, F.lane, xs[j]); } }
    }
}

__device__ __forceinline__ void phase_ln1_router(const Frame& F0, int li) {
    Frame F = F0; { size_t z_ = 0; asm volatile("" : "+v"(F.tid), "+v"(F.lane), "+s"(z_), "+s"(F.bid), "+s"(F.G), "+s"(F.wave)); F.ws = F0.ws + z_; F.out = F0.out + z_; }
    LAS float* RW = (LAS float*)F.lds;
    LAS unsigned* hl0 = (LAS unsigned*)(F.lds + 65536);
    for (int i = F.tid; i < 32 * 512; i += NTHREADS) hl0[i] = 0u;
    const float* router = F.in[I_ROUTER] + (size_t)li * D * NE;
    for (int i = F.tid; i < D * NE; i += NTHREADS) RW[(i & 15) * D + (i >> 4)] = router[i];
    { unsigned* hist = (unsigned*)(F.ws + WS_HIST); for (int i = F.bid * NTHREADS + F.tid; i < 2 * 32 * 1024; i += F.G * NTHREADS) hist[32 * 1024 + i] = 0u;
      if (F.bid == 0 && F.tid < 64) { unsigned* ctl = (unsigned*)(F.ws + WS_CTL); ctl[CW_CNT + F.tid] = 0u; ctl[CW_TIE + F.tid] = 0u; }
      int* stok = (int*)(F.ws + WS_STOK); float* sg = (float*)(F.ws + WS_SGATE);
      for (int i = F.bid * NTHREADS + F.tid; i < NE * (EROWS - EVALID); i += F.G * NTHREADS) { const int e = i / (EROWS - EVALID), r = EVALID + i % (EROWS - EVALID); stok[e * EROWS + r] = 0; sg[e * EROWS + r] = 0.f; } }
    __syncthreads();
    const bf16_t* X1 = (const bf16_t*)(F.ws + R_X1); float* aff = (float*)(F.ws + WS_AFF);
    float gg[16], bb[16]; ld16_f32(F.in[I_LN1G] + (size_t)li * D, F.lane, gg); ld16_f32(F.in[I_LN1B] + (size_t)li * D, F.lane, bb);
    const int gw = F.bid * NWAVES + F.wave, nw = F.G * NWAVES;
    for (int row0 = gw; row0 < NTOK; row0 += 4 * nw) {
      u32x4 XR[4][2];
#pragma unroll
      for (int jr = 0; jr < 4; ++jr) { const int row = row0 + jr * nw; if (row < NTOK) ldraw16(X1 + (size_t)row * D, F.lane, XR[jr]); }
#pragma unroll
      for (int jr = 0; jr < 4; ++jr) { const int row = row0 + jr * nw; if (row < NTOK) {
        float x[16]; unpack16(XR[jr], x);
        float mu, rstd; ln_stats(x, mu, rstd); ln_apply(x, mu, rstd, gg, bb);
        st16_bf16(F.hbuf() + (size_t)row * D, F.lane, x);
        { unsigned char* h8 = F.ws + R_H8 + (size_t)row * D;
#pragma unroll
          for (int j = 0; j < 2; ++j) { u32x2 w8; w8.x = pk4_fp8(x[8 * j], x[8 * j + 1], x[8 * j + 2], x[8 * j + 3]); w8.y = pk4_fp8(x[8 * j + 4], x[8 * j + 5], x[8 * j + 6], x[8 * j + 7]); *(u32x2*)(h8 + 512 * j + 8 * F.lane) = w8; } }
        float lg[16];
#pragma unroll
        for (int e = 0; e < 16; ++e) lg[e] = 0.f;
#pragma unroll 4
        for (int e = 0; e < 16; ++e) { float a = 0.f;
#pragma unroll
            for (int j = 0; j < 2; ++j) { const f32x4 w0 = *(const LAS f32x4*)(RW + e * D + 512 * j + 8 * F.lane), w1 = *(const LAS f32x4*)(RW + e * D + 512 * j + 8 * F.lane + 4);
                a += x[8 * j] * w0[0] + x[8 * j + 1] * w0[1] + x[8 * j + 2] * w0[2] + x[8 * j + 3] * w0[3] + x[8 * j + 4] * w1[0] + x[8 * j + 5] * w1[1] + x[8 * j + 6] * w1[2] + x[8 * j + 7] * w1[3]; }
            lg[e] = a; }
        float mx = -1e30f;
#pragma unroll
        for (int e = 0; e < 16; ++e) { lg[e] = wave_sum(lg[e]); mx = fmaxf(mx, lg[e]); }
        float den = 0.f;
#pragma unroll
        for (int e = 0; e < 16; ++e) { lg[e] = __expf(lg[e] - mx); den += lg[e]; }
        const float inv = __builtin_amdgcn_rcpf(den);
        float mine = 0.f;
#pragma unroll
        for (int e = 0; e < 16; ++e) mine = (F.lane == e) ? lg[e] * inv : mine;
        if (F.lane < 16) { aff[(size_t)row * 16 + F.lane] = mine;
            unsigned bin = __float_as_uint(mine) >> 20; if (bin > 1023u) bin = 1023u;
            (void)__hip_atomic_fetch_add(hl0 + ((row >= TOK0 ? 16 : 0) + F.lane) * 512 + (bin >> 1), 1u << (16 * (bin & 1u)), __ATOMIC_RELAXED, __HIP_MEMORY_SCOPE_WORKGROUP); }
      } }
    }
    __syncthreads();
    { unsigned* gh = (unsigned*)(F.ws + WS_HIST); for (int i = F.tid; i < 32 * 512; i += NTHREADS) { const unsigned v = hl0[i]; if (v & 0xffffu) atomicAdd(gh + 2 * i, v & 0xffffu); if (v >> 16) atomicAdd(gh + 2 * i + 1, v >> 16); } }
    __syncthreads();
}

__device__ __forceinline__ void find_bin(const unsigned* h, unsigned target, int lane, unsigned& bin, unsigned& rem, unsigned& bincnt) {
    unsigned c[16]; unsigned ls = 0;
#pragma unroll
    for (int i = 0; i < 16; ++i) { c[i] = __hip_atomic_load(h + 16 * lane + i, __ATOMIC_RELAXED, __HIP_MEMORY_SCOPE_AGENT); ls += c[i]; }
    unsigned x = ls;
#pragma unroll
    for (int o = 1; o < 64; o <<= 1) { const unsigned v = __shfl_down(x, o); if (lane + o < 64) x += v; }
    const unsigned above = x - ls;
    const bool own = (above < target) && (target <= above + ls);
    unsigned b = 0, r = 1, bc = 1;
    if (own) { unsigned cum = above; bool done = false;
#pragma unroll
        for (int i = 15; i >= 0; --i) { if (!done && target <= cum + c[i]) { b = 16 * lane + i; r = target - cum; bc = c[i]; done = true; } cum += c[i]; } }
    const unsigned long long m = __ballot(own);
    const int src = m ? (int)__builtin_ctzll(m) : 0;
    bin = __shfl(b, src); rem = __shfl(r, src); bincnt = __shfl(bc, src);
}
__device__ __forceinline__ void phase_topk(const Frame& F0, int pass) {
    Frame F = F0; { size_t z_ = 0; asm volatile("" : "+v"(F.tid), "+v"(F.lane), "+s"(z_), "+s"(F.bid), "+s"(F.G), "+s"(F.wave)); F.ws = F0.ws + z_; F.out = F0.out + z_; }
    LAS unsigned* hl = (LAS unsigned*)F.lds;
    LAS unsigned* selp = (LAS unsigned*)(F.lds + 131072);
    unsigned* hist = (unsigned*)(F.ws + WS_HIST);
    const float* aff = (const float*)(F.ws + WS_AFF);
    for (int i = F.tid; i < 32 * 1024; i += NTHREADS) hl[i] = 0u;
    for (int q = F.wave; q < 32; q += NWAVES) {
        const unsigned cap = (q < 16) ? CAP0 : CAP1; unsigned prefix = 0, rem = cap, bcnt = 0;
        for (int p = 0; p < pass; ++p) { unsigned bin, r; find_bin(hist + ((size_t)p * 32 + q) * 1024, rem, F.lane, bin, r, bcnt); prefix = (p == 0) ? bin : ((prefix << 10) | bin); rem = r; }
        if (F.lane == 0) { selp[q] = prefix; selp[32 + q] = rem; selp[64 + q] = bcnt; }
    }
    __syncthreads();
    if (pass < 3) {
        for (int tb0 = F.bid; tb0 < NTOK / 32; tb0 += 4 * F.G) {
            unsigned bv[4];
#pragma unroll
            for (int u = 0; u < 4; ++u) { const int tb = tb0 + u * F.G, tbc = tb < NTOK / 32 ? tb : NTOK / 32 - 1; bv[u] = __float_as_uint(aff[((size_t)tbc * 32 + (F.tid >> 4)) * 16 + (F.tid & 15)]); }
#pragma unroll
            for (int u = 0; u < 4; ++u) { const int tb = tb0 + u * F.G;
                const int t = tb * 32 + (F.tid >> 4), e = F.tid & 15, q = (t >= TOK0 ? 16 : 0) + e;
                const unsigned bits = bv[u];
                unsigned bin; bool ok;
                if (pass == 0) { bin = bits >> 20; ok = true; }
                else if (pass == 1) { bin = (bits >> 10) & 1023u; ok = (bits >> 20) == selp[q]; }
                else { bin = bits & 1023u; ok = (bits >> 10) == selp[q]; }
                if (bin > 1023u) bin = 1023u;
                if (ok && tb < NTOK / 32) (void)__hip_atomic_fetch_add(hl + q * 1024 + bin, 1u, __ATOMIC_RELAXED, __HIP_MEMORY_SCOPE_WORKGROUP); }
        }
        __syncthreads();
        unsigned* gh = hist + (size_t)pass * 32 * 1024;
        for (int i = F.tid; i < 32 * 1024; i += NTHREADS) { const unsigned v = hl[i]; if (v) atomicAdd(gh + i, v); }
    } else {
        unsigned* ctl = (unsigned*)(F.ws + WS_CTL); int* stok = (int*)(F.ws + WS_STOK); float* sg = (float*)(F.ws + WS_SGATE); int* inv = (int*)(F.ws + WS_INV);
        LAS unsigned* lcnt = selp + 96;
        LAS unsigned* lbase = selp + 128;
        if (F.tid < 32) lcnt[F.tid] = 0u;
        __syncthreads();
        auto selected = [&](int t, int e, int set, int q, unsigned bits) -> bool {
            const unsigned thr = selp[q]; bool sel = bits > thr; const bool tie = (bits == thr); if (tie) sel = true;
            unsigned long long need = __ballot(tie && (selp[64 + q] != selp[32 + q]));
            while (need) { const int src = (int)__builtin_ctzll(need); need &= need - 1;
                const int t_s = __shfl(t, src), e_s = __shfl(e, src), set_s = __shfl(set, src); const unsigned thr_s = __shfl(thr, src);
                unsigned c = 0; for (int t2 = (set_s ? TOK0 : 0) + F.lane; t2 < t_s; t2 += 64) c += (__float_as_uint(aff[(size_t)t2 * 16 + e_s]) == thr_s) ? 1u : 0u;
#pragma unroll
                for (int o = 32; o > 0; o >>= 1) c += __shfl_xor(c, o);
                if (F.lane == src) sel = c < selp[32 + q]; }
            return sel; };
        for (int tb = F.bid; tb < NTOK / 32; tb += F.G) {
            const int t = tb * 32 + (F.tid >> 4), e = F.tid & 15, set = (t >= TOK0) ? 1 : 0, q = set * 16 + e;
            if (selected(t, e, set, q, __float_as_uint(aff[(size_t)t * 16 + e]))) (void)__hip_atomic_fetch_add(lcnt + q, 1u, __ATOMIC_RELAXED, __HIP_MEMORY_SCOPE_WORKGROUP); }
        __syncthreads();
        if (F.tid < 32) { const unsigned n = lcnt[F.tid]; lbase[F.tid] = n ? atomicAdd(ctl + CW_CNT + F.tid, n) : 0u; lcnt[F.tid] = 0u; }
        __syncthreads();
        for (int tb = F.bid; tb < NTOK / 32; tb += F.G) {
            const int t = tb * 32 + (F.tid >> 4), e = F.tid & 15, set = (t >= TOK0) ? 1 : 0, q = set * 16 + e;
            const float a = aff[(size_t)t * 16 + e];
            int pos = -1;
            if (selected(t, e, set, q, __float_as_uint(a))) { const unsigned sl = lbase[q] + __hip_atomic_fetch_add(lcnt + q, 1u, __ATOMIC_RELAXED, __HIP_MEMORY_SCOPE_WORKGROUP); const unsigned cap = set ? CAP1 : CAP0;
                if (sl < cap) { pos = (int)(set ? CAP0 + sl : sl); stok[e * EROWS + pos] = t; sg[e * EROWS + pos] = a; } }
            inv[(size_t)t * 16 + e] = pos;
        }
    }
    __syncthreads();
}

__device__ __forceinline__ void phase_combine(const Frame& F0, int li) {
    Frame F = F0; { size_t z_ = 0; asm volatile("" : "+v"(F.tid), "+v"(F.lane), "+s"(z_), "+s"(F.bid), "+s"(F.G), "+s"(F.wave)); F.ws = F0.ws + z_; F.out = F0.out + z_; }
    const bf16_t* ye = (const bf16_t*)(F.ws + R_YE); const int* inv = (const int*)(F.ws + WS_INV);
    float gg[16], bb[16]; ld16_f32(F.in[I_LN2G] + (size_t)li * D, F.lane, gg); ld16_f32(F.in[I_LN2B] + (size_t)li * D, F.lane, bb);
    const int gw = F.bid * NWAVES + F.wave, nw = F.G * NWAVES;
    for (int row0 = gw; row0 < NTOK; row0 += 4 * nw) {
        u32x4 HR[4][2]; int iv[4];
#pragma unroll
        for (int j = 0; j < 4; ++j) { const int row = row0 + j * nw; iv[j] = -1; if (row < NTOK) { ldraw16(F.hbuf() + (size_t)row * D, F.lane, HR[j]); if (F.lane < 16) iv[j] = inv[(size_t)row * 16 + F.lane]; } }
        u32x4 Y0[4][2], Y1[4][2]; unsigned long long rest[4]; bool h0[4], h1[4];
#pragma unroll
        for (int j = 0; j < 4; ++j) { unsigned long long em = __ballot(iv[j] >= 0) & 0xFFFFull; h0[j] = false; h1[j] = false;
            if (em) { const int e = (int)__builtin_ctzll(em); em &= em - 1; const int p = __shfl(iv[j], e); ldraw16(ye + ((size_t)e * EROWS + p) * D, F.lane, Y0[j]); h0[j] = true; }
            if (em) { const int e = (int)__builtin_ctzll(em); em &= em - 1; const int p = __shfl(iv[j], e); ldraw16(ye + ((size_t)e * EROWS + p) * D, F.lane, Y1[j]); h1[j] = true; }
            rest[j] = em; }
#pragma unroll
        for (int j = 0; j < 4; ++j) { const int row = row0 + j * nw; if (row < NTOK) {
            float x[16]; unpack16(HR[j], x);
#pragma unroll
            for (int i = 0; i < 16; ++i) x[i] *= ALPHA;
            if (h0[j]) { float y[16]; unpack16(Y0[j], y);
#pragma unroll
                for (int i = 0; i < 16; ++i) x[i] += y[i]; }
            if (h1[j]) { float y[16]; unpack16(Y1[j], y);
#pragma unroll
                for (int i = 0; i < 16; ++i) x[i] += y[i]; }
            unsigned long long em = rest[j];
            while (em) { const int e = (int)__builtin_ctzll(em); em &= em - 1; const int p = __shfl(iv[j], e); float y[16]; ld16_bf16(ye + ((size_t)e * EROWS + p) * D, F.lane, y);
#pragma unroll
                for (int i = 0; i < 16; ++i) x[i] += y[i]; }
            float mu, rstd; ln_stats(x, mu, rstd); ln_apply(x, mu, rstd, gg, bb);
            if (li == NLAYER - 1) { const int s = row / LSEQ, t = row - s * LSEQ; if (t >= NMETA) st16_f32(F.out + ((size_t)s * SEQ + (t - NMETA)) * D, F.lane, x); }
            else { st16_bf16(F.hbuf() + (size_t)row * D, F.lane, x); st16_fp8((unsigned char*)F.out + OUT_HIN8 + (size_t)row * D, F.lane, x); } } }
    }
}

__device__ __forceinline__ f32x4 mfma16(bf16x8 x, bf16x8 y, f32x4 c) { return __builtin_amdgcn_mfma_f32_16x16x32_bf16(x, y, c, 0, 0, 0); }
__device__ __forceinline__ float dpp_f(float v, int ctrl_sel) {
    const int x = __float_as_int(v); int r;
    if (ctrl_sel == 0) r = __builtin_amdgcn_update_dpp(0, x, 0xB1, 0xF, 0xF, true);
    else if (ctrl_sel == 1) r = __builtin_amdgcn_update_dpp(0, x, 0x4E, 0xF, 0xF, true);
    else r = __builtin_amdgcn_update_dpp(0, x, 0x141, 0xF, 0xF, true);
    return __int_as_float(r);
}
__device__ __forceinline__ float red8(float v) { v += dpp_f(v, 0); v += dpp_f(v, 1); v += dpp_f(v, 2); return v; }
__device__ __forceinline__ float ldbf(const bf16_t* p) { return bf2f(*p); }

__device__ __forceinline__ bf16x8 pack4_(f32x4 a) { u32x4 r; r.x = pk2(a[0], a[1]); r.y = pk2(a[2], a[3]); r.z = 0u; r.w = 0u; return __builtin_bit_cast(bf16x8, r); }
__device__ __forceinline__ bf16x8 pack8_(f32x4 a, f32x4 b) { u32x4 r; r.x = pk2(a[0], a[1]); r.y = pk2(a[2], a[3]); r.z = pk2(b[0], b[1]); r.w = pk2(b[2], b[3]); return __builtin_bit_cast(bf16x8, r); }
__device__ __forceinline__ bf16x8 ld4_(const LAS bf16_t* p) { const u32x2 v = *(const LAS u32x2*)p; u32x4 r; r.x = v.x; r.y = v.y; r.z = 0u; r.w = 0u; return __builtin_bit_cast(bf16x8, r); }
__device__ __forceinline__ bf16x8 ld44_(const LAS bf16_t* p, const LAS bf16_t* q) { const u32x2 v = *(const LAS u32x2*)p, w = *(const LAS u32x2*)q; u32x4 r; r.x = v.x; r.y = v.y; r.z = w.x; r.w = w.y; return __builtin_bit_cast(bf16x8, r); }
__device__ __forceinline__ void rwkv_task(const Frame& F1, int li, int s, int d, int hg) {
    Frame F = F1; asm volatile("" : "+v"(F.tid), "+v"(F.lane));
    constexpr int DER = 17152;
    LAS float* ST = (LAS float*)(F.lds + 4 * DER);
    constexpr int STS = 260, STB = 2 * 16 * STS * 4;
    LAS bf16_t* TW = (LAS bf16_t*)(F.lds + 4 * DER + STB);
    LAS bf16_t* AD = TW + 16 * 72;
    LAS float* HS = (LAS float*)(F.lds + 4 * DER + STB + 4608);
    const int w = F.wave, hl = w >> 1, half = w & 1, h = 4 * hg + hl, lane = F.lane, fr = lane & 15, fq = lane >> 4, c = 64 * h + lane;
    LAS bf16_t* KAP = (LAS bf16_t*)(F.lds + hl * DER);
    LAS bf16_t* BH = KAP + 16 * 72; LAS bf16_t* KH = BH + 16 * 72; LAS bf16_t* RTL = KH + 16 * 72;
    LAS bf16_t* KBT = RTL + 16 * 72;
    LAS bf16_t* BBT = KBT + 64 * 20; LAS bf16_t* VT = BBT + 64 * 20;
    LAS float* GC = (LAS float*)(VT + 64 * 20);
    const bf16_t* U = F.ubuf();
    const float* mu = F.in[I_MU] + (size_t)li * 1920;
    const bf16_t* W2T = (const bf16_t*)(F.ws + WS_RW2T) + (((size_t)li * 2 + d) * 2 + 0) * 512 * 64 + (size_t)(64 * h + 32 * half + fr) * 64 + fq * 8; const bf16_t* A2T = W2T + (size_t)512 * 64;
    const float mu_r = mu[c], mu_k = mu[512 + c], mu_v = mu[1024 + c];
    const float w0c = F.in[I_W0][((size_t)li * 2 + d) * 512 + c], a0c = F.in[I_A0][((size_t)li * 2 + d) * 512 + c];
    const float kkc = F.in[I_KK][(size_t)li * 512 + c], kac = F.in[I_KA][(size_t)li * 512 + c], rkc = F.in[I_RK][(size_t)li * 512 + c];
    const int p_tt = F.tid >> 5, p_j = (F.tid & 31) * 2;
    const float mu_wd0 = mu[1536 + d * 64 + p_j], mu_wd1 = mu[1537 + d * 64 + p_j], mu_ad0 = mu[1664 + d * 64 + p_j], mu_ad1 = mu[1665 + d * 64 + p_j];
    float* bon = (float*)(F.ws + WS_BON);
    bf16_t* yout = (d == 0 ? F.br() : F.brx());
    const int ldy = (d == 0 ? 2048 : 1024);
    f32x4 Sacc[2][4];
#pragma unroll
    for (int it = 0; it < 2; ++it)
#pragma unroll
        for (int jt = 0; jt < 4; ++jt) Sacc[it][jt] = (f32x4){0.f, 0.f, 0.f, 0.f};
    const size_t rowbase = (size_t)s * LSEQ;
    const bool second = (d == 0) ? (half == 1) : (half == 0);
    unsigned pw[3], pa[3]; unsigned short pr[10], pk_[10], pv[10];
    auto prefetchA = [&](int t0) __attribute__((always_inline)) {
        { const int t = t0 + p_tt; const bf16_t* up = U + (rowbase + t) * N1 + 64 * d + p_j;
          const bf16_t* um = up - ((t > 0) ? N1 : 0); const bf16_t* upl = up + ((t < LSEQ - 1) ? N1 : 0);
          pw[1] = *(const unsigned*)(up + U1_WDN); pa[1] = *(const unsigned*)(up + U1_ADN);
          pw[0] = *(const unsigned*)(um + U1_WDN); pa[0] = *(const unsigned*)(um + U1_ADN);
          pw[2] = *(const unsigned*)(upl + U1_WDN); pa[2] = *(const unsigned*)(upl + U1_ADN); }
    };
    auto prefetchB = [&](int t0) __attribute__((always_inline)) {
        { const int tb = t0 + 8 * half - 1;
#pragma unroll
          for (int i = 0; i < 10; ++i) { int t = tb + i; t = t < 0 ? 0 : (t > LSEQ - 1 ? LSEQ - 1 : t); const bf16_t* up = U + (rowbase + t) * N1 + c;
            pr[i] = up[U1_R]; pk_[i] = up[U1_K]; pv[i] = up[U1_V]; } }
    };
    bf16x8 Xw[2][2], Xa[2][2];
#pragma unroll
    for (int ct = 0; ct < 2; ++ct)
#pragma unroll
        for (int ks = 0; ks < 2; ++ks) { Xw[ct][ks] = *(const bf16x8*)(W2T + ct * 16 * 64 + ks * 32); Xa[ct][ks] = *(const bf16x8*)(A2T + ct * 16 * 64 + ks * 32);
            asm volatile("" : "+v"(Xw[ct][ks]), "+v"(Xa[ct][ks])); }
    auto do_p1 = [&](int t0) __attribute__((always_inline)) {
        { float x[2], y[2];
          const unsigned mkm = (t0 + p_tt > 0) ? 0xffffffffu : 0u, mkp = (t0 + p_tt < LSEQ - 1) ? 0xffffffffu : 0u;
          const unsigned pw0 = pw[0] & mkm, pw2 = pw[2] & mkp, pa0 = pa[0] & mkm, pa2 = pa[2] & mkp;
#pragma unroll
          for (int e = 0; e < 2; ++e) { const int sh = 16 * e;
            const float x0 = bf2f((bf16_t)((pw[1] >> sh) & 0xffffu)), xm = bf2f((bf16_t)((pw0 >> sh) & 0xffffu)), xp = bf2f((bf16_t)((pw2 >> sh) & 0xffffu));
            const float y0 = bf2f((bf16_t)((pa[1] >> sh) & 0xffffu)), ym = bf2f((bf16_t)((pa0 >> sh) & 0xffffu)), yp = bf2f((bf16_t)((pa2 >> sh) & 0xffffu));
            { const float xa_ = x0 + (e ? mu_wd1 : mu_wd0) * (0.5f * (xm + xp) - x0); x[e] = 1.0f - 2.0f * __builtin_amdgcn_rcpf(1.0f + __expf(2.0f * xa_)); } y[e] = y0 + (e ? mu_ad1 : mu_ad0) * (0.5f * (ym + yp) - y0); }
          *(LAS unsigned*)(TW + p_tt * 72 + p_j) = pk2(x[0], x[1]); *(LAS unsigned*)(AD + p_tt * 72 + p_j) = pk2(y[0], y[1]); }
    };
    { const int t00 = (d == 0) ? 0 : LSEQ - 16, t01 = (d == 0) ? 16 : LSEQ - 32;
      prefetchA(t00); prefetchB(t00); do_p1(t00); prefetchA(t01); }
    __syncthreads();
    for (int ci = 0; ci < LSEQ / 16; ++ci) {
        const int t0 = (d == 0) ? 16 * ci : LSEQ - 16 - 16 * ci;
        { bf16x8 Yt[2], Ya[2];
#pragma unroll
          for (int ks = 0; ks < 2; ++ks) { Yt[ks] = *(const LAS bf16x8*)(TW + fr * 72 + ks * 32 + fq * 8); Ya[ks] = *(const LAS bf16x8*)(AD + fr * 72 + ks * 32 + fq * 8); }
#pragma unroll
          for (int ct = 0; ct < 2; ++ct) { f32x4 aw = (f32x4){0.f, 0.f, 0.f, 0.f}, aa = aw;
            aw = mfma16(Xw[ct][0], Yt[0], aw); aw = mfma16(Xw[ct][1], Yt[1], aw); aa = mfma16(Xa[ct][0], Ya[0], aa); aa = mfma16(Xa[ct][1], Ya[1], aa);
            *(LAS f32x4*)(ST + fr * STS + 64 * hl + 32 * half + ct * 16 + 4 * fq) = aw; *(LAS f32x4*)(ST + 16 * STS + fr * STS + 64 * hl + 32 * half + ct * 16 + 4 * fq) = aa; } }
        __syncthreads();
        { const bool lo_ok = (t0 + 8 * half - 1 >= 0), hi_ok = (t0 + 8 * half + 8 < LSEQ);
          if (!lo_ok) { pr[0] = 0; pk_[0] = 0; pv[0] = 0; }
          if (!hi_ok) { pr[9] = 0; pk_[9] = 0; pv[9] = 0; } }
        float lwv[8]; float tot = 0.f, other = 0.f;
#pragma unroll
        for (int i = 0; i < 8; ++i) { lwv[i] = -0.60653065971f * sigmoidf_(ST[(8 * half + i) * STS + 64 * hl + lane] + w0c); tot += lwv[i];
            other += -0.60653065971f * sigmoidf_(ST[(8 * (half ^ 1) + i) * STS + 64 * hl + lane] + w0c); }
        { const float off = second ? other : 0.f, glast = tot + other, eglast = __expf(glast);
          float run = 0.f, bsel = 0.f;
#pragma unroll
          for (int i = 0; i < 8; i += 2) {
            const int tt0 = 8 * half + i;
            const f32x2 rm = (f32x2){bf2f(pr[i]), bf2f(pr[i + 1])}, r1 = (f32x2){bf2f(pr[i + 1]), bf2f(pr[i + 2])}, rp = (f32x2){bf2f(pr[i + 2]), bf2f(pr[i + 3])};
            const f32x2 km = (f32x2){bf2f(pk_[i]), bf2f(pk_[i + 1])}, k1 = (f32x2){bf2f(pk_[i + 1]), bf2f(pk_[i + 2])}, kp = (f32x2){bf2f(pk_[i + 2]), bf2f(pk_[i + 3])};
            const f32x2 vm = (f32x2){bf2f(pv[i]), bf2f(pv[i + 1])}, v1 = (f32x2){bf2f(pv[i + 1]), bf2f(pv[i + 2])}, vp = (f32x2){bf2f(pv[i + 2]), bf2f(pv[i + 3])};
            const f32x2 r = r1 + mu_r * (0.5f * (rm + rp) - r1), k = k1 + mu_k * (0.5f * (km + kp) - k1), v = v1 + mu_v * (0.5f * (vm + vp) - v1);
            const f32x2 al = (f32x2){ST[16 * STS + tt0 * STS + 64 * hl + lane], ST[16 * STS + (tt0 + 1) * STS + 64 * hl + lane]} + a0c;
            const f32x2 a = (f32x2){sigmoidf_(al.x), sigmoidf_(al.y)};
            const f32x2 kd = k * (1.0f + (a - 1.0f) * kac), kk = k * kkc, sq = kk * kk, bs = r * kd * rkc;
            const f32x2 inrm = (f32x2){__builtin_amdgcn_rsqf(fmaxf(wave_sum(sq.x), 1e-24f)), __builtin_amdgcn_rsqf(fmaxf(wave_sum(sq.y), 1e-24f))};
            const float b0 = wave_sum(bs.x), b1 = wave_sum(bs.y);
            bsel = ((lane & 7) == i) ? b0 : (((lane & 7) == i + 1) ? b1 : bsel);
            const f32x2 kkn = kk * inrm, bt = kkn * a;
            run += lwv[i]; const float g0 = off + ((d == 0) ? run : (tot - run + lwv[i]));
            run += lwv[i + 1]; const float g1 = off + ((d == 0) ? run : (tot - run + lwv[i + 1]));
            const f32x2 eg = (f32x2){__expf(g0), __expf(g1)}, eng = (f32x2){__builtin_amdgcn_rcpf(eg.x), __builtin_amdgcn_rcpf(eg.y)}, ebar = eglast * eng;
            const f32x2 egm1 = (f32x2){__expf(g0 - lwv[i]), __expf(g1 - lwv[i + 1])};
            const f32x2 kap = kkn * egm1, bh = bt * eng, kh = kd * eng, rt = r * eg, kb = kd * ebar, bbn = -(bt * ebar);
            const int u0 = (d == 0) ? tt0 : 15 - tt0, u1 = (d == 0) ? u0 + 1 : u0 - 1, ulo = (d == 0) ? u0 : u1;
            { const unsigned p = pk2(kap.x, kap.y); KAP[u0 * 72 + lane] = (bf16_t)(p & 0xffffu); KAP[u1 * 72 + lane] = (bf16_t)(p >> 16); }
            { const unsigned p = pk2(bh.x, bh.y); BH[u0 * 72 + lane] = (bf16_t)(p & 0xffffu); BH[u1 * 72 + lane] = (bf16_t)(p >> 16); }
            { const unsigned p = pk2(kh.x, kh.y); KH[u0 * 72 + lane] = (bf16_t)(p & 0xffffu); KH[u1 * 72 + lane] = (bf16_t)(p >> 16); }
            { const unsigned p = pk2(rt.x, rt.y); RTL[u0 * 72 + lane] = (bf16_t)(p & 0xffffu); RTL[u1 * 72 + lane] = (bf16_t)(p >> 16); }
            { unsigned p = pk2(kb.x, kb.y); if (d) p = (p >> 16) | (p << 16); *(LAS unsigned*)(KBT + lane * 20 + ulo) = p; }
            { unsigned p = pk2(bbn.x, bbn.y); if (d) p = (p >> 16) | (p << 16); *(LAS unsigned*)(BBT + lane * 20 + ulo) = p; }
            { unsigned p = pk2(v.x, v.y); if (d) p = (p >> 16) | (p << 16); *(LAS unsigned*)(VT + lane * 20 + ulo) = p; } }
          bon[(rowbase + t0 + 8 * half + (lane & 7)) * 16 + d * 8 + h] = bsel;
          if (half == 0) GC[lane] = eglast; }
        if (ci + 1 < LSEQ / 16) { const int t1 = (d == 0) ? t0 + 16 : t0 - 16;
            prefetchB(t1);
            do_p1(t1);
            if (ci + 2 < LSEQ / 16) prefetchA((d == 0) ? t0 + 32 : t0 - 32); }
        __syncthreads();
        f32x4 aA = (f32x4){0.f, 0.f, 0.f, 0.f}, aAT = aA, aBT = aA, aC1 = aA, aC2 = aA;
#pragma unroll
        for (int ks = 0; ks < 2; ++ks) { const int o = fr * 72 + 32 * ks + 8 * fq;
            const bf16x8 fK = *(const LAS bf16x8*)(KAP + o), fB = *(const LAS bf16x8*)(BH + o), fH = *(const LAS bf16x8*)(KH + o), fR = *(const LAS bf16x8*)(RTL + o);
            aA = mfma16(fK, fB, aA); aAT = mfma16(fB, fK, aAT); aBT = mfma16(fH, fK, aBT); aC1 = mfma16(fH, fR, aC1); aC2 = mfma16(fB, fR, aC2); }
        f32x4 N, NT, H1;
#pragma unroll
        for (int e = 0; e < 4; ++e) { const int row = 4 * fq + e;
            N[e] = (fr < row) ? -aA[e] : 0.f; NT[e] = (row < fr) ? -aAT[e] : 0.f; aBT[e] = (row < fr) ? aBT[e] : 0.f;
            aC1[e] = (row <= fr) ? aC1[e] : 0.f; aC2[e] = (row <= fr) ? aC2[e] : 0.f; H1[e] = NT[e] + ((row == fr) ? 1.0f : 0.f); }
        const f32x4 Z4 = (f32x4){0.f, 0.f, 0.f, 0.f};
        const bf16x8 pN = pack4_(N), pNT = pack4_(NT);
        const f32x4 N2 = mfma16(pNT, pN, Z4), N2T = mfma16(pN, pNT, Z4);
        const bf16x8 pN2 = pack4_(N2), pN2T = pack4_(N2T);
        const f32x4 N4 = mfma16(pN2T, pN2, Z4), N4T = mfma16(pN2, pN2T, Z4);
        const bf16x8 pN4 = pack4_(N4);
        const f32x4 N8 = mfma16(pack4_(N4T), pN4, Z4);
        const f32x4 G1T = mfma16(pN2, pack4_(H1), H1);
        const f32x4 G2T = mfma16(pN4, pack4_(G1T), G1T);
        const f32x4 TT = mfma16(pack4_(N8), pack4_(G2T), G2T);
        const bf16x8 pTT = pack4_(TT), pBT = pack4_(aBT), pC1 = pack4_(aC1), pC2 = pack4_(aC2);
#pragma unroll
        for (int it = 0; it < 2; ++it) {
            const int i0 = 32 * half + 16 * it;
            const bf16x8 Vf = ld4_(VT + (i0 + fr) * 20 + 4 * fq);
            const bf16x8 Sf0 = pack8_(Sacc[it][0], Sacc[it][1]), Sf1 = pack8_(Sacc[it][2], Sacc[it][3]);
            f32x4 R = mfma16(ld44_(KAP + fr * 72 + 4 * fq, KAP + fr * 72 + 16 + 4 * fq), Sf0, Z4);
            R = mfma16(ld44_(KAP + fr * 72 + 32 + 4 * fq, KAP + fr * 72 + 48 + 4 * fq), Sf1, R);
            R = mfma16(pBT, Vf, R);
            const f32x4 Uu = mfma16(pTT, pack4_(R), Z4);
            f32x4 y = mfma16(Sf0, ld44_(RTL + fr * 72 + 4 * fq, RTL + fr * 72 + 16 + 4 * fq), Z4);
            y = mfma16(Sf1, ld44_(RTL + fr * 72 + 32 + 4 * fq, RTL + fr * 72 + 48 + 4 * fq), y);
            y = mfma16(Vf, pC1, y);
            const bf16x8 pU = pack4_(Uu), pUn = pack4_(-Uu);
            y = mfma16(pUn, pC2, y);
            { const int t = (d == 0) ? (t0 + fr) : (t0 + 15 - fr); u32x2 o; o.x = pk2(y[0], y[1]); o.y = pk2(y[2], y[3]);
              *(u32x2*)(yout + (rowbase + t) * ldy + 512 + 64 * h + i0 + 4 * fq) = o; }
#pragma unroll
            for (int jt = 0; jt < 4; ++jt) { const f32x4 dc = *(const LAS f32x4*)(GC + 16 * jt + 4 * fq);
                f32x4 acc = Sacc[it][jt] * dc;
                acc = mfma16(ld4_(KBT + (16 * jt + fr) * 20 + 4 * fq), Vf, acc);
                acc = mfma16(ld4_(BBT + (16 * jt + fr) * 20 + 4 * fq), pU, acc);
                Sacc[it][jt] = acc; }
            __builtin_amdgcn_sched_barrier(0);
        }
    }
    __syncthreads();
}

__device__ __forceinline__ void lru_block(const Frame& F1, int li, int s, int d, int g) {
    Frame F = F1; asm volatile("" : "+v"(F.tid), "+v"(F.lane));
    const int lane = F.lane, fr = lane & 15, fq = lane >> 4, c = 64 * g + lane;
    LAS bf16_t* XCT = (LAS bf16_t*)F.lds + F.wave * (16 * 72);
    constexpr int RSS = 68;
    LAS float* RS = (LAS float*)(F.lds + 18432) + F.wave * (3 * 16 * RSS);
    const bf16_t* U = F.ubuf();
    bf16x8 Xr[4][2], Xi[4][2];
    { const bf16_t* wrt = (const bf16_t*)(F.ws + WS_LRUT) + ((((size_t)li * 2 + d) * 2 + 0) * 8 + g) * 64 * 64; const bf16_t* wit = wrt + (size_t)8 * 64 * 64;
#pragma unroll
      for (int ct = 0; ct < 4; ++ct)
#pragma unroll
        for (int ks = 0; ks < 2; ++ks) { Xr[ct][ks] = *(const bf16x8*)(wrt + (ct * 16 + fr) * 64 + ks * 32 + fq * 8); Xi[ct][ks] = *(const bf16x8*)(wit + (ct * 16 + fr) * 64 + ks * 32 + fq * 8); } }
    const float* cw = F.in[I_CONVW] + (size_t)li * 4 * 512;
    const float cw0 = cw[c], cw1 = cw[512 + c], cw2 = cw[1024 + c], cw3 = cw[1536 + c], cb = F.in[I_CONVB][(size_t)li * 512 + c];
    const float brc = F.in[I_BR][((size_t)li * 2 + d) * 512 + c], bic = F.in[I_BI][((size_t)li * 2 + d) * 512 + c];
    const float lamfac = -8.0f * softplusf_(-F.in[I_LAM][((size_t)li * 2 + d) * 512 + c]);
    bf16_t* hout = (d == 0 ? F.br() : F.brx()); const int ldy = (d == 0 ? 2048 : 1024);
    const size_t rowbase = (size_t)s * LSEQ;
    float hs = 0.f;
    unsigned short px[19];
    auto lru_prefetch = [&](int t0) {
#pragma unroll
        for (int i = 0; i < 19; ++i) { int t = t0 - 2 + i; t = t < 0 ? 0 : (t > LSEQ - 1 ? LSEQ - 1 : t); px[i] = U[(rowbase + t) * N1 + U1_AX + c]; } };
    lru_prefetch((d == 0) ? 0 : LSEQ - 16);
    for (int ci = 0; ci < LSEQ / 16; ++ci) {
        const int t0 = (d == 0) ? 16 * ci : LSEQ - 16 - 16 * ci;
        { float xa[19];
#pragma unroll
          for (int i = 0; i < 19; ++i) { const int t = t0 - 2 + i; xa[i] = (t >= 0 && t < LSEQ) ? bf2f(px[i]) : 0.f; }
          if (ci + 1 < LSEQ / 16) lru_prefetch((d == 0) ? t0 + 16 : t0 - 16);
#pragma unroll
          for (int tt = 0; tt < 16; ++tt) { const float xc = cb + cw0 * xa[tt] + cw1 * xa[tt + 1] + cw2 * xa[tt + 2] + cw3 * xa[tt + 3];
            XCT[tt * 72 + lane] = f2bf(xc); RS[32 * RSS + tt * RSS + lane] = xc; } }
        { bf16x8 Y[2];
#pragma unroll
          for (int ks = 0; ks < 2; ++ks) Y[ks] = *(const LAS bf16x8*)(XCT + fr * 72 + ks * 32 + fq * 8);
#pragma unroll
          for (int ct = 0; ct < 4; ++ct) { f32x4 ar = (f32x4){0.f, 0.f, 0.f, 0.f}, ai = ar;
            ar = mfma16(Xr[ct][0], Y[0], ar); ar = mfma16(Xr[ct][1], Y[1], ar); ai = mfma16(Xi[ct][0], Y[0], ai); ai = mfma16(Xi[ct][1], Y[1], ai);
            *(LAS f32x4*)(RS + fr * RSS + ct * 16 + 4 * fq) = ar; *(LAS f32x4*)(RS + 16 * RSS + fr * RSS + ct * 16 + 4 * fq) = ai; } }
        { float av[16], bbv[16];
#pragma unroll
          for (int i = 0; i < 16; ++i) { const int tt = (d == 0) ? i : 15 - i;
            const float r = sigmoidf_(RS[tt * RSS + lane] + brc), ig = sigmoidf_(RS[16 * RSS + tt * RSS + lane] + bic), xc = RS[32 * RSS + tt * RSS + lane];
            const float a = __expf(lamfac * r); av[i] = a; bbv[i] = __builtin_amdgcn_sqrtf(fmaxf(1.0f - a * a, 0.f)) * ig * xc; }
#pragma unroll
          for (int i = 0; i < 16; ++i) { const int tt = (d == 0) ? i : 15 - i; hs = av[i] * hs + bbv[i]; hout[(rowbase + t0 + tt) * ldy + c] = f2bf(hs); } }
    }
}
__device__ __forceinline__ void lru_task(const Frame& F, int li, int s, int d) { lru_block(F, li, s, d, F.wave); __syncthreads(); }

__device__ __forceinline__ void phase_scan1(const Frame& F0, int li) {
    Frame F = F0; { size_t z_ = 0; asm volatile("" : "+v"(F.tid), "+v"(F.lane), "+s"(z_), "+s"(F.bid), "+s"(F.G), "+s"(F.wave)); F.ws = F0.ws + z_; F.out = F0.out + z_; }
    if (F.G == 256) {
        if (F.bid < 192) rwkv_task(F, li, F.bid >> 2, (F.bid >> 1) & 1, F.bid & 1);
        else {
            const int j = F.bid - 192, b0 = 12 * j + F.wave;
            lru_block(F, li, b0 >> 4, (b0 >> 3) & 1, b0 & 7);
            if (F.wave < 4) { const int b1 = 12 * j + 8 + F.wave; lru_block(F, li, b1 >> 4, (b1 >> 3) & 1, b1 & 7); }
            __syncthreads(); }
    } else {
        for (int task = F.bid; task < 288; task += F.G) {
            if (task < 192) rwkv_task(F, li, task >> 2, (task >> 1) & 1, task & 1);
            else lru_task(F, li, (task - 192) >> 1, (task - 192) & 1);
        }
    }
}

__device__ __forceinline__ void phase_post1(const Frame& F0, int li) {
    Frame F = F0; { size_t z_ = 0; asm volatile("" : "+v"(F.tid), "+v"(F.lane), "+s"(z_), "+s"(F.bid), "+s"(F.G), "+s"(F.wave)); F.ws = F0.ws + z_; F.out = F0.out + z_; }
    const int lane = F.lane, fr = lane & 15, fq = lane >> 4;
    LAS bf16_t* SG = (LAS bf16_t*)F.lds + F.wave * (16 * 136);
    const bf16_t* U = F.ubuf(); const bf16_t* G2T = (const bf16_t*)(F.ws + WS_G2T) + (size_t)li * 512 * 128;
    const float* mu = F.in[I_MU] + (size_t)li * 1920; const float* bon = (const float*)(F.ws + WS_BON);
    const float* lng = F.in[I_LNXG] + (size_t)li * 512; const float* lnb = F.in[I_LNXB] + (size_t)li * 512;
    bf16_t* BR = F.br(); const bf16_t* BRX = F.brx();
    LAS float* PM = (LAS float*)(F.lds + 40960);
    for (int i = F.tid; i < 512; i += NTHREADS) { PM[i] = mu[1024 + i]; PM[512 + i] = lng[i]; PM[1024 + i] = lnb[i]; }
    __syncthreads();
    const int gw = F.bid * NWAVES + F.wave, nw = F.G * NWAVES;
    for (int tile = gw; tile < NTOK / 16; tile += nw) {
        const int row0 = tile * 16;
#pragma unroll 4
        for (int r = 0; r < 16; ++r) { bf16_t* p = BR + (size_t)(row0 + r) * 2048 + 8 * lane; const u32x4 a = *(const u32x4*)p, b = *(const u32x4*)(BRX + (size_t)(row0 + r) * 1024 + 8 * lane);
            const unsigned aw[4] = {a.x, a.y, a.z, a.w}, bw[4] = {b.x, b.y, b.z, b.w}; unsigned o[4];
#pragma unroll
            for (int j = 0; j < 4; ++j) o[j] = pk2(bf2f((bf16_t)(aw[j] & 0xffffu)) + bf2f((bf16_t)(bw[j] & 0xffffu)), bf2f((bf16_t)(aw[j] >> 16)) + bf2f((bf16_t)(bw[j] >> 16)));
            u32x4 w; w.x = o[0]; w.y = o[1]; w.z = o[2]; w.w = o[3]; *(u32x4*)p = w; }
#pragma unroll 4
        for (int r = 0; r < 16; ++r) { const int row = row0 + r, s = row / LSEQ, t = row - s * LSEQ; const bf16_t* up = U + (size_t)row * N1 + U1_GDN + 2 * lane;
            const unsigned x0 = *(const unsigned*)up, xm = (t > 0) ? *(const unsigned*)(up - N1) : 0u, xp = (t < LSEQ - 1) ? *(const unsigned*)(up + N1) : 0u;
            const float m0 = mu[1792 + 2 * lane], m1 = mu[1793 + 2 * lane];
            const float a0 = bf2f((bf16_t)(x0 & 0xffffu)), a1 = bf2f((bf16_t)(x0 >> 16));
            const float g0 = a0 + m0 * (0.5f * (bf2f((bf16_t)(xm & 0xffffu)) + bf2f((bf16_t)(xp & 0xffffu))) - a0), g1 = a1 + m1 * (0.5f * (bf2f((bf16_t)(xm >> 16)) + bf2f((bf16_t)(xp >> 16))) - a1);
            *(LAS unsigned*)(SG + r * 136 + 2 * lane) = pk2(sigmoidf_(g0), sigmoidf_(g1)); }
        bf16x8 Y[4];
#pragma unroll
        for (int ks = 0; ks < 4; ++ks) Y[ks] = *(const LAS bf16x8*)(SG + fr * 136 + ks * 32 + fq * 8);
        const int row = row0 + fr, s = row / LSEQ, t = row - s * LSEQ;
        struct HIn { u32x2 a[4], b[4], v0[4], vm[4], vp[4]; float b0, b1; };
        auto hload = [&](int h, HIn& I) __attribute__((always_inline)) {
#pragma unroll
            for (int ct = 0; ct < 4; ++ct) { const int col = 512 + 64 * h + ct * 16 + 4 * fq; I.a[ct] = *(const u32x2*)(BR + (size_t)row * 2048 + col); I.b[ct] = *(const u32x2*)(BRX + (size_t)row * 1024 + col);
                const bf16_t* up = U + (size_t)row * N1 + U1_V + 64 * h + ct * 16 + 4 * fq;
                I.v0[ct] = *(const u32x2*)up; I.vm[ct] = *(const u32x2*)(up - ((t > 0) ? N1 : 0)); I.vp[ct] = *(const u32x2*)(up + ((t < LSEQ - 1) ? N1 : 0)); }
            I.b0 = bon[(size_t)row * 16 + h]; I.b1 = bon[(size_t)row * 16 + 8 + h]; };
        auto hcomp = [&](int h, const HIn& I) __attribute__((always_inline)) {
            f32x4 gacc[4];
#pragma unroll
            for (int ct = 0; ct < 4; ++ct) { gacc[ct] = (f32x4){0.f, 0.f, 0.f, 0.f};
#pragma unroll
                for (int ks = 0; ks < 4; ++ks) { const bf16x8 X = *(const bf16x8*)(G2T + (size_t)(64 * h + ct * 16 + fr) * 128 + ks * 32 + fq * 8); gacc[ct] = mfma16(X, Y[ks], gacc[ct]); } }
            float y[16]; float sm = 0.f;
#pragma unroll
            for (int ct = 0; ct < 4; ++ct) { const u32x2 a = I.a[ct], b = I.b[ct];
                y[4 * ct] = bf2f((bf16_t)(a.x & 0xffffu)) + bf2f((bf16_t)(b.x & 0xffffu)); y[4 * ct + 1] = bf2f((bf16_t)(a.x >> 16)) + bf2f((bf16_t)(b.x >> 16));
                y[4 * ct + 2] = bf2f((bf16_t)(a.y & 0xffffu)) + bf2f((bf16_t)(b.y & 0xffffu)); y[4 * ct + 3] = bf2f((bf16_t)(a.y >> 16)) + bf2f((bf16_t)(b.y >> 16)); }
#pragma unroll
            for (int i = 0; i < 16; ++i) sm += y[i];
            sm = rows_sum(sm);
            const float mean = sm * (1.0f / 64.0f); float q = 0.f;
#pragma unroll
            for (int i = 0; i < 16; ++i) { const float dl = y[i] - mean; q += dl * dl; }
            q = rows_sum(q);
            const float rstd = rsqrtf(q * (1.0f / 64.0f) + 64e-5f);
            const float bsum = I.b0 + I.b1;
            const unsigned mkm = (t > 0) ? 0xffffffffu : 0u, mkp = (t < LSEQ - 1) ? 0xffffffffu : 0u;
#pragma unroll
            for (int ct = 0; ct < 4; ++ct) { const int cc = 64 * h + ct * 16 + 4 * fq;
                const f32x4 pmu = *(const LAS f32x4*)(PM + cc), pg = *(const LAS f32x4*)(PM + 512 + cc), pb = *(const LAS f32x4*)(PM + 1024 + cc);
                const unsigned v0w[2] = {I.v0[ct].x, I.v0[ct].y}, vmw[2] = {I.vm[ct].x & mkm, I.vm[ct].y & mkm}, vpw[2] = {I.vp[ct].x & mkp, I.vp[ct].y & mkp}; float o[4];
#pragma unroll
                for (int e = 0; e < 4; ++e) { const int sh = (e & 1) * 16; const float x0 = bf2f((bf16_t)((v0w[e >> 1] >> sh) & 0xffffu)), xm = bf2f((bf16_t)((vmw[e >> 1] >> sh) & 0xffffu)), xp = bf2f((bf16_t)((vpw[e >> 1] >> sh) & 0xffffu));
                    const float v = x0 + pmu[e] * (0.5f * (xm + xp) - x0);
                    const float yn = (y[4 * ct + e] - mean) * rstd * pg[e] + pb[e];
                    o[e] = (yn + bsum * v) * gacc[ct][e]; }
                u32x2 w; w.x = pk2(o[0], o[1]); w.y = pk2(o[2], o[3]);
                *(u32x2*)(BR + (size_t)row * 2048 + 512 + cc) = w; } };
        HIn hN, hC;
        hload(0, hN);
#pragma unroll 1
        for (int h = 0; h < 8; ++h) { hC = hN;
            if (h + 1 < 8) hload(h + 1, hN);
            hcomp(h, hC); }
    }
    __syncthreads();
}

template <int DK>
__device__ __forceinline__ void gla_task(const Frame& F1, int li, int s, int hd, int d) {
    Frame F = F1; asm volatile("" : "+v"(F.tid), "+v"(F.lane));
    constexpr bool RET = (DK == 64); constexpr int QS = DK + 8, TS = 72, NDT = DK / 16, NKS = DK / 32;
    LAS bf16_t* QT = (LAS bf16_t*)F.lds;
    LAS bf16_t* KT = QT + 64 * QS;
    LAS bf16_t* KBT = KT + 64 * QS;
    LAS bf16_t* VT = KBT + DK * TS;
    LAS float* DEC = (LAS float*)(VT + 128 * TS);
    const int lane = F.lane, w = F.wave, fr = lane & 15, fq = lane >> 4, tid = F.tid;
    const bf16_t* U = F.ubuf();
    bf16_t* oout = (d == 0 ? F.br() : F.brx()); const int ldy = (d == 0 ? 2048 : 1024);
    const int ocol = (d == 0 ? (RET ? 1536 : 1024) : (RET ? 512 : 0)) + 128 * hd;
    const size_t rowbase = (size_t)s * LSEQ;
    const int pd = tid & 127, pg = tid >> 7;
    float lbv = 0.f, lgam = 0.f, invf = 0.f, cth = 1.f, sth = 0.f;
    if constexpr (!RET) lbv = ((const float*)(F.ws + WS_LB))[(size_t)li * 512 + 128 * hd + pd];
    else { const float gam = sigmoidf_(F.in[I_RDEC][((size_t)li * 2 + d) * 4 + hd]); lgam = __logf(gam);
           invf = expf(-(float)(tid & 31) * (9.210340371976184f / 32.0f)); cth = cosf(invf); sth = (d == 0) ? sinf(invf) : -sinf(invf); }
    f32x4 Sacc[NDT];
#pragma unroll
    for (int i = 0; i < NDT; ++i) Sacc[i] = (f32x4){0.f, 0.f, 0.f, 0.f};
    unsigned short ra[16], rb[16], rc[16];
    const int ri = tid & 31; const bool risk = (tid & 32) != 0; const int rg2 = tid >> 6;
    auto prefetch = [&](int sc) { const int nt = (sc < 32) ? 64 : 16, tau0 = 64 * sc;
        if (16 * pg < nt) { const int tb = tau0 + 16 * pg;
#pragma unroll
            for (int i = 0; i < 16; ++i) { const int t = d ? (LSEQ - 1 - (tb + i)) : (tb + i); const bf16_t* up = U + (rowbase + t) * N2 + 128 * hd + pd;
                if constexpr (!RET) { ra[i] = up[U2_CQ]; rb[i] = up[U2_CF + 512 * d]; rc[i] = up[U2_CI]; } else rc[i] = up[U2_DV]; } }
        if constexpr (RET) { if (8 * rg2 < nt) { const int tb = tau0 + 8 * rg2; const int tfirst = d ? (LSEQ - 1 - tb) : tb;
#pragma unroll
            for (int j = 0; j < 8; ++j) { const int t = d ? (tfirst - j) : (tfirst + j); const bf16_t* up = U + (rowbase + t) * N2 + (risk ? U2_DK : U2_DQ) + 64 * hd + ri; ra[j] = up[0]; rb[j] = up[32]; } } } };
    prefetch(0);
    for (int sc = 0; sc < 33; ++sc) {
        const int nt = (sc < 32) ? 64 : 16, nsub = nt >> 4, tau0 = 64 * sc;
        if (16 * pg < nt) {
            if constexpr (!RET) {
                float kk[16]; float eb = 1.0f;
#pragma unroll
                for (int i = 0; i < 16; ++i) { const float fr_ = bf2f(rb[i]), sg = sigmoidf_(fr_); const float f = lbv + (1.0f - lbv) * sg, k = (1.0f - lbv) * (1.0f - sg);
                    eb *= f; const float enb = __builtin_amdgcn_rcpf(eb); const float q = siluf_(bf2f(ra[i])) * 0.08838834764831845f;
                    QT[(16 * pg + i) * QS + pd] = f2bf(q * eb); KT[(16 * pg + i) * QS + pd] = f2bf(k * enb); kk[i] = k * enb;
                    VT[pd * TS + 16 * pg + i] = rc[i]; }
#pragma unroll
                for (int i = 0; i < 16; i += 2) *(LAS unsigned*)(KBT + pd * TS + 16 * pg + i) = pk2(kk[i] * eb, kk[i + 1] * eb);
                DEC[pg * DK + pd] = eb;
            } else {
#pragma unroll
                for (int i = 0; i < 16; ++i) VT[pd * TS + 16 * pg + i] = rc[i];
                if (pd < 64) DEC[pg * DK + pd] = __expf(16.0f * lgam);
            }
        }
        if constexpr (RET) {
            if (8 * rg2 < nt) {
                const int tb = tau0 + 8 * rg2; const int tfirst = d ? (LSEQ - 1 - tb) : tb;
                const float ang = (float)tfirst * invf; float cs = cosf(ang), sn = sinf(ang);
#pragma unroll
                for (int j = 0; j < 8; ++j) { const int tl = 8 * rg2 + j, il = tl & 15; const float x1 = bf2f(ra[j]), x2 = bf2f(rb[j]);
                    const float o1 = x1 * cs - x2 * sn, o2 = x1 * sn + x2 * cs;
                    if (!risk) { const float sc_ = __expf((float)(il + 1) * lgam); QT[tl * QS + ri] = f2bf(o1 * sc_); QT[tl * QS + ri + 32] = f2bf(o2 * sc_); }
                    else { const float s1 = 0.125f * __expf(-(float)(il + 1) * lgam), s2 = 0.125f * __expf((float)(15 - il) * lgam);
                        KT[tl * QS + ri] = f2bf(o1 * s1); KT[tl * QS + ri + 32] = f2bf(o2 * s1); KBT[ri * TS + tl] = f2bf(o1 * s2); KBT[(ri + 32) * TS + tl] = f2bf(o2 * s2); }
                    const float cn = cs * cth - sn * sth; sn = sn * cth + cs * sth; cs = cn; }
            }
        }
        if (sc + 1 < 33) prefetch(sc + 1);
        __syncthreads();
#pragma unroll 2
        for (int g = 0; g < nsub; ++g) {
            const int r0 = 16 * g;
            f32x4 aacc = (f32x4){0.f, 0.f, 0.f, 0.f};
#pragma unroll
            for (int ks = 0; ks < NKS; ++ks) { const bf16x8 X = *(const LAS bf16x8*)(KT + (r0 + fr) * QS + 32 * ks + 8 * fq), Y = *(const LAS bf16x8*)(QT + (r0 + fr) * QS + 32 * ks + 8 * fq); aacc = mfma16(X, Y, aacc); }
#pragma unroll
            for (int e = 0; e < 4; ++e) aacc[e] = (4 * fq + e <= fr) ? aacc[e] : 0.f;
            u32x4 ya; ya.x = pk2(aacc[0], aacc[1]); ya.y = pk2(aacc[2], aacc[3]); ya.z = 0u; ya.w = 0u;
            const u32x2 vv = *(const LAS u32x2*)(VT + (16 * w + fr) * TS + r0 + 4 * fq);
            u32x4 xv; xv.x = vv.x; xv.y = vv.y; xv.z = 0u; xv.w = 0u;
            f32x4 o = (f32x4){0.f, 0.f, 0.f, 0.f};
            o = mfma16(__builtin_bit_cast(bf16x8, xv), __builtin_bit_cast(bf16x8, ya), o);
#pragma unroll
            for (int ks = 0; ks < NKS; ++ks) { u32x4 xs; xs.x = pk2(Sacc[2 * ks][0], Sacc[2 * ks][1]); xs.y = pk2(Sacc[2 * ks][2], Sacc[2 * ks][3]); xs.z = pk2(Sacc[2 * ks + 1][0], Sacc[2 * ks + 1][1]); xs.w = pk2(Sacc[2 * ks + 1][2], Sacc[2 * ks + 1][3]);
                const u32x2 q0 = *(const LAS u32x2*)(QT + (r0 + fr) * QS + 32 * ks + 4 * fq), q1 = *(const LAS u32x2*)(QT + (r0 + fr) * QS + 32 * ks + 16 + 4 * fq);
                u32x4 yq; yq.x = q0.x; yq.y = q0.y; yq.z = q1.x; yq.w = q1.y;
                o = mfma16(__builtin_bit_cast(bf16x8, xs), __builtin_bit_cast(bf16x8, yq), o); }
            { const int tau = tau0 + r0 + fr, t = d ? (LSEQ - 1 - tau) : tau; u32x2 ov; ov.x = pk2(o[0], o[1]); ov.y = pk2(o[2], o[3]);
              *(u32x2*)(oout + (rowbase + t) * ldy + ocol + 16 * w + 4 * fq) = ov; }
#pragma unroll
            for (int dt = 0; dt < NDT; ++dt) { const f32x4 dc = *(const LAS f32x4*)(DEC + g * DK + 16 * dt + 4 * fq);
                const u32x2 kb = *(const LAS u32x2*)(KBT + (16 * dt + fr) * TS + r0 + 4 * fq); u32x4 xk; xk.x = kb.x; xk.y = kb.y; xk.z = 0u; xk.w = 0u;
                Sacc[dt] = mfma16(__builtin_bit_cast(bf16x8, xk), __builtin_bit_cast(bf16x8, xv), Sacc[dt] * dc); }
        }
        __syncthreads();
    }
}
__device__ __forceinline__ void phase_scan2(const Frame& F0, int li) {
    Frame F = F0; { size_t z_ = 0; asm volatile("" : "+v"(F.tid), "+v"(F.lane), "+s"(z_), "+s"(F.bid), "+s"(F.G), "+s"(F.wave)); F.ws = F0.ws + z_; F.out = F0.out + z_; }
    for (int task = F.bid; task < 768; task += F.G) {
        const int k = task % 384, s = k >> 3, hd = (k >> 1) & 3, d = k & 1;
                if (task < 384) gla_task<128>(F, li, s, hd, d); else gla_task<64>(F, li, s, hd, d);
    }
}
__device__ __forceinline__ void phase_post2(const Frame& F0, int li) {
    Frame F = F0; { size_t z_ = 0; asm volatile("" : "+v"(F.tid), "+v"(F.lane), "+s"(z_), "+s"(F.bid), "+s"(F.G), "+s"(F.wave)); F.ws = F0.ws + z_; F.out = F0.out + z_; }
    const int lane = F.lane; bf16_t* BR = F.br(); const bf16_t* BRX = F.brx();
    { unsigned* hist = (unsigned*)(F.ws + WS_HIST); for (int i = F.bid * NTHREADS + F.tid; i < 32 * 1024; i += F.G * NTHREADS) hist[i] = 0u; }
    const float* ng = F.in[I_HNG] + (size_t)li * 512 + 8 * lane;
    float g8[8];
#pragma unroll
    for (int i = 0; i < 8; ++i) g8[i] = ng[i];
    const int gw = F.bid * NWAVES + F.wave, nw = F.G * NWAVES;
    for (int row0 = gw; row0 < NTOK; row0 += 4 * nw) {
        u32x4 A[4][2], B[4][2];
#pragma unroll
        for (int j = 0; j < 4; ++j) { const int row = row0 + j * nw; if (row < NTOK) {
#pragma unroll
            for (int sec = 0; sec < 2; ++sec) { A[j][sec] = __builtin_nontemporal_load((const u32x4*)(BR + (size_t)row * 2048 + 1024 + 512 * sec + 8 * lane)); B[j][sec] = __builtin_nontemporal_load((const u32x4*)(BRX + (size_t)row * 1024 + 512 * sec + 8 * lane)); } } }
#pragma unroll
        for (int j = 0; j < 4; ++j) { const int row = row0 + j * nw; if (row < NTOK) {
#pragma unroll
            for (int sec = 0; sec < 2; ++sec) {
                const unsigned aw[4] = {A[j][sec].x, A[j][sec].y, A[j][sec].z, A[j][sec].w}, bw[4] = {B[j][sec].x, B[j][sec].y, B[j][sec].z, B[j][sec].w}; float o[8];
#pragma unroll
                for (int i = 0; i < 4; ++i) { o[2 * i] = bf2f((bf16_t)(aw[i] & 0xffffu)) + bf2f((bf16_t)(bw[i] & 0xffffu)); o[2 * i + 1] = bf2f((bf16_t)(aw[i] >> 16)) + bf2f((bf16_t)(bw[i] >> 16)); }
                float sm = 0.f;
                if (sec == 1) {
#pragma unroll
                    for (int i = 0; i < 8; ++i) sm += o[i];
                    sm += dppx(sm, 0); sm += dppx(sm, 1); sm += dppx(sm, 2); sm += dppx(sm, 3);
                    sm *= (1.0f / 128.0f); }
                float q = 0.f;
#pragma unroll
                for (int i = 0; i < 8; ++i) { o[i] -= sm; q += o[i] * o[i]; }
                q += dppx(q, 0); q += dppx(q, 1); q += dppx(q, 2); q += dppx(q, 3);
                const float rs = rsqrtf(q * (1.0f / 128.0f) + 1e-6f);
#pragma unroll
                for (int i = 0; i < 8; ++i) o[i] = o[i] * rs * (sec == 0 ? g8[i] : 1.0f);
                u32x4 wv; wv.x = pk2(o[0], o[1]); wv.y = pk2(o[2], o[3]); wv.z = pk2(o[4], o[5]); wv.w = pk2(o[6], o[7]);
                *(u32x4*)(BR + (size_t)row * 2048 + 1024 + 512 * sec + 8 * lane) = wv; } } }
    }
}

constexpr int NPL = 17, NPHASE = 1 + NLAYER * NPL;
__global__ void __launch_bounds__(NTHREADS, 2) mega(Args args) {
    extern __shared__ __attribute__((aligned(16))) unsigned char lds_raw[];
    Frame F; F.in = args.in; F.out = args.out; F.ws = args.ws; F.lds = (LAS unsigned char*)lds_raw; F.ldsg = lds_raw;
    F.tid = threadIdx.x; F.lane = F.tid & 63; F.wave = __builtin_amdgcn_readfirstlane(F.tid >> 6); F.G = gridDim.x; F.bid = blockIdx.x;
    const int lo = args.ph_lo, hi = args.ph_hi;
    const bool single = (hi - lo) > 1;
    volatile LAS unsigned* misc = (volatile LAS unsigned*)(F.lds + LDS_MISC);
    if (F.tid < 8) misc[F.tid] = 0u;
    __syncthreads();
    XcdBarrier bar; bar.bar = (unsigned*)(F.ws + WS_CTL) + CW_BAR; bar.x = 0; bar.st = misc;
    if (single) bar = xcd_barrier_post((unsigned*)(F.ws + WS_CTL) + CW_BAR, misc);
#ifndef PH_MASK
#define PH_MASK 0xFFFFFFu
#endif
#define PHON(o) (((PH_MASK) >> (o)) & 1u)
#ifndef DUP_MASK
#define DUP_MASK 0u
#endif
#define DUPN(o) (1 + (int)(((DUP_MASK) >> (o)) & 1u))
#define CJ_A1 1130
#define CJ_A2 2230
#define CJ_G  3658
#define CJ_P  4074
#define CJ_M  4096
#define IN(k) (lo <= (k) && (k) < hi)
#define SEAM(k) do { if (IN(k) && IN((k) + 1)) xcd_barrier(bar); } while (0)
    LAS unsigned char* glds = F.lds;
    if (PHON(20) && IN(0)) { phase_prep_weights(F); phase_embed(F); }
    SEAM(0);
    if (single) {
        if (F.tid == 0) { unsigned ok = ((F.G & 7) == 0) ? 1u : 0u;
            for (int j = 0; j < 16; ++j) { const unsigned cj = xb_ld(bar.bar + XB_XCNT(j)); if (j < 8 ? (cj != (unsigned)F.G / 8u) : (cj != 0u)) ok = 0u; }
            const unsigned r = misc[2]; misc[3] = (ok && bar.x < 8u && r < (unsigned)F.G / 8u) ? (r * 8u + bar.x) : (unsigned)F.bid; }
        __syncthreads();
        F.bid = __builtin_amdgcn_readfirstlane((int)misc[3]);
    }
    for (int li = 0; li < NLAYER; ++li) {
        const int pb = 1 + li * NPL;
        for (int rep = 0; rep < DUPN(0); ++rep) if (PHON(0) && IN(pb + 0)) { Frame Fq = F; { size_t z_ = 0; asm volatile("" : "+s"(z_), "+s"(Fq.bid), "+s"(Fq.G)); Fq.ws = F.ws + z_; Fq.out = F.out + z_; } const Frame& F = Fq;
            SchedPlain S; S.T.init(NTILE_M, N1 / 256, F.G, F.bid); S.A = (const char*)F.hbuf(); S.B = (const char*)(F.ws + WS_W1T + (size_t)li * N1 * D * 2); S.astep = (size_t)256 * D * 2; S.bstep = (size_t)256 * D * 2;
            EpiStoreBf16 E; E.O0 = E.O1 = E.O2 = E.O3 = F.ubuf(); E.ldo = N1;
            pg8::gemm_phase<EpiStoreBf16, SchedPlain, false>(glds, D, D, D, S, E); }
        if (PHON(0) && IN(pb + 0)) phase_prep_experts(F, li, 0, CJ_A1, NTILE_M * (N1 / 256));
        SEAM(pb + 0);
        for (int rep = 0; rep < DUPN(1); ++rep) if (PHON(1) && IN(pb + 1)) phase_scan1(F, li);
        SEAM(pb + 1);
        if (PHON(2) && IN(pb + 2)) phase_post1(F, li);
        SEAM(pb + 2);
        for (int rep = 0; rep < DUPN(3); ++rep) if (PHON(3) && IN(pb + 3)) { Frame Fq = F; { size_t z_ = 0; asm volatile("" : "+s"(z_), "+s"(Fq.bid), "+s"(Fq.G)); Fq.ws = F.ws + z_; Fq.out = F.out + z_; } const Frame& F = Fq;
            SchedPlain S; S.T.init(NTILE_M, N2 / 256, F.G, F.bid); S.A = (const char*)F.hbuf(); S.B = (const char*)(F.ws + WS_W2T + (size_t)li * N2 * D * 2); S.astep = (size_t)256 * D * 2; S.bstep = (size_t)256 * D * 2;
            EpiStoreBf16 E; E.O0 = E.O1 = E.O2 = E.O3 = F.ubuf(); E.ldo = N2;
            pg8::gemm_phase<EpiStoreBf16, SchedPlain, false>(glds, D, D, D, S, E); }
        if (PHON(3) && IN(pb + 3)) phase_prep_experts(F, li, CJ_A1, CJ_A2, NTILE_M * (N2 / 256));
        SEAM(pb + 3);
        for (int rep = 0; rep < DUPN(4); ++rep) if (PHON(4) && IN(pb + 4)) phase_scan2(F, li);
        SEAM(pb + 4);
        if (PHON(5) && IN(pb + 5)) phase_post2(F, li);
        SEAM(pb + 5);
        if (PHON(6) && IN(pb + 6)) { Frame Fq = F; { size_t z_ = 0; asm volatile("" : "+s"(z_), "+s"(Fq.bid), "+s"(Fq.G)); Fq.ws = F.ws + z_; Fq.out = F.out + z_; } const Frame& F = Fq;
            SchedPlain S; S.T.init(NTILE_M, NG / 256, F.G, F.bid); S.A = (const char*)F.hbuf(); S.B = (const char*)(F.ws + WS_WGT + (size_t)li * NG * D * 2); S.astep = (size_t)256 * D * 2; S.bstep = (size_t)256 * D * 2;
            EpiGate E; E.BR = F.br();
            pg8::gemm_phase<EpiGate, SchedPlain, false>(glds, D, D, D, S, E); }
        if (PHON(6) && IN(pb + 6)) phase_prep_experts(F, li, CJ_A2, CJ_G, NTILE_M * (NG / 256));
        SEAM(pb + 6);
        for (int rep = 0; rep < DUPN(7); ++rep) if (PHON(7) && IN(pb + 7)) { Frame Fq = F; { size_t z_ = 0; asm volatile("" : "+s"(z_), "+s"(Fq.bid), "+s"(Fq.G)); Fq.ws = F.ws + z_; Fq.out = F.out + z_; } const Frame& F = Fq;
            SchedP S; S.T.init(NTILE_M, 16, F.G, F.bid); S.A = (const char*)F.br(); S.B = (const char*)(F.ws + WS_WBT + (size_t)li * 4 * D * 512 * 2);
            EpiStoreBf16 E; E.O0 = F.pb(0); E.O1 = F.pb(1); E.O2 = F.pb(2); E.O3 = F.pb(3); E.ldo = D;
            pg8::gemm_phase<EpiStoreBf16, SchedP, false>(glds, 512, 2048, 512, S, E); }
        if (PHON(7) && IN(pb + 7)) phase_prep_experts(F, li, CJ_G, CJ_P, NTILE_M * 16);
        SEAM(pb + 7);
        for (int rep = 0; rep < DUPN(8); ++rep) if (PHON(8) && IN(pb + 8)) { Frame Fq = F; { size_t z_ = 0; asm volatile("" : "+s"(z_), "+s"(Fq.bid), "+s"(Fq.G)); Fq.ws = F.ws + z_; Fq.out = F.out + z_; } const Frame& F = Fq;
            SchedPlain S; S.T.init(NTILE_M, NM / 256, F.G, F.bid); S.A = (const char*)F.out + OUT_HIN8; S.B = (const char*)(F.ws + WS_WMT + (size_t)li * NM * D); S.astep = (size_t)256 * D; S.bstep = (size_t)256 * D;
            EpiMerge E; E.PB0 = F.pb(0); E.PB1 = F.pb(1); E.PB2 = F.pb(2); E.PB3 = F.pb(3); E.MG = (bf16_t*)(F.ws + R_MERGED);
            pg8::gemm_phase<EpiMerge, SchedPlain, false, true>(glds, D / 2, D / 2, D / 2, S, E); }
        if (PHON(8) && IN(pb + 8)) phase_prep_experts(F, li, CJ_P, CJ_M, NTILE_M * (NM / 256));
        SEAM(pb + 8);
        if (PHON(9) && IN(pb + 9) && ((F.bid & 1) == 0)) phase_prep_experts(F, li, CJ_M, NE * 384, 4 * NTILE_M);
        for (int rep = 0; rep < DUPN(9); ++rep) if (PHON(9) && IN(pb + 9)) { Frame Fq = F; { size_t z_ = 0; asm volatile("" : "+s"(z_), "+s"(Fq.bid), "+s"(Fq.G)); Fq.ws = F.ws + z_; Fq.out = F.out + z_; } const Frame& F = Fq;
            SchedPlain S; S.T.init(NTILE_M, D / 256, F.G, F.bid); S.A = (const char*)(F.ws + R_MERGED); S.B = (const char*)(F.ws + WS_WOT + (size_t)li * D * D * 2); S.astep = (size_t)256 * D * 2; S.bstep = (size_t)256 * D * 2;
            EpiOut E; E.H = F.hbuf(); E.X1 = (bf16_t*)(F.ws + R_X1);
            pg8::gemm_phase<EpiOut, SchedPlain, false>(glds, D, D, D, S, E); }
        if (PHON(9) && IN(pb + 9) && ((F.bid & 1) == 1)) phase_prep_experts(F, li, CJ_M, NE * 384, 4 * NTILE_M);
        SEAM(pb + 9);
        if (PHON(10) && IN(pb + 10)) phase_ln1_router(F, li);
        SEAM(pb + 10);
        for (int p = 1; p < 4; ++p) { if (PHON(11) && IN(pb + 10 + p)) phase_topk(F, p); SEAM(pb + 10 + p); }
        for (int rnd = 0; rnd < 1; ++rnd) {
            for (int rep = 0; rep < DUPN(15); ++rep) if (PHON(15) && IN(pb + 14 + 2 * rnd)) { Frame Fq = F; { size_t z_ = 0; asm volatile("" : "+s"(z_), "+s"(Fq.bid), "+s"(Fq.G)); Fq.ws = F.ws + z_; Fq.out = F.out + z_; } const Frame& F = Fq;
                SchedE1 S; S.T.init(NE * ETILES, 16, F.G, F.bid); S.A = (const char*)(F.ws + R_H8); S.B = (const char*)F.out + OUT_W13; S.stok = (const int*)(F.ws + WS_STOK); S.e0 = 0;
                EpiSwiglu E; E.HE = (unsigned char*)(F.ws + R_HE);
                pg8::gemm_phase<EpiSwiglu, SchedE1, true, true>(glds, D / 2, D / 2, D / 2, S, E); }
            SEAM(pb + 14 + 2 * rnd);
            for (int rep = 0; rep < DUPN(16); ++rep) if (PHON(16) && IN(pb + 15 + 2 * rnd)) { Frame Fq = F; { size_t z_ = 0; asm volatile("" : "+s"(z_), "+s"(Fq.bid), "+s"(Fq.G)); Fq.ws = F.ws + z_; Fq.out = F.out + z_; } const Frame& F = Fq;
                SchedE2 S; S.T.init(NE * ETILES, 4, F.G, F.bid); S.A = (const char*)(F.ws + R_HE); S.B = (const char*)F.out + OUT_W2; S.e0 = 0;
                EpiScale E; E.YE = (bf16_t*)(F.ws + R_YE); E.SG = (const float*)(F.ws + WS_SGATE);
                pg8::gemm_phase<EpiScale, SchedE2, false, true>(glds, DFF / 2, DFF / 2, DFF / 2, S, E); }
            SEAM(pb + 15 + 2 * rnd);
        }
        if (PHON(19) && IN(pb + 16)) phase_combine(F, li);
        SEAM(pb + 16);
    }
}

#ifndef MK_SINGLE
#define MK_SINGLE 1
#endif
extern "C" void kernel_launch(void* const* d_in, const int* in_sizes, int n_in, void* d_out, int out_size, void* d_ws, size_t ws_size, hipStream_t stream) {
    static int grid = 0;
    if (grid == 0) {
        if (n_in != 37 || in_sizes[0] != NSEQ0 * SEQ * D || out_size != NSEQ * SEQ * D || ws_size < WS_END) {
            fprintf(stderr, "kernel_launch: unexpected shapes: n_in %d in0 %d out %d ws %zu (need %zu); nothing launched\n", n_in, n_in > 0 ? in_sizes[0] : -1, out_size, ws_size, (size_t)WS_END); grid = -1; return; }
        int dev = 0, cus = 0, per_cu = 0;
        if (hipGetDevice(&dev) != hipSuccess || hipDeviceGetAttribute(&cus, hipDeviceAttributeMultiprocessorCount, dev) != hipSuccess) { grid = -1; return; }
        if (hipFuncSetAttribute((const void*)mega, hipFuncAttributeMaxDynamicSharedMemorySize, LDS_BYTES) != hipSuccess) { fprintf(stderr, "kernel_launch: hipFuncSetAttribute failed\n"); grid = -1; return; }
        if (hipOccupancyMaxActiveBlocksPerMultiprocessor(&per_cu, (const void*)mega, NTHREADS, LDS_BYTES) != hipSuccess || per_cu < 1) fprintf(stderr, "kernel_launch: occupancy query reports %d\n", per_cu);
        (void)hipGetLastError();
        grid = cus;
    }
    if (grid < 0) return;
    if (hipMemsetAsync((char*)d_ws + WS_CTL, 0, CTL_BYTES, stream) != hipSuccess) return;
    Args a{};
    for (int i = 0; i < 37; ++i) a.in[i] = (const float*)d_in[i];
    a.out = (float*)d_out; a.ws = (unsigned char*)d_ws;
#if MK_SINGLE
    a.ph_lo = 0; a.ph_hi = NPHASE;
    hipLaunchKernelGGL(mega, dim3(grid), dim3(NTHREADS), LDS_BYTES, stream, a);
#else
    for (int p = 0; p < NPHASE; ++p) { a.ph_lo = p; a.ph_hi = p + 1; hipLaunchKernelGGL(mega, dim3(grid), dim3(NTHREADS), LDS_BYTES, stream, a); }
#endif
}
```

```cpp
#include <hip/hip_runtime.h>
#include <cstdio>
#include <cstdint>
#include <cstddef>

#define LAS __attribute__((address_space(3)))
typedef unsigned short bf16_t;
typedef short bf16x8 __attribute__((ext_vector_type(8)));
typedef float f32x4 __attribute__((ext_vector_type(4)));
typedef float f32x2 __attribute__((ext_vector_type(2)));
typedef unsigned u32x4 __attribute__((ext_vector_type(4)));
typedef unsigned u32x2 __attribute__((ext_vector_type(2)));

constexpr int D = 1024, LSEQ = 2064, NSEQ = 48, NTOK = NSEQ * LSEQ, NMETA = 16, SEQ = 2048, NSEQ0 = 32, TOK0 = NSEQ0 * LSEQ;
constexpr int N_IN = 11136, NLAYER = 2;
constexpr int N1 = 2560, N2 = 3072, NG = 1536, NM = 4096;
constexpr int NE = 16, DFF = 2048, CAP0 = 8256, CAP1 = 4128, EVALID = CAP0 + CAP1, EROWS = 12544, ETILES = EROWS / 256;
constexpr int NTILE_M = NTOK / 256;
static_assert(NTOK % 256 == 0, "token tiling");
constexpr float ALPHA = 1.41421356237f;
constexpr int NTHREADS = 512, NWAVES = 8;
constexpr int LDS_BYTES = 147456;
constexpr int LDS_MISC = LDS_BYTES - 64;

constexpr int U1_AX = 0, U1_R = 512, U1_K = 1024, U1_V = 1536, U1_WDN = 2048, U1_ADN = 2176, U1_GDN = 2304;
constexpr int U2_CQ = 0, U2_CF = 512, U2_CI = 1536, U2_DQ = 2048, U2_DK = 2304, U2_DV = 2560;

constexpr size_t al256(size_t x) { return (x + 255) & ~(size_t)255; }
constexpr size_t WS_CTL = 0, CTL_BYTES = 65536;
constexpr size_t WS_AFF = WS_CTL + CTL_BYTES;
constexpr size_t WS_INV = WS_AFF + al256((size_t)NTOK * 16 * 4);
constexpr size_t WS_STOK = WS_INV + al256((size_t)NTOK * 16 * 4);
constexpr size_t WS_SGATE = WS_STOK + al256((size_t)NE * EROWS * 4);
constexpr size_t WS_HIST = WS_SGATE + al256((size_t)NE * EROWS * 4);
constexpr size_t WS_BON = WS_HIST + al256((size_t)3 * 32 * 1024 * 4);
constexpr size_t WS_G2T = WS_BON + al256((size_t)NTOK * 16 * 4);
constexpr size_t WS_LB = WS_G2T + al256((size_t)2 * 512 * 128 * 2);
constexpr size_t WS_RW2T = WS_LB + al256((size_t)2 * 512 * 4);
constexpr size_t WS_LRUT = WS_RW2T + al256((size_t)2 * 2 * 2 * 512 * 64 * 2);
constexpr size_t WS_HBUF = WS_LRUT + al256((size_t)2 * 2 * 2 * 8 * 64 * 64 * 2);
constexpr size_t WS_W1T = WS_HBUF + al256((size_t)NTOK * D * 2);
constexpr size_t WS_W2T = WS_W1T + al256((size_t)2 * N1 * D * 2);
constexpr size_t WS_WGT = WS_W2T + al256((size_t)2 * N2 * D * 2);
constexpr size_t WS_WMT = WS_WGT + al256((size_t)2 * NG * D * 2);
constexpr size_t WS_WBT = WS_WMT + al256((size_t)2 * NM * D * 2);
constexpr size_t WS_WOT = WS_WBT + al256((size_t)2 * 4 * D * 512 * 2);
constexpr size_t WS_R = WS_WOT + al256((size_t)2 * D * D * 2);
constexpr size_t SZ_TD2 = (size_t)NTOK * D * 2;
constexpr size_t R_BR = WS_R;
constexpr size_t R_U = WS_R + 2 * SZ_TD2;
constexpr size_t R_PB = R_U;
constexpr size_t R_MERGED = WS_R;
constexpr size_t R_H8 = WS_R;
constexpr size_t OUT_HIN8 = SZ_TD2;
constexpr size_t OUT_W13 = OUT_HIN8 + (size_t)NTOK * D;
constexpr size_t OUT_W2 = (size_t)NE * 4096 * D;
static_assert(OUT_W13 + (size_t)NE * 4096 * D <= (size_t)NSEQ * SEQ * D * 4, "W13t must fit in d_out");
constexpr float WM_SCALE = 32.0f;
constexpr float W13_SCALE = 32.0f, W2_SCALE = 64.0f;
constexpr size_t R_X1 = R_U;
constexpr size_t R_WEXP = WS_R;
constexpr size_t SZ_W13 = (size_t)NE * 4096 * D * 2, SZ_W2E = (size_t)NE * D * DFF * 2;
constexpr size_t R_YE = R_WEXP + SZ_W13 + SZ_W2E;
constexpr size_t SZ_YE = (size_t)NE * EROWS * D * 2;
constexpr size_t R_HE = R_YE + SZ_YE;
constexpr size_t SZ_HE = (size_t)8 * EROWS * DFF * 2;
constexpr size_t WS_END_A = R_U + (size_t)NTOK * N2 * 2;
constexpr size_t WS_END_B = R_HE + SZ_HE;
constexpr size_t WS_END = WS_END_A > WS_END_B ? WS_END_A : WS_END_B;

constexpr int CW_BAR = 0;
constexpr int CW_CNT = 4096;
constexpr int CW_TIE = 4160;

__device__ __forceinline__ float bf2f(bf16_t v) { return __uint_as_float(((unsigned)v) << 16); }
typedef __bf16 bf16n2 __attribute__((ext_vector_type(2)));
__device__ __forceinline__ unsigned pk2(float lo, float hi) { const f32x2 v = {lo, hi}; return __builtin_bit_cast(unsigned, __builtin_convertvector(v, bf16n2)); }
__device__ __forceinline__ bf16_t f2bf(float f) { return (bf16_t)(pk2(f, 0.f) & 0xffffu); }
__device__ __forceinline__ unsigned pk4_fp8(float a, float b, float c, float d) { int p = __builtin_amdgcn_cvt_pk_fp8_f32(a, b, 0, false); p = __builtin_amdgcn_cvt_pk_fp8_f32(c, d, p, true); return (unsigned)p; }
__device__ __forceinline__ float sigmoidf_(float x) { return __builtin_amdgcn_rcpf(1.0f + __expf(-x)); }
__device__ __forceinline__ float siluf_(float x) { return x * __builtin_amdgcn_rcpf(1.0f + __expf(-x)); }
__device__ __forceinline__ float gelu_tanh_(float x) { const float u = 1.5957691216f * (x + 0.044715f * x * x * x); return x * __builtin_amdgcn_rcpf(1.0f + __expf(-u)); }
__device__ __forceinline__ float softplusf_(float x) { return fmaxf(x, 0.f) + log1pf(__expf(-fabsf(x))); }
__device__ __forceinline__ float dppx(float v, int sel) {
    const int x = __float_as_int(v); int r;
    if (sel == 0) r = __builtin_amdgcn_update_dpp(0, x, 0xB1, 0xF, 0xF, true);
    else if (sel == 1) r = __builtin_amdgcn_update_dpp(0, x, 0x4E, 0xF, 0xF, true);
    else if (sel == 2) r = __builtin_amdgcn_update_dpp(0, x, 0x141, 0xF, 0xF, true);
    else r = __builtin_amdgcn_update_dpp(0, x, 0x140, 0xF, 0xF, true);
    return __int_as_float(r);
}
typedef unsigned u32x2_pl __attribute__((ext_vector_type(2)));
__device__ __forceinline__ float rows_sum(float v) {
    const unsigned x = __float_as_uint(v);
    const u32x2_pl a = __builtin_amdgcn_permlane16_swap(x, x, false, false);
    const float s = __uint_as_float(a[0]) + __uint_as_float(a[1]);
    const unsigned y = __float_as_uint(s);
    const u32x2_pl b = __builtin_amdgcn_permlane32_swap(y, y, false, false);
    return __uint_as_float(b[0]) + __uint_as_float(b[1]);
}
__device__ __forceinline__ float wave_sum(float v) {
    v += dppx(v, 0); v += dppx(v, 1); v += dppx(v, 2); v += dppx(v, 3);
    return rows_sum(v);
}

#define XB_TMO      128
#define XB_XCNT(j)  (256  + 64 * (j))
#define XB_XSUB(j)  (1280 + 64 * (j))
#define XB_XGEN(j)  (2304 + 64 * (j))
#define XB_TOP      3328
#define XB_TOPGEN   3392
#define XCD_BAR_WORDS 3456
#define XB_SPIN_CAP (1u << 23)
__device__ __forceinline__ unsigned xb_ld(unsigned* p)              { return __hip_atomic_load(p, __ATOMIC_RELAXED, __HIP_MEMORY_SCOPE_AGENT); }
__device__ __forceinline__ unsigned xb_add(unsigned* p, unsigned v) { return __hip_atomic_fetch_add(p, v, __ATOMIC_RELAXED, __HIP_MEMORY_SCOPE_AGENT); }
__device__ __forceinline__ unsigned xb_xcc_id() { return (unsigned)__builtin_amdgcn_s_getreg((3 << 11) | 20) & 0xFu; }
#define XB_SPIN(cond, bar) do { unsigned _sp = 0; while (cond) { __builtin_amdgcn_s_sleep(1); \
    if ((++_sp & 255u) == 0u) { if (xb_ld(&(bar)[XB_TMO])) break; if (_sp > XB_SPIN_CAP) { atomicAdd(&(bar)[XB_TMO], 1u); break; } } } } while (0)
struct XcdBarrier { unsigned* bar; unsigned x; volatile LAS unsigned* st; };
__device__ __forceinline__ XcdBarrier xcd_barrier_post(unsigned* bar, volatile LAS unsigned* st) {
    XcdBarrier b; b.bar = bar; b.x = xb_xcc_id(); b.st = st;
    if (threadIdx.x == 0) st[2] = xb_add(&bar[XB_XCNT(b.x)], 1u);
    return b;
}
__device__ __forceinline__ void xcd_barrier_complete(unsigned* bar, unsigned x, unsigned& nloc, unsigned& nx) {
    const unsigned G = gridDim.x * gridDim.y * gridDim.z;
    unsigned sum, cnt, mine, sp = 0u;
    for (;;) {
        sum = 0u; cnt = 0u; mine = 0u;
#pragma unroll
        for (unsigned j = 0; j < 16; ++j) { const unsigned c = xb_ld(&bar[XB_XCNT(j)]); sum += c; cnt += (c > 0u) ? 1u : 0u; mine = (j == x) ? c : mine; }
        if (sum == G) break;
        __builtin_amdgcn_s_sleep(1);
        if ((++sp & 255u) == 0u) { if (xb_ld(&bar[XB_TMO])) break; if (sp > XB_SPIN_CAP) { atomicAdd(&bar[XB_TMO], 1u); break; } }
    }
    nloc = mine > 0u ? mine : 1u; nx = cnt > 0u ? cnt : 1u;
}
__device__ __forceinline__ void xcd_barrier(const XcdBarrier& b) {
    asm volatile("s_waitcnt vmcnt(0)" ::: "memory");
    __syncthreads();
    if (threadIdx.x == 0) {
        unsigned* bar = b.bar;
        __builtin_amdgcn_s_waitcnt(0);
        unsigned nloc = b.st[0], nx = b.st[1];
        if (nloc == 0u) { xcd_barrier_complete(bar, b.x, nloc, nx); b.st[0] = nloc; b.st[1] = nx; }
        const unsigned old = xb_add(&bar[XB_XSUB(b.x)], 1u);
        const unsigned gen = old / nloc;
        if (old + 1u == (gen + 1u) * nloc) {
            __builtin_amdgcn_fence(__ATOMIC_RELEASE, "agent");
            asm volatile("s_waitcnt vmcnt(0)" ::: "memory");
            const unsigned og = xb_add(&bar[XB_TOP], 1u);
            const unsigned tg = og / nx;
            if (og + 1u == (tg + 1u) * nx) xb_add(&bar[XB_TOPGEN], 1u);
            else XB_SPIN(xb_ld(&bar[XB_TOPGEN]) == tg, bar);
            __builtin_amdgcn_fence(__ATOMIC_ACQUIRE, "agent");
            xb_add(&bar[XB_XGEN(b.x)], 1u);
            asm volatile("s_waitcnt vmcnt(0)" ::: "memory");
        } else {
            XB_SPIN(xb_ld(&bar[XB_XGEN(b.x)]) == gen, bar);
            __builtin_amdgcn_fence(__ATOMIC_ACQUIRE, "agent");
            asm volatile("s_waitcnt vmcnt(0)" ::: "memory");
        }
    }
    __syncthreads();
}

namespace pg8 {
constexpr int BM = 256, BK = 64, HALF = 128, HTB = HALF * BK * 2, STAGE_BYTES = 8 * HTB, NXCD = 8, WGM = 8;
__host__ __device__ __forceinline__ int lds_byte(int r, int c) { const int st = (r >> 4) * 2 + (c >> 5), rr = r & 15, cc = c & 31, ob = rr * 64 + cc * 2; return st * 1024 + (ob ^ (((ob >> 9) & 1) << 5)); }
__host__ __device__ __forceinline__ void stage_rc(int b, int& R, int& C) { const int st = b / 1024, sb = b % 1024, swz = sb ^ (((sb >> 9) & 1) << 5); R = (st >> 1) * 16 + swz / 64; C = (st & 1) * 32 + (swz % 64) / 2; }
__host__ __device__ __forceinline__ int perm32(int rho) { const int n = rho >> 4, i = rho & 15; return 8 * (i >> 2) + 4 * n + (i & 3); }

struct Unit { int pm, pn, aux; const char* A; const char* B; const int* rows; };

struct TileOrder {
    int nM, nN, nwg, G, c;
    __device__ __forceinline__ void init(int nM_, int nN_, int G_, int c_) { nM = nM_; nN = nN_; nwg = nM * nN; G = G_; c = c_; }
    __device__ __forceinline__ bool tile(int i, int& pm, int& pn) const {
        const long L = (long)i * G + c; if (L >= nwg) return false;
        int wgid = (int)L; { const int q = nwg / NXCD, r = nwg % NXCD, xcd = wgid % NXCD, off = wgid / NXCD; wgid = (xcd < r ? xcd * (q + 1) : r * (q + 1) + (xcd - r) * q) + off; }
        const int nig = WGM * nN, gid = wgid / nig, fm = gid * WGM, gsz = (nM - fm) < WGM ? (nM - fm) : WGM;
        pm = fm + ((wgid % nig) % gsz); pn = (wgid % nig) / gsz; return true;
    }
};

typedef int i32x4_ __attribute__((ext_vector_type(4)));
typedef int i32x8_ __attribute__((ext_vector_type(8)));
__device__ __forceinline__ i32x8_ cat8(bf16x8 a, bf16x8 b) { const i32x4_ x = __builtin_bit_cast(i32x4_, a), y = __builtin_bit_cast(i32x4_, b); return __builtin_shufflevector(x, y, 0, 1, 2, 3, 4, 5, 6, 7); }
template <class Epi, class Sched, bool GATHER, bool F8 = false>
__device__ __forceinline__ void gemm_phase(LAS unsigned char* lds, const int K, const int lda, const int ldb, const Sched& S, const Epi& E) {
    int tid = threadIdx.x; asm volatile("" : "+v"(tid));
    const int wid = __builtin_amdgcn_readfirstlane(tid >> 6), lane = tid & 63, wr = wid >> 2, wc = wid & 3, fr = lane & 15, fq = lane >> 4;
    const int nt = K / BK;
    unsigned voffA[2][2], nvA[2][2], voffB[2];
#pragma unroll
    for (int i = 0; i < 2; ++i) { int R, C; stage_rc(tid * 16 + i * 8192, R, C); const int Rb = Epi::PERM ? ((R & ~31) + perm32(R & 31)) : R;
        voffB[i] = (unsigned)(Rb * ldb + C) * 2u;
#pragma unroll
        for (int h = 0; h < 2; ++h) { voffA[h][i] = (unsigned)((R + h * HALF) * lda + C) * 2u; nvA[h][i] = voffA[h][i]; } }
    const size_t kstep = (size_t)(BK * 2);
    const size_t hstepB = (size_t)HALF * ldb * 2;
    const unsigned ldsw = (unsigned)wid * 1024u;
    const int aoff = lds_byte(wr * 64 + fr, fq * 8), boff = lds_byte(wc * 32 + fr, fq * 8);
#define PG8_SA(b, h) (((b) * 2 + (h)) * HTB)
#define PG8_SB(b, h) ((4 + (b) * 2 + (h)) * HTB)
#define PG8_STAGE(bufoff, gbase, voff) do { _Pragma("unroll") for (int _i = 0; _i < 2; ++_i) \
        __builtin_amdgcn_global_load_lds((const unsigned*)((const char*)(gbase) + (voff)[_i]), (LAS unsigned*)(lds + (bufoff) + ldsw + _i * 8192), 16, 0, 0); } while (0)
#define PG8_LDA(dst, b, h) do { _Pragma("unroll") for (int m = 0; m < 4; ++m) { if constexpr (F8) { const i32x4_ lo_ = *(const LAS i32x4_*)(lds + PG8_SA(b, h) + aoff + m * 2048), hi_ = *(const LAS i32x4_*)(lds + PG8_SA(b, h) + aoff + m * 2048 + 1024); \
            dst##8[m] = __builtin_shufflevector(lo_, hi_, 0, 1, 2, 3, 4, 5, 6, 7); } else { _Pragma("unroll") for (int k = 0; k < 2; ++k) dst[m][k] = *(const LAS bf16x8*)(lds + PG8_SA(b, h) + aoff + m * 2048 + k * 1024); } } } while (0)
#define PG8_LDB(dst, b, h) do { _Pragma("unroll") for (int n = 0; n < 2; ++n) { if constexpr (F8) { const i32x4_ lo_ = *(const LAS i32x4_*)(lds + PG8_SB(b, h) + boff + n * 2048), hi_ = *(const LAS i32x4_*)(lds + PG8_SB(b, h) + boff + n * 2048 + 1024); \
            dst##8[n] = __builtin_shufflevector(lo_, hi_, 0, 1, 2, 3, 4, 5, 6, 7); } else { _Pragma("unroll") for (int k = 0; k < 2; ++k) dst[n][k] = *(const LAS bf16x8*)(lds + PG8_SB(b, h) + boff + n * 2048 + k * 1024); } } } while (0)
#define PG8_MMA(ai, bj, At, Bt) do { __builtin_amdgcn_s_setprio(1); _Pragma("unroll") for (int m = 0; m < 4; ++m) _Pragma("unroll") for (int n = 0; n < 2; ++n) { \
        if constexpr (F8) asm volatile("v_mfma_scale_f32_16x16x128_f8f6f4 %0, %1, %2, %0, %3, %3 op_sel_hi:[0,0,0]" : "+v"(acc[ai][bj][m][n]) : "v"(Bt##8[n]), "v"(At##8[m]), "v"(f8scale));   \
        else { _Pragma("unroll") for (int k = 0; k < 2; ++k) acc[ai][bj][m][n] = __builtin_amdgcn_mfma_f32_16x16x32_bf16(Bt[n][k], At[m][k], acc[ai][bj][m][n], 0, 0, 0); } } \
        __builtin_amdgcn_s_setprio(0); } while (0)
#define PG8_WAIT_V(n) asm volatile("s_waitcnt vmcnt(" #n ")" ::: "memory")
#define PG8_WAIT_L(n) asm volatile("s_waitcnt lgkmcnt(" #n ")" ::: "memory")
#define PG8_BAR __builtin_amdgcn_s_barrier()
#define PG8_SCHED __builtin_amdgcn_sched_barrier(0)
#define PG8_GATHER(dst, u) do { if constexpr (GATHER) { _Pragma("unroll") for (int _i = 0; _i < 2; ++_i) { int _R, _C; stage_rc(tid * 16 + _i * 8192, _R, _C); _Pragma("unroll") for (int _h = 0; _h < 2; ++_h) \
        dst[_h][_i] = ((unsigned)(u).rows[_R + _h * HALF] * (unsigned)lda + (unsigned)_C) * 2u; } } } while (0)
#define PG8_GATHER_LD(dst, u) do { _Pragma("unroll") for (int _i = 0; _i < 2; ++_i) { int _R, _C; stage_rc(tid * 16 + _i * 8192, _R, _C); _Pragma("unroll") for (int _h = 0; _h < 2; ++_h) dst[_h][_i] = (unsigned)(u).rows[_R + _h * HALF]; } } while (0)
#define PG8_GATHER_CV(dst, srcv) do { _Pragma("unroll") for (int _i = 0; _i < 2; ++_i) { int _R, _C; stage_rc(tid * 16 + _i * 8192, _R, _C); _Pragma("unroll") for (int _h = 0; _h < 2; ++_h) dst[_h][_i] = (srcv[_h][_i] * (unsigned)lda + (unsigned)_C) * 2u; } } while (0)
    Unit cur, nxt; int ui = 0;
    if (!S.next(0, cur)) return;
    f32x4 acc[2][2][4][2];
#pragma unroll
    for (int a = 0; a < 2; ++a)
#pragma unroll
        for (int b = 0; b < 2; ++b)
#pragma unroll
            for (int m = 0; m < 4; ++m)
#pragma unroll
                for (int n = 0; n < 2; ++n) acc[a][b][m][n] = (f32x4){0.f, 0.f, 0.f, 0.f};
    bf16x8 At[4][2], B0[2][2], B1[2][2];
    const int f8scale = 0x7f7f7f7f;
    i32x8_ At8[4], B08[2], B18[2];
    const char* cA = cur.A; const char* cB = cur.B;
    PG8_GATHER(voffA, cur);
    unsigned raw1[2][2];
    if constexpr (GATHER) { Unit n1; if (S.next(1, n1)) { PG8_GATHER_LD(raw1, n1); } }
    PG8_STAGE(PG8_SB(0, 0), cB, voffB); PG8_STAGE(PG8_SA(0, 0), cA, voffA[0]); PG8_STAGE(PG8_SB(0, 1), cB + hstepB, voffB); PG8_STAGE(PG8_SA(0, 1), cA, voffA[1]);
    if (wr == 1) PG8_BAR;
    PG8_WAIT_V(4); PG8_BAR;
    PG8_STAGE(PG8_SB(1, 0), cB + kstep, voffB); PG8_STAGE(PG8_SA(1, 0), cA + kstep, voffA[0]); PG8_STAGE(PG8_SB(1, 1), cB + hstepB + kstep, voffB);
    PG8_WAIT_V(6); PG8_BAR;
    for (;;) {
        const bool has_next = S.next(ui + 1, nxt);
        const char* nA = has_next ? nxt.A : cA; const char* nB = has_next ? nxt.B : cB;
        if constexpr (GATHER) {
            if (has_next) { PG8_GATHER_CV(nvA, raw1); } else {
#pragma unroll
            for (int h = 0; h < 2; ++h)
#pragma unroll
                for (int i = 0; i < 2; ++i) nvA[h][i] = voffA[h][i]; }
            { Unit n2; if (S.next(ui + 2, n2)) { PG8_GATHER_LD(raw1, n2); } } }
        for (int t = 0; t < nt; t += 2) {
            const bool last = (t == nt - 2);
            const char* a1 = cA + (size_t)(t + 1) * kstep;
            const char* a2 = last ? nA : cA + (size_t)(t + 2) * kstep; const char* b2 = last ? nB : cB + (size_t)(t + 2) * kstep;
            const char* a3 = a2 + kstep; const char* b3 = b2 + kstep;
            unsigned vA0[2], vA1[2];
            if constexpr (GATHER) { vA0[0] = last ? nvA[0][0] : voffA[0][0]; vA0[1] = last ? nvA[0][1] : voffA[0][1]; vA1[0] = last ? nvA[1][0] : voffA[1][0]; vA1[1] = last ? nvA[1][1] : voffA[1][1]; }
            else { vA0[0] = voffA[0][0]; vA0[1] = voffA[0][1]; vA1[0] = voffA[1][0]; vA1[1] = voffA[1][1]; }
            PG8_LDB(B0, 0, 0); PG8_SCHED; PG8_LDA(At, 0, 0); PG8_STAGE(PG8_SA(1, 1), a1, voffA[1]);
            PG8_WAIT_L(8); PG8_BAR; PG8_WAIT_L(0); PG8_MMA(0, 0, At, B0); PG8_BAR; PG8_SCHED;
            PG8_LDB(B1, 0, 1); PG8_STAGE(PG8_SB(0, 0), b2, voffB);
            PG8_BAR; PG8_WAIT_L(0); PG8_MMA(0, 1, At, B1); PG8_BAR;
            PG8_LDA(At, 0, 1); PG8_STAGE(PG8_SA(0, 0), a2, vA0);
            PG8_BAR; PG8_WAIT_L(0); PG8_MMA(1, 0, At, B0); PG8_BAR; PG8_SCHED;
            PG8_STAGE(PG8_SB(0, 1), b2 + hstepB, voffB);
            PG8_WAIT_V(6); PG8_BAR; PG8_MMA(1, 1, At, B1); PG8_BAR;
            PG8_LDB(B0, 1, 0); PG8_SCHED; PG8_LDA(At, 1, 0); PG8_STAGE(PG8_SA(0, 1), a2, vA1);
            PG8_WAIT_L(8); PG8_BAR; PG8_WAIT_L(0); PG8_MMA(0, 0, At, B0); PG8_BAR; PG8_SCHED;
            PG8_LDB(B1, 1, 1); PG8_STAGE(PG8_SB(1, 0), b3, voffB);
            PG8_BAR; PG8_WAIT_L(0); PG8_MMA(0, 1, At, B1); PG8_BAR;
            PG8_LDA(At, 1, 1); PG8_STAGE(PG8_SA(1, 0), a3, vA0);
            PG8_BAR; PG8_WAIT_L(0); PG8_MMA(1, 0, At, B0); PG8_BAR; PG8_SCHED;
            PG8_STAGE(PG8_SB(1, 1), b3 + hstepB, voffB);
            PG8_WAIT_V(6); PG8_BAR; PG8_MMA(1, 1, At, B1); PG8_BAR;
        }
        if constexpr (F8) asm volatile("s_nop 15\n\ts_nop 7" ::: "memory");
        { int tl_e = (int)threadIdx.x; asm volatile("" : "+v"(tl_e));
          const int fr_e = tl_e & 15, fq_e = (tl_e >> 4) & 3;
          E(acc, cur, wr, wc, fr_e, fq_e); }
        if (!has_next) break;
#pragma unroll
        for (int a = 0; a < 2; ++a)
#pragma unroll
            for (int b = 0; b < 2; ++b)
#pragma unroll
                for (int m = 0; m < 4; ++m)
#pragma unroll
                    for (int n = 0; n < 2; ++n) acc[a][b][m][n] = (f32x4){0.f, 0.f, 0.f, 0.f};
        cur = nxt; cA = nA; cB = nB; ++ui;
        if constexpr (GATHER) {
#pragma unroll
            for (int h = 0; h < 2; ++h)
#pragma unroll
                for (int i = 0; i < 2; ++i) voffA[h][i] = nvA[h][i]; }
    }
    PG8_WAIT_V(0);
    if (wr == 0) PG8_BAR;
    PG8_BAR;
#undef PG8_SA
#undef PG8_SB
#undef PG8_STAGE
#undef PG8_LDA
#undef PG8_LDB
#undef PG8_MMA
#undef PG8_WAIT_V
#undef PG8_WAIT_L
#undef PG8_BAR
#undef PG8_SCHED
#undef PG8_GATHER
#undef PG8_GATHER_LD
#undef PG8_GATHER_CV
}
}
using pg8::Unit;

struct Args { const float* in[37]; float* out; unsigned char* ws; int ph_lo, ph_hi; };
enum { I_XP = 0, I_XS, I_META, I_LNEG, I_LNEB, I_HLB, I_WIN, I_CONVW, I_CONVB, I_WR, I_BR, I_WI, I_BI, I_LAM, I_MU, I_W0, I_W2, I_A0, I_A2, I_G2, I_KK, I_KA, I_RK,
       I_LNXG, I_LNXB, I_HNG, I_RDEC, I_WBR, I_WOUT, I_LN1G, I_LN1B, I_ROUTER, I_EW1, I_EW3, I_EW2, I_LN2G, I_LN2B };
struct Frame {
    const float* const* in; float* out; unsigned char* ws; LAS unsigned char* lds; unsigned char* ldsg;
    int tid, lane, wave, G, bid;
    __device__ __forceinline__ bf16_t* hbuf() const { return (bf16_t*)(ws + WS_HBUF); }
    __device__ __forceinline__ bf16_t* br() const { return (bf16_t*)(ws + R_BR); }
    __device__ __forceinline__ bf16_t* brx() const { return (bf16_t*)out; }
    __device__ __forceinline__ bf16_t* ubuf() const { return (bf16_t*)(ws + R_U); }
    __device__ __forceinline__ bf16_t* pb(int n) const { return n < 3 ? (bf16_t*)(ws + R_PB + (size_t)n * SZ_TD2) : (bf16_t*)out; }
};

struct SchedPlain {
    pg8::TileOrder T; const char* A; const char* B; size_t astep, bstep;
    __device__ __forceinline__ bool next(int i, Unit& u) const { int pm, pn; if (!T.tile(i, pm, pn)) return false; u.pm = pm; u.pn = pn; u.aux = 0; u.A = A + (size_t)pm * astep; u.B = B + (size_t)pn * bstep; u.rows = nullptr; return true; }
};
struct SchedP {
    pg8::TileOrder T; const char* A; const char* B;
    __device__ __forceinline__ bool next(int i, Unit& u) const { int pm, pn; if (!T.tile(i, pm, pn)) return false; const int nb = pn >> 2, pl = pn & 3; u.pm = pm; u.pn = pl; u.aux = nb;
        u.A = A + (size_t)pm * 256 * 2048 * 2 + (size_t)nb * 512 * 2; u.B = B + (size_t)nb * 1024 * 512 * 2 + (size_t)pl * 256 * 512 * 2; u.rows = nullptr; return true; }
};
struct SchedE1 {
    pg8::TileOrder T; const char* A; const char* B; const int* stok; int e0;
    __device__ __forceinline__ bool next(int i, Unit& u) const { int pm, pn; if (!T.tile(i, pm, pn)) return false; const int el = pm / ETILES, pl = pm - el * ETILES, e = e0 + el; u.pm = pl; u.pn = pn; u.aux = el;
        u.A = A; u.B = B + (size_t)e * 4096 * D + (size_t)pn * 256 * D; u.rows = stok + (size_t)e * EROWS + pl * 256; return true; }
};
struct SchedE2 {
    pg8::TileOrder T; const char* A; const char* B; int e0;
    __device__ __forceinline__ bool next(int i, Unit& u) const { int pm, pn; if (!T.tile(i, pm, pn)) return false; const int el = pm / ETILES, pl = pm - el * ETILES, e = e0 + el; u.pm = pl; u.pn = pn; u.aux = e;
        u.A = A + ((size_t)el * EROWS + (size_t)pl * 256) * DFF; u.B = B + (size_t)e * D * DFF + (size_t)pn * 256 * DFF; u.rows = nullptr; return true; }
};

#define EPI_LOOP_AM _Pragma("unroll") for (int ai = 0; ai < 2; ++ai) _Pragma("unroll") for (int m = 0; m < 4; ++m)
struct EpiStoreBf16 {
    static constexpr bool PERM = true;
    bf16_t* O0; bf16_t* O1; bf16_t* O2; bf16_t* O3; int ldo;
    __device__ __forceinline__ void operator()(const f32x4 (&acc)[2][2][4][2], const Unit& u, int wr, int wc, int fr, int fq) const {
        bf16_t* base = (u.aux == 0) ? O0 : ((u.aux == 1) ? O1 : ((u.aux == 2) ? O2 : O3));
        const int row0 = u.pm * 256 + wr * 64 + fr, col0 = u.pn * 256 + wc * 32 + 8 * fq;
        EPI_LOOP_AM { bf16_t* rowp = base + (size_t)(row0 + ai * 128 + m * 16) * ldo + col0;
#pragma unroll
            for (int bj = 0; bj < 2; ++bj) { const f32x4 v0 = acc[ai][bj][m][0], v1 = acc[ai][bj][m][1];
                u32x4 w; w.x = pk2(v0[0], v0[1]); w.y = pk2(v0[2], v0[3]); w.z = pk2(v1[0], v1[1]); w.w = pk2(v1[2], v1[3]);
                *(u32x4*)(rowp + bj * 128) = w; } }
    }
};
struct EpiGate {
    static constexpr bool PERM = true;
    bf16_t* BR;
    __device__ __forceinline__ void operator()(const f32x4 (&acc)[2][2][4][2], const Unit& u, int wr, int wc, int fr, int fq) const {
        const int sec = u.pn >> 1;
        const int cbase = (sec == 0 ? 0 : (sec == 1 ? 1024 : 1536)) + (u.pn & 1) * 256 + wc * 32 + 8 * fq;
        const int row0 = u.pm * 256 + wr * 64 + fr;
        u32x4 xv[2][4][2];
        EPI_LOOP_AM { const bf16_t* rowp = BR + (size_t)(row0 + ai * 128 + m * 16) * 2048 + cbase; xv[ai][m][0] = *(const u32x4*)rowp; xv[ai][m][1] = *(const u32x4*)(rowp + 128); }
        EPI_LOOP_AM { bf16_t* rowp = BR + (size_t)(row0 + ai * 128 + m * 16) * 2048 + cbase;
#pragma unroll
            for (int bj = 0; bj < 2; ++bj) {
                const u32x4 x = xv[ai][m][bj];
                float g[8];
#pragma unroll
                for (int j = 0; j < 4; ++j) { g[j] = acc[ai][bj][m][0][j]; g[4 + j] = acc[ai][bj][m][1][j]; }
#pragma unroll
                for (int j = 0; j < 8; ++j) g[j] = (sec == 0) ? gelu_tanh_(g[j]) : siluf_(g[j]);
                const unsigned xs[4] = {x.x, x.y, x.z, x.w}; unsigned ws_[4];
#pragma unroll
                for (int j = 0; j < 4; ++j) ws_[j] = pk2(bf2f((bf16_t)(xs[j] & 0xffffu)) * g[2 * j], bf2f((bf16_t)(xs[j] >> 16)) * g[2 * j + 1]);
                u32x4 w; w.x = ws_[0]; w.y = ws_[1]; w.z = ws_[2]; w.w = ws_[3];
                *(u32x4*)(rowp + bj * 128) = w; } }
    }
};
struct EpiMerge {
    static constexpr bool PERM = false;
    const bf16_t* PB0; const bf16_t* PB1; const bf16_t* PB2; const bf16_t* PB3; bf16_t* MG;
    __device__ __forceinline__ void operator()(const f32x4 (&acc)[2][2][4][2], const Unit& u, int wr, int wc, int fr, int fq) const {
        const int row0 = u.pm * 256 + wr * 64 + fr, d0 = u.pn * 64 + wc * 16 + 4 * fq;
        u32x2 pbv[2][4][4];
        EPI_LOOP_AM { const size_t off = (size_t)(row0 + ai * 128 + m * 16) * D + d0;
            pbv[ai][m][0] = *(const u32x2*)(PB0 + off); pbv[ai][m][1] = *(const u32x2*)(PB1 + off); pbv[ai][m][2] = *(const u32x2*)(PB2 + off); pbv[ai][m][3] = *(const u32x2*)(PB3 + off); }
        EPI_LOOP_AM { const size_t off = (size_t)(row0 + ai * 128 + m * 16) * D + d0;
            float s[4] = {0.f, 0.f, 0.f, 0.f};
#pragma unroll
            for (int bj = 0; bj < 2; ++bj)
#pragma unroll
                for (int n = 0; n < 2; ++n) { const u32x2 p = pbv[ai][m][2 * bj + n]; const f32x4 a = acc[ai][bj][m][n];
                    constexpr float IS = 1.0f / WM_SCALE;
                    s[0] += sigmoidf_(a[0] * IS) * bf2f((bf16_t)(p.x & 0xffffu)); s[1] += sigmoidf_(a[1] * IS) * bf2f((bf16_t)(p.x >> 16));
                    s[2] += sigmoidf_(a[2] * IS) * bf2f((bf16_t)(p.y & 0xffffu)); s[3] += sigmoidf_(a[3] * IS) * bf2f((bf16_t)(p.y >> 16)); }
            u32x2 w; w.x = pk2(s[0], s[1]); w.y = pk2(s[2], s[3]);
            *(u32x2*)(MG + off) = w; }
    }
};
struct EpiOut {
    static constexpr bool PERM = true;
    const bf16_t* H; bf16_t* X1;
    __device__ __forceinline__ void operator()(const f32x4 (&acc)[2][2][4][2], const Unit& u, int wr, int wc, int fr, int fq) const {
        const int row0 = u.pm * 256 + wr * 64 + fr, col0 = u.pn * 256 + wc * 32 + 8 * fq;
        u32x4 hv[2][4][2];
        EPI_LOOP_AM { const size_t off = (size_t)(row0 + ai * 128 + m * 16) * D + col0; hv[ai][m][0] = *(const u32x4*)(H + off); hv[ai][m][1] = *(const u32x4*)(H + off + 128); }
        EPI_LOOP_AM { const size_t off = (size_t)(row0 + ai * 128 + m * 16) * D + col0;
#pragma unroll
            for (int bj = 0; bj < 2; ++bj) { const u32x4 p = hv[ai][m][bj]; const f32x4 a0 = acc[ai][bj][m][0], a1 = acc[ai][bj][m][1];
                u32x4 w;
                w.x = pk2(ALPHA * bf2f((bf16_t)(p.x & 0xffffu)) + a0[0], ALPHA * bf2f((bf16_t)(p.x >> 16)) + a0[1]);
                w.y = pk2(ALPHA * bf2f((bf16_t)(p.y & 0xffffu)) + a0[2], ALPHA * bf2f((bf16_t)(p.y >> 16)) + a0[3]);
                w.z = pk2(ALPHA * bf2f((bf16_t)(p.z & 0xffffu)) + a1[0], ALPHA * bf2f((bf16_t)(p.z >> 16)) + a1[1]);
                w.w = pk2(ALPHA * bf2f((bf16_t)(p.w & 0xffffu)) + a1[2], ALPHA * bf2f((bf16_t)(p.w >> 16)) + a1[3]);
                *(u32x4*)(X1 + off + bj * 128) = w; } }
    }
};
struct EpiSwiglu {
    static constexpr bool PERM = true;
    unsigned char* HE;
    __device__ __forceinline__ void operator()(const f32x4 (&acc)[2][2][4][2], const Unit& u, int wr, int wc, int fr, int fq) const {
        const int row0 = u.pm * 256 + wr * 64 + fr, col0 = u.pn * 128 + wc * 32 + 8 * fq;
        unsigned char* base = HE + (size_t)u.aux * EROWS * DFF;
        constexpr float IS = 1.0f / W13_SCALE;
        EPI_LOOP_AM { unsigned char* rowp = base + (size_t)(row0 + ai * 128 + m * 16) * DFF + col0;
            float h[8];
#pragma unroll
            for (int n = 0; n < 2; ++n)
#pragma unroll
                for (int j = 0; j < 4; ++j) h[4 * n + j] = siluf_(acc[ai][0][m][n][j] * IS) * (acc[ai][1][m][n][j] * IS);
            u32x2 w; w.x = pk4_fp8(h[0], h[1], h[2], h[3]); w.y = pk4_fp8(h[4], h[5], h[6], h[7]);
            *(u32x2*)rowp = w; }
    }
};
struct EpiScale {
    static constexpr bool PERM = true;
    bf16_t* YE; const float* SG;
    __device__ __forceinline__ void operator()(const f32x4 (&acc)[2][2][4][2], const Unit& u, int wr, int wc, int fr, int fq) const {
        const int row0 = u.pm * 256 + wr * 64 + fr, col0 = u.pn * 256 + wc * 32 + 8 * fq;
        bf16_t* base = YE + (size_t)u.aux * EROWS * D; const float* sg = SG + (size_t)u.aux * EROWS;
        float gv[2][4];
        EPI_LOOP_AM { gv[ai][m] = sg[row0 + ai * 128 + m * 16]; }
        EPI_LOOP_AM { const int row = row0 + ai * 128 + m * 16; const float g = gv[ai][m] * (1.0f / W2_SCALE); bf16_t* rowp = base + (size_t)row * D + col0;
#pragma unroll
            for (int bj = 0; bj < 2; ++bj) { const f32x4 v0 = acc[ai][bj][m][0] * g, v1 = acc[ai][bj][m][1] * g;
                u32x4 w; w.x = pk2(v0[0], v0[1]); w.y = pk2(v0[2], v0[3]); w.z = pk2(v1[0], v1[1]); w.w = pk2(v1[2], v1[3]);
                *(u32x4*)(rowp + bj * 128) = w; } }
    }
};

template <class ColMap>
__device__ __forceinline__ void tr_tile(const Frame& F, const float* src, size_t ld_src, bf16_t* dst, size_t ldd, int n0, int k0, const ColMap& cm) {
    LAS float* tile = (LAS float*)F.lds;
    const int a = F.tid >> 6, b = F.tid & 63;
    const int col = cm(n0 + b);
#pragma unroll
    for (int j = 0; j < 8; ++j) { const int kk = a + 8 * j; tile[b * 65 + kk] = (col >= 0) ? src[(size_t)(k0 + kk) * ld_src + col] : 0.f; }
    __syncthreads();
#pragma unroll
    for (int j = 0; j < 8; ++j) { const int nn = a + 8 * j; dst[(size_t)(n0 + nn) * ldd + k0 + b] = f2bf(tile[nn * 65 + b]); }
    __syncthreads();
}
template <class ColMap>
__device__ __forceinline__ void tr_strip(const Frame& F, const float* src, size_t ld_src, bf16_t* dst, size_t ldd, int n0, int k0, const ColMap& cm) {
    LAS float* tile = (LAS float*)F.lds;
    const int a = F.tid >> 6, b = F.tid & 63;
    const int col = cm(n0 + b);
    float v[32];
#pragma unroll
    for (int j = 0; j < 32; ++j) v[j] = (col >= 0) ? src[(size_t)(k0 + a + 8 * j) * ld_src + col] : 0.f;
#pragma unroll
    for (int j = 0; j < 32; ++j) tile[b * 257 + a + 8 * j] = v[j];
    __syncthreads();
#pragma unroll
    for (int j = 0; j < 8; ++j) { const int nn = a + 8 * j;
#pragma unroll
        for (int m = 0; m < 2; ++m) { const int kk = 2 * b + 128 * m; *(unsigned*)(dst + (size_t)(n0 + nn) * ldd + k0 + kk) = pk2(tile[nn * 257 + kk], tile[nn * 257 + kk + 1]); } }
    __syncthreads();
}
template <class ColMap>
__device__ __forceinline__ void tr_strip8m(const Frame& F, const float* src, size_t ld_src, unsigned char* dst, size_t ldd, int n0, int k0, const ColMap& cm, float scale) {
    LAS float* tile = (LAS float*)F.lds;
    const int a = F.tid >> 6, b = F.tid & 63; const int col = cm(n0 + b);
    float v[32];
#pragma unroll
    for (int j = 0; j < 32; ++j) v[j] = src[(size_t)(k0 + a + 8 * j) * ld_src + col];
#pragma unroll
    for (int j = 0; j < 32; ++j) tile[b * 257 + a + 8 * j] = v[j] * scale;
    __syncthreads();
#pragma unroll
    for (int j = 0; j < 8; ++j) { const int nn = a + 8 * j; const LAS float* tp = tile + nn * 257 + 4 * b;
        *(unsigned*)(dst + (size_t)(n0 + nn) * ldd + k0 + 4 * b) = pk4_fp8(tp[0], tp[1], tp[2], tp[3]); }
    __syncthreads();
}
__device__ __forceinline__ void tr_strip8(const Frame& F, const float* src, size_t ld_src, unsigned char* dst, size_t ldd, int n0, int k0, int coff, float scale) {
    LAS float* tile = (LAS float*)F.lds;
    const int a = F.tid >> 6, b = F.tid & 63;
    float v[32];
#pragma unroll
    for (int j = 0; j < 32; ++j) v[j] = src[(size_t)(k0 + a + 8 * j) * ld_src + coff + n0 + b];
#pragma unroll
    for (int j = 0; j < 32; ++j) tile[b * 257 + a + 8 * j] = v[j] * scale;
    __syncthreads();
#pragma unroll
    for (int j = 0; j < 8; ++j) { const int nn = a + 8 * j; const LAS float* tp = tile + nn * 257 + 4 * b;
        *(unsigned*)(dst + (size_t)(n0 + nn) * ldd + k0 + 4 * b) = pk4_fp8(tp[0], tp[1], tp[2], tp[3]); }
    __syncthreads();
}
struct CmId { int off; __device__ __forceinline__ int operator()(int n) const { return off + n; } };
struct CmW1 { __device__ __forceinline__ int operator()(int n) const { return n < 512 ? n : (n < 2432 ? n + 512 : -1); } };
struct CmW2 { __device__ __forceinline__ int operator()(int n) const { return n < 2048 ? 2944 + n : 3456 + n; } };
struct CmWG { __device__ __forceinline__ int operator()(int n) const { return n < 512 ? 512 + n : (n < 1024 ? 4480 + n : 5504 + n); } };
struct CmWM { __device__ __forceinline__ int operator()(int n) const { const int pn = n >> 8, c = n & 255, bj = c >> 7, wc = (c >> 5) & 3, nn = (c >> 4) & 1, fq = (c >> 2) & 3, j = c & 3;
        return 7040 + (2 * bj + nn) * 1024 + 64 * pn + 16 * wc + 4 * fq + j; } };

__device__ __forceinline__ void phase_prep_weights(const Frame& F0) {
    Frame F = F0; { size_t z_ = 0; asm volatile("" : "+v"(F.tid), "+v"(F.lane), "+s"(z_), "+s"(F.bid), "+s"(F.G), "+s"(F.wave)); F.ws = F0.ws + z_; F.out = F0.out + z_; }
    for (int job = F.bid; job < 2 * 912; job += F.G) {
        const int li = job / 912; int j = job - li * 912;
        const float* win = F.in[I_WIN] + (size_t)li * D * N_IN;
        if (j < 160) { tr_strip(F, win, N_IN, (bf16_t*)(F.ws + WS_W1T) + (size_t)li * N1 * D, D, (j >> 2) * 64, (j & 3) * 256, CmW1()); continue; } j -= 160;
        if (j < 192) { tr_strip(F, win, N_IN, (bf16_t*)(F.ws + WS_W2T) + (size_t)li * N2 * D, D, (j >> 2) * 64, (j & 3) * 256, CmW2()); continue; } j -= 192;
        if (j < 96) { tr_strip(F, win, N_IN, (bf16_t*)(F.ws + WS_WGT) + (size_t)li * NG * D, D, (j >> 2) * 64, (j & 3) * 256, CmWG()); continue; } j -= 96;
        if (j < 256) { tr_strip8m(F, win, N_IN, (unsigned char*)(F.ws + WS_WMT) + (size_t)li * NM * D, D, (j >> 2) * 64, (j & 3) * 256, CmWM(), WM_SCALE); continue; } j -= 256;
        if (j < 128) { const int nb = j >> 5, r = j & 31;
            tr_strip(F, F.in[I_WBR] + ((size_t)li * 4 + nb) * 512 * D, D, (bf16_t*)(F.ws + WS_WBT) + ((size_t)li * 4 + nb) * D * 512, 512, (r >> 1) * 64, (r & 1) * 256, CmId{0}); continue; } j -= 128;
        if (j < 64) { tr_strip(F, F.in[I_WOUT] + (size_t)li * D * D, D, (bf16_t*)(F.ws + WS_WOT) + (size_t)li * D * D, D, (j >> 2) * 64, (j & 3) * 256, CmId{0}); continue; } j -= 64;
        tr_tile(F, F.in[I_G2] + (size_t)li * 128 * 512, 512, (bf16_t*)(F.ws + WS_G2T) + (size_t)li * 512 * 128, 128, (j >> 1) * 64, (j & 1) * 64, CmId{0});
    }
    for (int job = F.bid; job < 128; job += F.G) {
        if (job < 64) { const int li = job >> 5, d = (job >> 4) & 1, m = (job >> 3) & 1, nt = job & 7;
            tr_tile(F, F.in[m ? I_A2 : I_W2] + ((size_t)li * 2 + d) * 64 * 512, 512, (bf16_t*)(F.ws + WS_RW2T) + (((size_t)li * 2 + d) * 2 + m) * 512 * 64, 64, nt * 64, 0, CmId{0});
        } else { const int j = job - 64, li = j >> 5, d = (j >> 4) & 1, m = (j >> 3) & 1, g = j & 7;
            tr_tile(F, F.in[m ? I_WI : I_WR] + (((size_t)li * 2 + d) * 8 + g) * 64 * 64, 64, (bf16_t*)(F.ws + WS_LRUT) + ((((size_t)li * 2 + d) * 2 + m) * 8 + g) * 64 * 64, 64, 0, 0, CmId{0}); }
    }
    if (F.bid == 0) { float* lb = (float*)(F.ws + WS_LB); const float* h = F.in[I_HLB];
        for (int c = F.tid; c < 512; c += NTHREADS) { lb[c] = 0.f; lb[512 + c] = 1.0f / (1.0f + expf(h[c] - h[512 + c])); } }
}
__device__ __forceinline__ void phase_prep_experts(const Frame& F0, int li, int jlo, int jhi, int units) {
    Frame F = F0; { size_t z_ = 0; asm volatile("" : "+v"(F.tid), "+v"(F.lane), "+s"(z_), "+s"(F.bid), "+s"(F.G), "+s"(F.wave)); F.ws = F0.ws + z_; F.out = F0.out + z_; }
    const int nskip = (units > F.G && F.G > 64) ? units % F.G : 0;
    if (F.bid < nskip) return;
    for (int job = jlo + F.bid - nskip; job < jhi; job += F.G - nskip) {
        const bool is13 = job < NE * 256; const int e = is13 ? (job >> 8) : ((job - NE * 256) >> 7); int j = is13 ? (job & 255) : 256 + ((job - NE * 256) & 127);
        if (j < 256) { const int nt = j >> 2, ks = j & 3, p = nt >> 2, r = nt & 3, which = r >> 1, nsub = r & 1;
            const float* src = F.in[which ? I_EW3 : I_EW1] + ((size_t)li * NE + e) * D * DFF;
            const int n0 = 64 * nt;
            tr_strip8(F, src, DFF, (unsigned char*)F.out + OUT_W13 + (size_t)e * 4096 * D, D, n0, ks * 256, 128 * p + 64 * nsub - n0, W13_SCALE);
        } else { j -= 256;
            tr_strip8(F, F.in[I_EW2] + ((size_t)li * NE + e) * DFF * D, D, (unsigned char*)F.out + OUT_W2 + (size_t)e * D * DFF, DFF, (j >> 3) * 64, (j & 7) * 256, 0, W2_SCALE); }
    }
}

__device__ __forceinline__ void ln_stats(const float (&x)[16], float& mu, float& rstd) {
    float s = 0.f;
#pragma unroll
    for (int i = 0; i < 16; ++i) s += x[i];
    mu = wave_sum(s) * (1.0f / 1024.0f);
    float q = 0.f;
#pragma unroll
    for (int i = 0; i < 16; ++i) { const float dlt = x[i] - mu; q += dlt * dlt; }
    rstd = rsqrtf(wave_sum(q) * (1.0f / 1024.0f) + 1e-5f);
}
__device__ __forceinline__ void ld16_f32(const float* p, int lane, float (&x)[16]) {
#pragma unroll
    for (int j = 0; j < 2; ++j) { const f32x4 a = *(const f32x4*)(p + 512 * j + 8 * lane), b = *(const f32x4*)(p + 512 * j + 8 * lane + 4);
#pragma unroll
        for (int i = 0; i < 4; ++i) { x[8 * j + i] = a[i]; x[8 * j + 4 + i] = b[i]; } }
}
__device__ __forceinline__ void ld16_bf16(const bf16_t* p, int lane, float (&x)[16]) {
#pragma unroll
    for (int j = 0; j < 2; ++j) { const u32x4 a = *(const u32x4*)(p + 512 * j + 8 * lane); const unsigned w[4] = {a.x, a.y, a.z, a.w};
#pragma unroll
        for (int i = 0; i < 4; ++i) { x[8 * j + 2 * i] = bf2f((bf16_t)(w[i] & 0xffffu)); x[8 * j + 2 * i + 1] = bf2f((bf16_t)(w[i] >> 16)); } }
}
__device__ __forceinline__ void unpack16(const u32x4 (&a)[2], float (&x)[16]) {
#pragma unroll
    for (int j = 0; j < 2; ++j) { const unsigned w[4] = {a[j].x, a[j].y, a[j].z, a[j].w};
#pragma unroll
        for (int i = 0; i < 4; ++i) { x[8 * j + 2 * i] = bf2f((bf16_t)(w[i] & 0xffffu)); x[8 * j + 2 * i + 1] = bf2f((bf16_t)(w[i] >> 16)); } }
}
__device__ __forceinline__ void ldraw16(const bf16_t* p, int lane, u32x4 (&a)[2]) { a[0] = __builtin_nontemporal_load((const u32x4*)(p + 8 * lane)); a[1] = __builtin_nontemporal_load((const u32x4*)(p + 512 + 8 * lane)); }
__device__ __forceinline__ void st16_bf16(bf16_t* p, int lane, const float (&x)[16]) {
#pragma unroll
    for (int j = 0; j < 2; ++j) { u32x4 w; w.x = pk2(x[8 * j], x[8 * j + 1]); w.y = pk2(x[8 * j + 2], x[8 * j + 3]); w.z = pk2(x[8 * j + 4], x[8 * j + 5]); w.w = pk2(x[8 * j + 6], x[8 * j + 7]);
        *(u32x4*)(p + 512 * j + 8 * lane) = w; }
}
__device__ __forceinline__ void st16_fp8(unsigned char* p, int lane, const float (&x)[16]) {
#pragma unroll
    for (int j = 0; j < 2; ++j) { u32x2 w8; w8.x = pk4_fp8(x[8 * j], x[8 * j + 1], x[8 * j + 2], x[8 * j + 3]); w8.y = pk4_fp8(x[8 * j + 4], x[8 * j + 5], x[8 * j + 6], x[8 * j + 7]); *(u32x2*)(p + 512 * j + 8 * lane) = w8; }
}
__device__ __forceinline__ void st16_f32(float* p, int lane, const float (&x)[16]) {
#pragma unroll
    for (int j = 0; j < 2; ++j) { *(f32x4*)(p + 512 * j + 8 * lane) = (f32x4){x[8 * j], x[8 * j + 1], x[8 * j + 2], x[8 * j + 3]}; *(f32x4*)(p + 512 * j + 8 * lane + 4) = (f32x4){x[8 * j + 4], x[8 * j + 5], x[8 * j + 6], x[8 * j + 7]}; }
}
__device__ __forceinline__ void ln_apply(float (&x)[16], float mu, float rstd, const float (&gg)[16], const float (&bb)[16]) {
#pragma unroll
    for (int i = 0; i < 16; ++i) x[i] = (x[i] - mu) * rstd * gg[i] + bb[i];
}

__device__ __forceinline__ void phase_embed(const Frame& F0) {
    Frame F = F0; { size_t z_ = 0; asm volatile("" : "+v"(F.tid), "+v"(F.lane), "+s"(z_), "+s"(F.bid), "+s"(F.G), "+s"(F.wave)); F.ws = F0.ws + z_; F.out = F0.out + z_; }
    const int gw = F.bid * NWAVES + F.wave, nw = F.G * NWAVES;
    float gg[16], bb[16]; ld16_f32(F.in[I_LNEG], F.lane, gg); ld16_f32(F.in[I_LNEB], F.lane, bb);
    for (int row0 = gw; row0 < NTOK; row0 += 2 * nw) {
        float xs[2][16];
#pragma unroll
        for (int j = 0; j < 2; ++j) { const int row = row0 + j * nw; if (row < NTOK) { const int s = row / LSEQ, t = row - s * LSEQ;
            const float* src = (t < NMETA) ? F.in[I_META] + (size_t)t * D : ((s < NSEQ0) ? F.in[I_XP] + ((size_t)s * SEQ + (t - NMETA)) * D : F.in[I_XS] + ((size_t)(s - NSEQ0) * SEQ + (t - NMETA)) * D);
            ld16_f32(src, F.lane, xs[j]); } }
#pragma unroll
        for (int j = 0; j < 2; ++j) { const int row = row0 + j * nw; if (row < NTOK) {
            float mu, rstd; ln_stats(xs[j], mu, rstd); ln_apply(xs[j], mu, rstd, gg, bb);
            st16_bf16(F.hbuf() + (size_t)row * D, F.lane, xs[j]); st16_fp8((unsigned char*)F.out + OUT_HIN8 + (size_t)row * D, F.lane, xs[j]); } }
    }
}

__device__ __forceinline__ void phase_ln1_router(const Frame& F0, int li) {
    Frame F = F0; { size_t z_ = 0; asm volatile("" : "+v"(F.tid), "+v"(F.lane), "+s"(z_), "+s"(F.bid), "+s"(F.G), "+s"(F.wave)); F.ws = F0.ws + z_; F.out = F0.out + z_; }
    LAS float* RW = (LAS float*)F.lds;
    LAS unsigned* hl0 = (LAS unsigned*)(F.lds + 65536);
    for (int i = F.tid; i < 32 * 512; i += NTHREADS) hl0[i] = 0u;
    const float* router = F.in[I_ROUTER] + (size_t)li * D * NE;
    for (int i = F.tid; i < D * NE; i += NTHREADS) RW[(i & 15) * D + (i >> 4)] = router[i];
    { unsigned* hist = (unsigned*)(F.ws + WS_HIST); for (int i = F.bid * NTHREADS + F.tid; i < 2 * 32 * 1024; i += F.G * NTHREADS) hist[32 * 1024 + i] = 0u;
      if (F.bid == 0 && F.tid < 64) { unsigned* ctl = (unsigned*)(F.ws + WS_CTL); ctl[CW_CNT + F.tid] = 0u; ctl[CW_TIE + F.tid] = 0u; }
      int* stok = (int*)(F.ws + WS_STOK); float* sg = (float*)(F.ws + WS_SGATE);
      for (int i = F.bid * NTHREADS + F.tid; i < NE * (EROWS - EVALID); i += F.G * NTHREADS) { const int e = i / (EROWS - EVALID), r = EVALID + i % (EROWS - EVALID); stok[e * EROWS + r] = 0; sg[e * EROWS + r] = 0.f; } }
    __syncthreads();
    const bf16_t* X1 = (const bf16_t*)(F.ws + R_X1); float* aff = (float*)(F.ws + WS_AFF);
    float gg[16], bb[16]; ld16_f32(F.in[I_LN1G] + (size_t)li * D, F.lane, gg); ld16_f32(F.in[I_LN1B] + (size_t)li * D, F.lane, bb);
    const int gw = F.bid * NWAVES + F.wave, nw = F.G * NWAVES;
    for (int row0 = gw; row0 < NTOK; row0 += 4 * nw) {
      u32x4 XR[4][2];
#pragma unroll
      for (int jr = 0; jr < 4; ++jr) { const int row = row0 + jr * nw; if (row < NTOK) ldraw16(X1 + (size_t)row * D, F.lane, XR[jr]); }
#pragma unroll
      for (int jr = 0; jr < 4; ++jr) { const int row = row0 + jr * nw; if (row < NTOK) {
        float x[16]; unpack16(XR[jr], x);
        float mu, rstd; ln_stats(x, mu, rstd); ln_apply(x, mu, rstd, gg, bb);
        st16_bf16(F.hbuf() + (size_t)row * D, F.lane, x);
        { unsigned char* h8 = F.ws + R_H8 + (size_t)row * D;
#pragma unroll
          for (int j = 0; j < 2; ++j) { u32x2 w8; w8.x = pk4_fp8(x[8 * j], x[8 * j + 1], x[8 * j + 2], x[8 * j + 3]); w8.y = pk4_fp8(x[8 * j + 4], x[8 * j + 5], x[8 * j + 6], x[8 * j + 7]); *(u32x2*)(h8 + 512 * j + 8 * F.lane) = w8; } }
        float lg[16];
#pragma unroll
        for (int e = 0; e < 16; ++e) lg[e] = 0.f;
#pragma unroll 4
        for (int e = 0; e < 16; ++e) { float a = 0.f;
#pragma unroll
            for (int j = 0; j < 2; ++j) { const f32x4 w0 = *(const LAS f32x4*)(RW + e * D + 512 * j + 8 * F.lane), w1 = *(const LAS f32x4*)(RW + e * D + 512 * j + 8 * F.lane + 4);
                a += x[8 * j] * w0[0] + x[8 * j + 1] * w0[1] + x[8 * j + 2] * w0[2] + x[8 * j + 3] * w0[3] + x[8 * j + 4] * w1[0] + x[8 * j + 5] * w1[1] + x[8 * j + 6] * w1[2] + x[8 * j + 7] * w1[3]; }
            lg[e] = a; }
        float mx = -1e30f;
#pragma unroll
        for (int e = 0; e < 16; ++e) { lg[e] = wave_sum(lg[e]); mx = fmaxf(mx, lg[e]); }
        float den = 0.f;
#pragma unroll
        for (int e = 0; e < 16; ++e) { lg[e] = __expf(lg[e] - mx); den += lg[e]; }
        const float inv = __builtin_amdgcn_rcpf(den);
        float mine = 0.f;
#pragma unroll
        for (int e = 0; e < 16; ++e) mine = (F.lane == e) ? lg[e] * inv : mine;
        if (F.lane < 16) { aff[(size_t)row * 16 + F.lane] = mine;
            unsigned bin = __float_as_uint(mine) >> 20; if (bin > 1023u) bin = 1023u;
            (void)__hip_atomic_fetch_add(hl0 + ((row >= TOK0 ? 16 : 0) + F.lane) * 512 + (bin >> 1), 1u << (16 * (bin & 1u)), __ATOMIC_RELAXED, __HIP_MEMORY_SCOPE_WORKGROUP); }
      } }
    }
    __syncthreads();
    { unsigned* gh = (unsigned*)(F.ws + WS_HIST); for (int i = F.tid; i < 32 * 512; i += NTHREADS) { const unsigned v = hl0[i]; if (v & 0xffffu) atomicAdd(gh + 2 * i, v & 0xffffu); if (v >> 16) atomicAdd(gh + 2 * i + 1, v >> 16); } }
    __syncthreads();
}

__device__ __forceinline__ void find_bin(const unsigned* h, unsigned target, int lane, unsigned& bin, unsigned& rem, unsigned& bincnt) {
    unsigned c[16]; unsigned ls = 0;
#pragma unroll
    for (int i = 0; i < 16; ++i) { c[i] = __hip_atomic_load(h + 16 * lane + i, __ATOMIC_RELAXED, __HIP_MEMORY_SCOPE_AGENT); ls += c[i]; }
    unsigned x = ls;
#pragma unroll
    for (int o = 1; o < 64; o <<= 1) { const unsigned v = __shfl_down(x, o); if (lane + o < 64) x += v; }
    const unsigned above = x - ls;
    const bool own = (above < target) && (target <= above + ls);
    unsigned b = 0, r = 1, bc = 1;
    if (own) { unsigned cum = above; bool done = false;
#pragma unroll
        for (int i = 15; i >= 0; --i) { if (!done && target <= cum + c[i]) { b = 16 * lane + i; r = target - cum; bc = c[i]; done = true; } cum += c[i]; } }
    const unsigned long long m = __ballot(own);
    const int src = m ? (int)__builtin_ctzll(m) : 0;
    bin = __shfl(b, src); rem = __shfl(r, src); bincnt = __shfl(bc, src);
}
__device__ __forceinline__ void phase_topk(const Frame& F0, int pass) {
    Frame F = F0; { size_t z_ = 0; asm volatile("" : "+v"(F.tid), "+v"(F.lane), "+s"(z_), "+s"(F.bid), "+s"(F.G), "+s"(F.wave)); F.ws = F0.ws + z_; F.out = F0.out + z_; }
    LAS unsigned* hl = (LAS unsigned*)F.lds;
    LAS unsigned* selp = (LAS unsigned*)(F.lds + 131072);
    unsigned* hist = (unsigned*)(F.ws + WS_HIST);
    const float* aff = (const float*)(F.ws + WS_AFF);
    for (int i = F.tid; i < 32 * 1024; i += NTHREADS) hl[i] = 0u;
    for (int q = F.wave; q < 32; q += NWAVES) {
        const unsigned cap = (q < 16) ? CAP0 : CAP1; unsigned prefix = 0, rem = cap, bcnt = 0;
        for (int p = 0; p < pass; ++p) { unsigned bin, r; find_bin(hist + ((size_t)p * 32 + q) * 1024, rem, F.lane, bin, r, bcnt); prefix = (p == 0) ? bin : ((prefix << 10) | bin); rem = r; }
        if (F.lane == 0) { selp[q] = prefix; selp[32 + q] = rem; selp[64 + q] = bcnt; }
    }
    __syncthreads();
    if (pass < 3) {
        for (int tb0 = F.bid; tb0 < NTOK / 32; tb0 += 4 * F.G) {
            unsigned bv[4];
#pragma unroll
            for (int u = 0; u < 4; ++u) { const int tb = tb0 + u * F.G, tbc = tb < NTOK / 32 ? tb : NTOK / 32 - 1; bv[u] = __float_as_uint(aff[((size_t)tbc * 32 + (F.tid >> 4)) * 16 + (F.tid & 15)]); }
#pragma unroll
            for (int u = 0; u < 4; ++u) { const int tb = tb0 + u * F.G;
                const int t = tb * 32 + (F.tid >> 4), e = F.tid & 15, q = (t >= TOK0 ? 16 : 0) + e;
                const unsigned bits = bv[u];
                unsigned bin; bool ok;
                if (pass == 0) { bin = bits >> 20; ok = true; }
                else if (pass == 1) { bin = (bits >> 10) & 1023u; ok = (bits >> 20) == selp[q]; }
                else { bin = bits & 1023u; ok = (bits >> 10) == selp[q]; }
                if (bin > 1023u) bin = 1023u;
                if (ok && tb < NTOK / 32) (void)__hip_atomic_fetch_add(hl + q * 1024 + bin, 1u, __ATOMIC_RELAXED, __HIP_MEMORY_SCOPE_WORKGROUP); }
        }
        __syncthreads();
        unsigned* gh = hist + (size_t)pass * 32 * 1024;
        for (int i = F.tid; i < 32 * 1024; i += NTHREADS) { const unsigned v = hl[i]; if (v) atomicAdd(gh + i, v); }
    } else {
        unsigned* ctl = (unsigned*)(F.ws + WS_CTL); int* stok = (int*)(F.ws + WS_STOK); float* sg = (float*)(F.ws + WS_SGATE); int* inv = (int*)(F.ws + WS_INV);
        LAS unsigned* lcnt = selp + 96;
        LAS unsigned* lbase = selp + 128;
        if (F.tid < 32) lcnt[F.tid] = 0u;
        __syncthreads();
        auto selected = [&](int t, int e, int set, int q, unsigned bits) -> bool {
            const unsigned thr = selp[q]; bool sel = bits > thr; const bool tie = (bits == thr); if (tie) sel = true;
            unsigned long long need = __ballot(tie && (selp[64 + q] != selp[32 + q]));
            while (need) { const int src = (int)__builtin_ctzll(need); need &= need - 1;
                const int t_s = __shfl(t, src), e_s = __shfl(e, src), set_s = __shfl(set, src); const unsigned thr_s = __shfl(thr, src);
                unsigned c = 0; for (int t2 = (set_s ? TOK0 : 0) + F.lane; t2 < t_s; t2 += 64) c += (__float_as_uint(aff[(size_t)t2 * 16 + e_s]) == thr_s) ? 1u : 0u;
#pragma unroll
                for (int o = 32; o > 0; o >>= 1) c += __shfl_xor(c, o);
                if (F.lane == src) sel = c < selp[32 + q]; }
            return sel; };
        for (int tb = F.bid; tb < NTOK / 32; tb += F.G) {
            const int t = tb * 32 + (F.tid >> 4), e = F.tid & 15, set = (t >= TOK0) ? 1 : 0, q = set * 16 + e;
            if (selected(t, e, set, q, __float_as_uint(aff[(size_t)t * 16 + e]))) (void)__hip_atomic_fetch_add(lcnt + q, 1u, __ATOMIC_RELAXED, __HIP_MEMORY_SCOPE_WORKGROUP); }
        __syncthreads();
        if (F.tid < 32) { const unsigned n = lcnt[F.tid]; lbase[F.tid] = n ? atomicAdd(ctl + CW_CNT + F.tid, n) : 0u; lcnt[F.tid] = 0u; }
        __syncthreads();
        for (int tb = F.bid; tb < NTOK / 32; tb += F.G) {
            const int t = tb * 32 + (F.tid >> 4), e = F.tid & 15, set = (t >= TOK0) ? 1 : 0, q = set * 16 + e;
            const float a = aff[(size_t)t * 16 + e];
            int pos = -1;
            if (selected(t, e, set, q, __float_as_uint(a))) { const unsigned sl = lbase[q] + __hip_atomic_fetch_add(lcnt + q, 1u, __ATOMIC_RELAXED, __HIP_MEMORY_SCOPE_WORKGROUP); const unsigned cap = set ? CAP1 : CAP0;
                if (sl < cap) { pos = (int)(set ? CAP0 + sl : sl); stok[e * EROWS + pos] = t; sg[e * EROWS + pos] = a; } }
            inv[(size_t)t * 16 + e] = pos;
        }
    }
    __syncthreads();
}

__device__ __forceinline__ void phase_combine(const Frame& F0, int li) {
    Frame F = F0; { size_t z_ = 0; asm volatile("" : "+v"(F.tid), "+v"(F.lane), "+s"(z_), "+s"(F.bid), "+s"(F.G), "+s"(F.wave)); F.ws = F0.ws + z_; F.out = F0.out + z_; }
    const bf16_t* ye = (const bf16_t*)(F.ws + R_YE); const int* inv = (const int*)(F.ws + WS_INV);
    float gg[16], bb[16]; ld16_f32(F.in[I_LN2G] + (size_t)li * D, F.lane, gg); ld16_f32(F.in[I_LN2B] + (size_t)li * D, F.lane, bb);
    const int gw = F.bid * NWAVES + F.wave, nw = F.G * NWAVES;
    for (int row0 = gw; row0 < NTOK; row0 += 4 * nw) {
        u32x4 HR[4][2]; int iv[4];
#pragma unroll
        for (int j = 0; j < 4; ++j) { const int row = row0 + j * nw; iv[j] = -1; if (row < NTOK) { ldraw16(F.hbuf() + (size_t)row * D, F.lane, HR[j]); if (F.lane < 16) iv[j] = inv[(size_t)row * 16 + F.lane]; } }
        u32x4 Y0[4][2], Y1[4][2]; unsigned long long rest[4]; bool h0[4], h1[4];
#pragma unroll
        for (int j = 0; j < 4; ++j) { unsigned long long em = __ballot(iv[j] >= 0) & 0xFFFFull; h0[j] = false; h1[j] = false;
            if (em) { const int e = (int)__builtin_ctzll(em); em &= em - 1; const int p = __shfl(iv[j], e); ldraw16(ye + ((size_t)e * EROWS + p) * D, F.lane, Y0[j]); h0[j] = true; }
            if (em) { const int e = (int)__builtin_ctzll(em); em &= em - 1; const int p = __shfl(iv[j], e); ldraw16(ye + ((size_t)e * EROWS + p) * D, F.lane, Y1[j]); h1[j] = true; }
            rest[j] = em; }
#pragma unroll
        for (int j = 0; j < 4; ++j) { const int row = row0 + j * nw; if (row < NTOK) {
            float x[16]; unpack16(HR[j], x);
#pragma unroll
            for (int i = 0; i < 16; ++i) x[i] *= ALPHA;
            if (h0[j]) { float y[16]; unpack16(Y0[j], y);
#pragma unroll
                for (int i = 0; i < 16; ++i) x[i] += y[i]; }
            if (h1[j]) { float y[16]; unpack16(Y1[j], y);
#pragma unroll
                for (int i = 0; i < 16; ++i) x[i] += y[i]; }
            unsigned long long em = rest[j];
            while (em) { const int e = (int)__builtin_ctzll(em); em &= em - 1; const int p = __shfl(iv[j], e); float y[16]; ld16_bf16(ye + ((size_t)e * EROWS + p) * D, F.lane, y);
#pragma unroll
                for (int i = 0; i < 16; ++i) x[i] += y[i]; }
            float mu, rstd; ln_stats(x, mu, rstd); ln_apply(x, mu, rstd, gg, bb);
            if (li == NLAYER - 1) { const int s = row / LSEQ, t = row - s * LSEQ; if (t >= NMETA) st16_f32(F.out + ((size_t)s * SEQ + (t - NMETA)) * D, F.lane, x); }
            else { st16_bf16(F.hbuf() + (size_t)row * D, F.lane, x); st16_fp8((unsigned char*)F.out + OUT_HIN8 + (size_t)row * D, F.lane, x); } } }
    }
}

__device__ __forceinline__ f32x4 mfma16(bf16x8 x, bf16x8 y, f32x4 c) { return __builtin_amdgcn_mfma_f32_16x16x32_bf16(x, y, c, 0, 0, 0); }
__device__ __forceinline__ float dpp_f(float v, int ctrl_sel) {
    const int x = __float_as_int(v); int r;
    if (ctrl_sel == 0) r = __builtin_amdgcn_update_dpp(0, x, 0xB1, 0xF, 0xF, true);
    else if (ctrl_sel == 1) r = __builtin_amdgcn_update_dpp(0, x, 0x4E, 0xF, 0xF, true);
    else r = __builtin_amdgcn_update_dpp(0, x, 0x141, 0xF, 0xF, true);
    return __int_as_float(r);
}
__device__ __forceinline__ float red8(float v) { v += dpp_f(v, 0); v += dpp_f(v, 1); v += dpp_f(v, 2); return v; }
__device__ __forceinline__ float ldbf(const bf16_t* p) { return bf2f(*p); }

__device__ __forceinline__ bf16x8 pack4_(f32x4 a) { u32x4 r; r.x = pk2(a[0], a[1]); r.y = pk2(a[2], a[3]); r.z = 0u; r.w = 0u; return __builtin_bit_cast(bf16x8, r); }
__device__ __forceinline__ bf16x8 pack8_(f32x4 a, f32x4 b) { u32x4 r; r.x = pk2(a[0], a[1]); r.y = pk2(a[2], a[3]); r.z = pk2(b[0], b[1]); r.w = pk2(b[2], b[3]); return __builtin_bit_cast(bf16x8, r); }
__device__ __forceinline__ bf16x8 ld4_(const LAS bf16_t* p) { const u32x2 v = *(const LAS u32x2*)p; u32x4 r; r.x = v.x; r.y = v.y; r.z = 0u; r.w = 0u; return __builtin_bit_cast(bf16x8, r); }
__device__ __forceinline__ bf16x8 ld44_(const LAS bf16_t* p, const LAS bf16_t* q) { const u32x2 v = *(const LAS u32x2*)p, w = *(const LAS u32x2*)q; u32x4 r; r.x = v.x; r.y = v.y; r.z = w.x; r.w = w.y; return __builtin_bit_cast(bf16x8, r); }
__device__ __forceinline__ void rwkv_task(const Frame& F1, int li, int s, int d, int hg) {
    Frame F = F1; asm volatile("" : "+v"(F.tid), "+v"(F.lane));
    constexpr int DER = 17152;
    LAS float* ST = (LAS float*)(F.lds + 4 * DER);
    constexpr int STS = 260, STB = 2 * 16 * STS * 4;
    LAS bf16_t* TW = (LAS bf16_t*)(F.lds + 4 * DER + STB);
    LAS bf16_t* AD = TW + 16 * 72;
    LAS float* HS = (LAS float*)(F.lds + 4 * DER + STB + 4608);
    const int w = F.wave, hl = w >> 1, half = w & 1, h = 4 * hg + hl, lane = F.lane, fr = lane & 15, fq = lane >> 4, c = 64 * h + lane;
    LAS bf16_t* KAP = (LAS bf16_t*)(F.lds + hl * DER);
    LAS bf16_t* BH = KAP + 16 * 72; LAS bf16_t* KH = BH + 16 * 72; LAS bf16_t* RTL = KH + 16 * 72;
    LAS bf16_t* KBT = RTL + 16 * 72;
    LAS bf16_t* BBT = KBT + 64 * 20; LAS bf16_t* VT = BBT + 64 * 20;
    LAS float* GC = (LAS float*)(VT + 64 * 20);
    const bf16_t* U = F.ubuf();
    const float* mu = F.in[I_MU] + (size_t)li * 1920;
    const bf16_t* W2T = (const bf16_t*)(F.ws + WS_RW2T) + (((size_t)li * 2 + d) * 2 + 0) * 512 * 64 + (size_t)(64 * h + 32 * half + fr) * 64 + fq * 8; const bf16_t* A2T = W2T + (size_t)512 * 64;
    const float mu_r = mu[c], mu_k = mu[512 + c], mu_v = mu[1024 + c];
    const float w0c = F.in[I_W0][((size_t)li * 2 + d) * 512 + c], a0c = F.in[I_A0][((size_t)li * 2 + d) * 512 + c];
    const float kkc = F.in[I_KK][(size_t)li * 512 + c], kac = F.in[I_KA][(size_t)li * 512 + c], rkc = F.in[I_RK][(size_t)li * 512 + c];
    const int p_tt = F.tid >> 5, p_j = (F.tid & 31) * 2;
    const float mu_wd0 = mu[1536 + d * 64 + p_j], mu_wd1 = mu[1537 + d * 64 + p_j], mu_ad0 = mu[1664 + d * 64 + p_j], mu_ad1 = mu[1665 + d * 64 + p_j];
    float* bon = (float*)(F.ws + WS_BON);
    bf16_t* yout = (d == 0 ? F.br() : F.brx());
    const int ldy = (d == 0 ? 2048 : 1024);
    f32x4 Sacc[2][4];
#pragma unroll
    for (int it = 0; it < 2; ++it)
#pragma unroll
        for (int jt = 0; jt < 4; ++jt) Sacc[it][jt] = (f32x4){0.f, 0.f, 0.f, 0.f};
    const size_t rowbase = (size_t)s * LSEQ;
    const bool second = (d == 0) ? (half == 1) : (half == 0);
    unsigned pw[3], pa[3]; unsigned short pr[10], pk_[10], pv[10];
    auto prefetchA = [&](int t0) __attribute__((always_inline)) {
        { const int t = t0 + p_tt; const bf16_t* up = U + (rowbase + t) * N1 + 64 * d + p_j;
          const bf16_t* um = up - ((t > 0) ? N1 : 0); const bf16_t* upl = up + ((t < LSEQ - 1) ? N1 : 0);
          pw[1] = *(const unsigned*)(up + U1_WDN); pa[1] = *(const unsigned*)(up + U1_ADN);
          pw[0] = *(const unsigned*)(um + U1_WDN); pa[0] = *(const unsigned*)(um + U1_ADN);
          pw[2] = *(const unsigned*)(upl + U1_WDN); pa[2] = *(const unsigned*)(upl + U1_ADN); }
    };
    auto prefetchB = [&](int t0) __attribute__((always_inline)) {
        { const int tb = t0 + 8 * half - 1;
#pragma unroll
          for (int i = 0; i < 10; ++i) { int t = tb + i; t = t < 0 ? 0 : (t > LSEQ - 1 ? LSEQ - 1 : t); const bf16_t* up = U + (rowbase + t) * N1 + c;
            pr[i] = up[U1_R]; pk_[i] = up[U1_K]; pv[i] = up[U1_V]; } }
    };
    bf16x8 Xw[2][2], Xa[2][2];
#pragma unroll
    for (int ct = 0; ct < 2; ++ct)
#pragma unroll
        for (int ks = 0; ks < 2; ++ks) { Xw[ct][ks] = *(const bf16x8*)(W2T + ct * 16 * 64 + ks * 32); Xa[ct][ks] = *(const bf16x8*)(A2T + ct * 16 * 64 + ks * 32);
            asm volatile("" : "+v"(Xw[ct][ks]), "+v"(Xa[ct][ks])); }
    auto do_p1 = [&](int t0) __attribute__((always_inline)) {
        { float x[2], y[2];
          const unsigned mkm = (t0 + p_tt > 0) ? 0xffffffffu : 0u, mkp = (t0 + p_tt < LSEQ - 1) ? 0xffffffffu : 0u;
          const unsigned pw0 = pw[0] & mkm, pw2 = pw[2] & mkp, pa0 = pa[0] & mkm, pa2 = pa[2] & mkp;
#pragma unroll
          for (int e = 0; e < 2; ++e) { const int sh = 16 * e;
            const float x0 = bf2f((bf16_t)((pw[1] >> sh) & 0xffffu)), xm = bf2f((bf16_t)((pw0 >> sh) & 0xffffu)), xp = bf2f((bf16_t)((pw2 >> sh) & 0xffffu));
            const float y0 = bf2f((bf16_t)((pa[1] >> sh) & 0xffffu)), ym = bf2f((bf16_t)((pa0 >> sh) & 0xffffu)), yp = bf2f((bf16_t)((pa2 >> sh) & 0xffffu));
            { const float xa_ = x0 + (e ? mu_wd1 : mu_wd0) * (0.5f * (xm + xp) - x0); x[e] = 1.0f - 2.0f * __builtin_amdgcn_rcpf(1.0f + __expf(2.0f * xa_)); } y[e] = y0 + (e ? mu_ad1 : mu_ad0) * (0.5f * (ym + yp) - y0); }
          *(LAS unsigned*)(TW + p_tt * 72 + p_j) = pk2(x[0], x[1]); *(LAS unsigned*)(AD + p_tt * 72 + p_j) = pk2(y[0], y[1]); }
    };
    { const int t00 = (d == 0) ? 0 : LSEQ - 16, t01 = (d == 0) ? 16 : LSEQ - 32;
      prefetchA(t00); prefetchB(t00); do_p1(t00); prefetchA(t01); }
    __syncthreads();
    for (int ci = 0; ci < LSEQ / 16; ++ci) {
        const int t0 = (d == 0) ? 16 * ci : LSEQ - 16 - 16 * ci;
        { bf16x8 Yt[2], Ya[2];
#pragma unroll
          for (int ks = 0; ks < 2; ++ks) { Yt[ks] = *(const LAS bf16x8*)(TW + fr * 72 + ks * 32 + fq * 8); Ya[ks] = *(const LAS bf16x8*)(AD + fr * 72 + ks * 32 + fq * 8); }
#pragma unroll
          for (int ct = 0; ct < 2; ++ct) { f32x4 aw = (f32x4){0.f, 0.f, 0.f, 0.f}, aa = aw;
            aw = mfma16(Xw[ct][0], Yt[0], aw); aw = mfma16(Xw[ct][1], Yt[1], aw); aa = mfma16(Xa[ct][0], Ya[0], aa); aa = mfma16(Xa[ct][1], Ya[1], aa);
            *(LAS f32x4*)(ST + fr * STS + 64 * hl + 32 * half + ct * 16 + 4 * fq) = aw; *(LAS f32x4*)(ST + 16 * STS + fr * STS + 64 * hl + 32 * half + ct * 16 + 4 * fq) = aa; } }
        __syncthreads();
        { const bool lo_ok = (t0 + 8 * half - 1 >= 0), hi_ok = (t0 + 8 * half + 8 < LSEQ);
          if (!lo_ok) { pr[0] = 0; pk_[0] = 0; pv[0] = 0; }
          if (!hi_ok) { pr[9] = 0; pk_[9] = 0; pv[9] = 0; } }
        float lwv[8]; float tot = 0.f, other = 0.f;
#pragma unroll
        for (int i = 0; i < 8; ++i) { lwv[i] = -0.60653065971f * sigmoidf_(ST[(8 * half + i) * STS + 64 * hl + lane] + w0c); tot += lwv[i];
            other += -0.60653065971f * sigmoidf_(ST[(8 * (half ^ 1) + i) * STS + 64 * hl + lane] + w0c); }
        { const float off = second ? other : 0.f, glast = tot + other, eglast = __expf(glast);
          float run = 0.f, bsel = 0.f;
#pragma unroll
          for (int i = 0; i < 8; i += 2) {
            const int tt0 = 8 * half + i;
            const f32x2 rm = (f32x2){bf2f(pr[i]), bf2f(pr[i + 1])}, r1 = (f32x2){bf2f(pr[i + 1]), bf2f(pr[i + 2])}, rp = (f32x2){bf2f(pr[i + 2]), bf2f(pr[i + 3])};
            const f32x2 km = (f32x2){bf2f(pk_[i]), bf2f(pk_[i + 1])}, k1 = (f32x2){bf2f(pk_[i + 1]), bf2f(pk_[i + 2])}, kp = (f32x2){bf2f(pk_[i + 2]), bf2f(pk_[i + 3])};
            const f32x2 vm = (f32x2){bf2f(pv[i]), bf2f(pv[i + 1])}, v1 = (f32x2){bf2f(pv[i + 1]), bf2f(pv[i + 2])}, vp = (f32x2){bf2f(pv[i + 2]), bf2f(pv[i + 3])};
            const f32x2 r = r1 + mu_r * (0.5f * (rm + rp) - r1), k = k1 + mu_k * (0.5f * (km + kp) - k1), v = v1 + mu_v * (0.5f * (vm + vp) - v1);
            const f32x2 al = (f32x2){ST[16 * STS + tt0 * STS + 64 * hl + lane], ST[16 * STS + (tt0 + 1) * STS + 64 * hl + lane]} + a0c;
            const f32x2 a = (f32x2){sigmoidf_(al.x), sigmoidf_(al.y)};
            const f32x2 kd = k * (1.0f + (a - 1.0f) * kac), kk = k * kkc, sq = kk * kk, bs = r * kd * rkc;
            const f32x2 inrm = (f32x2){__builtin_amdgcn_rsqf(fmaxf(wave_sum(sq.x), 1e-24f)), __builtin_amdgcn_rsqf(fmaxf(wave_sum(sq.y), 1e-24f))};
            const float b0 = wave_sum(bs.x), b1 = wave_sum(bs.y);
            bsel = ((lane & 7) == i) ? b0 : (((lane & 7) == i + 1) ? b1 : bsel);
            const f32x2 kkn = kk * inrm, bt = kkn * a;
            run += lwv[i]; const float g0 = off + ((d == 0) ? run : (tot - run + lwv[i]));
            run += lwv[i + 1]; const float g1 = off + ((d == 0) ? run : (tot - run + lwv[i + 1]));
            const f32x2 eg = (f32x2){__expf(g0), __expf(g1)}, eng = (f32x2){__builtin_amdgcn_rcpf(eg.x), __builtin_amdgcn_rcpf(eg.y)}, ebar = eglast * eng;
            const f32x2 egm1 = (f32x2){__expf(g0 - lwv[i]), __expf(g1 - lwv[i + 1])};
            const f32x2 kap = kkn * egm1, bh = bt * eng, kh = kd * eng, rt = r * eg, kb = kd * ebar, bbn = -(bt * ebar);
            const int u0 = (d == 0) ? tt0 : 15 - tt0, u1 = (d == 0) ? u0 + 1 : u0 - 1, ulo = (d == 0) ? u0 : u1;
            { const unsigned p = pk2(kap.x, kap.y); KAP[u0 * 72 + lane] = (bf16_t)(p & 0xffffu); KAP[u1 * 72 + lane] = (bf16_t)(p >> 16); }
            { const unsigned p = pk2(bh.x, bh.y); BH[u0 * 72 + lane] = (bf16_t)(p & 0xffffu); BH[u1 * 72 + lane] = (bf16_t)(p >> 16); }
            { const unsigned p = pk2(kh.x, kh.y); KH[u0 * 72 + lane] = (bf16_t)(p & 0xffffu); KH[u1 * 72 + lane] = (bf16_t)(p >> 16); }
            { const unsigned p = pk2(rt.x, rt.y); RTL[u0 * 72 + lane] = (bf16_t)(p & 0xffffu); RTL[u1 * 72 + lane] = (bf16_t)(p >> 16); }
            { unsigned p = pk2(kb.x, kb.y); if (d) p = (p >> 16) | (p << 16); *(LAS unsigned*)(KBT + lane * 20 + ulo) = p; }
            { unsigned p = pk2(bbn.x, bbn.y); if (d) p = (p >> 16) | (p << 16); *(LAS unsigned*)(BBT + lane * 20 + ulo) = p; }
            { unsigned p = pk2(v.x, v.y); if (d) p = (p >> 16) | (p << 16); *(LAS unsigned*)(VT + lane * 20 + ulo) = p; } }
          bon[(rowbase + t0 + 8 * half + (lane & 7)) * 16 + d * 8 + h] = bsel;
          if (half == 0) GC[lane] = eglast; }
        if (ci + 1 < LSEQ / 16) { const int t1 = (d == 0) ? t0 + 16 : t0 - 16;
            prefetchB(t1);
            do_p1(t1);
            if (ci + 2 < LSEQ / 16) prefetchA((d == 0) ? t0 + 32 : t0 - 32); }
        __syncthreads();
        f32x4 aA = (f32x4){0.f, 0.f, 0.f, 0.f}, aAT = aA, aBT = aA, aC1 = aA, aC2 = aA;
#pragma unroll
        for (int ks = 0; ks < 2; ++ks) { const int o = fr * 72 + 32 * ks + 8 * fq;
            const bf16x8 fK = *(const LAS bf16x8*)(KAP + o), fB = *(const LAS bf16x8*)(BH + o), fH = *(const LAS bf16x8*)(KH + o), fR = *(const LAS bf16x8*)(RTL + o);
            aA = mfma16(fK, fB, aA); aAT = mfma16(fB, fK, aAT); aBT = mfma16(fH, fK, aBT); aC1 = mfma16(fH, fR, aC1); aC2 = mfma16(fB, fR, aC2); }
        f32x4 N, NT, H1;
#pragma unroll
        for (int e = 0; e < 4; ++e) { const int row = 4 * fq + e;
            N[e] = (fr < row) ? -aA[e] : 0.f; NT[e] = (row < fr) ? -aAT[e] : 0.f; aBT[e] = (row < fr) ? aBT[e] : 0.f;
            aC1[e] = (row <= fr) ? aC1[e] : 0.f; aC2[e] = (row <= fr) ? aC2[e] : 0.f; H1[e] = NT[e] + ((row == fr) ? 1.0f : 0.f); }
        const f32x4 Z4 = (f32x4){0.f, 0.f, 0.f, 0.f};
        const bf16x8 pN = pack4_(N), pNT = pack4_(NT);
        const f32x4 N2 = mfma16(pNT, pN, Z4), N2T = mfma16(pN, pNT, Z4);
        const bf16x8 pN2 = pack4_(N2), pN2T = pack4_(N2T);
        const f32x4 N4 = mfma16(pN2T, pN2, Z4), N4T = mfma16(pN2, pN2T, Z4);
        const bf16x8 pN4 = pack4_(N4);
        const f32x4 N8 = mfma16(pack4_(N4T), pN4, Z4);
        const f32x4 G1T = mfma16(pN2, pack4_(H1), H1);
        const f32x4 G2T = mfma16(pN4, pack4_(G1T), G1T);
        const f32x4 TT = mfma16(pack4_(N8), pack4_(G2T), G2T);
        const bf16x8 pTT = pack4_(TT), pBT = pack4_(aBT), pC1 = pack4_(aC1), pC2 = pack4_(aC2);
#pragma unroll
        for (int it = 0; it < 2; ++it) {
            const int i0 = 32 * half + 16 * it;
            const bf16x8 Vf = ld4_(VT + (i0 + fr) * 20 + 4 * fq);
            const bf16x8 Sf0 = pack8_(Sacc[it][0], Sacc[it][1]), Sf1 = pack8_(Sacc[it][2], Sacc[it][3]);
            f32x4 R = mfma16(ld44_(KAP + fr * 72 + 4 * fq, KAP + fr * 72 + 16 + 4 * fq), Sf0, Z4);
            R = mfma16(ld44_(KAP + fr * 72 + 32 + 4 * fq, KAP + fr * 72 + 48 + 4 * fq), Sf1, R);
            R = mfma16(pBT, Vf, R);
            const f32x4 Uu = mfma16(pTT, pack4_(R), Z4);
            f32x4 y = mfma16(Sf0, ld44_(RTL + fr * 72 + 4 * fq, RTL + fr * 72 + 16 + 4 * fq), Z4);
            y = mfma16(Sf1, ld44_(RTL + fr * 72 + 32 + 4 * fq, RTL + fr * 72 + 48 + 4 * fq), y);
            y = mfma16(Vf, pC1, y);
            const bf16x8 pU = pack4_(Uu), pUn = pack4_(-Uu);
            y = mfma16(pUn, pC2, y);
            { const int t = (d == 0) ? (t0 + fr) : (t0 + 15 - fr); u32x2 o; o.x = pk2(y[0], y[1]); o.y = pk2(y[2], y[3]);
              *(u32x2*)(yout + (rowbase + t) * ldy + 512 + 64 * h + i0 + 4 * fq) = o; }
#pragma unroll
            for (int jt = 0; jt < 4; ++jt) { const f32x4 dc = *(const LAS f32x4*)(GC + 16 * jt + 4 * fq);
                f32x4 acc = Sacc[it][jt] * dc;
                acc = mfma16(ld4_(KBT + (16 * jt + fr) * 20 + 4 * fq), Vf, acc);
                acc = mfma16(ld4_(BBT + (16 * jt + fr) * 20 + 4 * fq), pU, acc);
                Sacc[it][jt] = acc; }
            __builtin_amdgcn_sched_barrier(0);
        }
    }
    __syncthreads();
}

__device__ __forceinline__ void lru_block(const Frame& F1, int li, int s, int d, int g) {
    Frame F = F1; asm volatile("" : "+v"(F.tid), "+v"(F.lane));
    const int lane = F.lane, fr = lane & 15, fq = lane >> 4, c = 64 * g + lane;
    LAS bf16_t* XCT = (LAS bf16_t*)F.lds + F.wave * (16 * 72);
    constexpr int RSS = 68;
    LAS float* RS = (LAS float*)(F.lds + 18432) + F.wave * (3 * 16 * RSS);
    const bf16_t* U = F.ubuf();
    bf16x8 Xr[4][2], Xi[4][2];
    { const bf16_t* wrt = (const bf16_t*)(F.ws + WS_LRUT) + ((((size_t)li * 2 + d) * 2 + 0) * 8 + g) * 64 * 64; const bf16_t* wit = wrt + (size_t)8 * 64 * 64;
#pragma unroll
      for (int ct = 0; ct < 4; ++ct)
#pragma unroll
        for (int ks = 0; ks < 2; ++ks) { Xr[ct][ks] = *(const bf16x8*)(wrt + (ct * 16 + fr) * 64 + ks * 32 + fq * 8); Xi[ct][ks] = *(const bf16x8*)(wit + (ct * 16 + fr) * 64 + ks * 32 + fq * 8); } }
    const float* cw = F.in[I_CONVW] + (size_t)li * 4 * 512;
    const float cw0 = cw[c], cw1 = cw[512 + c], cw2 = cw[1024 + c], cw3 = cw[1536 + c], cb = F.in[I_CONVB][(size_t)li * 512 + c];
    const float brc = F.in[I_BR][((size_t)li * 2 + d) * 512 + c], bic = F.in[I_BI][((size_t)li * 2 + d) * 512 + c];
    const float lamfac = -8.0f * softplusf_(-F.in[I_LAM][((size_t)li * 2 + d) * 512 + c]);
    bf16_t* hout = (d == 0 ? F.br() : F.brx()); const int ldy = (d == 0 ? 2048 : 1024);
    const size_t rowbase = (size_t)s * LSEQ;
    float hs = 0.f;
    unsigned short px[19];
    auto lru_prefetch = [&](int t0) {
#pragma unroll
        for (int i = 0; i < 19; ++i) { int t = t0 - 2 + i; t = t < 0 ? 0 : (t > LSEQ - 1 ? LSEQ - 1 : t); px[i] = U[(rowbase + t) * N1 + U1_AX + c]; } };
    lru_prefetch((d == 0) ? 0 : LSEQ - 16);
    for (int ci = 0; ci < LSEQ / 16; ++ci) {
        const int t0 = (d == 0) ? 16 * ci : LSEQ - 16 - 16 * ci;
        { float xa[19];
#pragma unroll
          for (int i = 0; i < 19; ++i) { const int t = t0 - 2 + i; xa[i] = (t >= 0 && t < LSEQ) ? bf2f(px[i]) : 0.f; }
          if (ci + 1 < LSEQ / 16) lru_prefetch((d == 0) ? t0 + 16 : t0 - 16);
#pragma unroll
          for (int tt = 0; tt < 16; ++tt) { const float xc = cb + cw0 * xa[tt] + cw1 * xa[tt + 1] + cw2 * xa[tt + 2] + cw3 * xa[tt + 3];
            XCT[tt * 72 + lane] = f2bf(xc); RS[32 * RSS + tt * RSS + lane] = xc; } }
        { bf16x8 Y[2];
#pragma unroll
          for (int ks = 0; ks < 2; ++ks) Y[ks] = *(const LAS bf16x8*)(XCT + fr * 72 + ks * 32 + fq * 8);
#pragma unroll
          for (int ct = 0; ct < 4; ++ct) { f32x4 ar = (f32x4){0.f, 0.f, 0.f, 0.f}, ai = ar;
            ar = mfma16(Xr[ct][0], Y[0], ar); ar = mfma16(Xr[ct][1], Y[1], ar); ai = mfma16(Xi[ct][0], Y[0], ai); ai = mfma16(Xi[ct][1], Y[1], ai);
            *(LAS f32x4*)(RS + fr * RSS + ct * 16 + 4 * fq) = ar; *(LAS f32x4*)(RS + 16 * RSS + fr * RSS + ct * 16 + 4 * fq) = ai; } }
        { float av[16], bbv[16];
#pragma unroll
          for (int i = 0; i < 16; ++i) { const int tt = (d == 0) ? i : 15 - i;
            const float r = sigmoidf_(RS[tt * RSS + lane] + brc), ig = sigmoidf_(RS[16 * RSS + tt * RSS + lane] + bic), xc = RS[32 * RSS + tt * RSS + lane];
            const float a = __expf(lamfac * r); av[i] = a; bbv[i] = __builtin_amdgcn_sqrtf(fmaxf(1.0f - a * a, 0.f)) * ig * xc; }
#pragma unroll
          for (int i = 0; i < 16; ++i) { const int tt = (d == 0) ? i : 15 - i; hs = av[i] * hs + bbv[i]; hout[(rowbase + t0 + tt) * ldy + c] = f2bf(hs); } }
    }
}
__device__ __forceinline__ void lru_task(const Frame& F, int li, int s, int d) { lru_block(F, li, s, d, F.wave); __syncthreads(); }

__device__ __forceinline__ void phase_scan1(const Frame& F0, int li) {
    Frame F = F0; { size_t z_ = 0; asm volatile("" : "+v"(F.tid), "+v"(F.lane), "+s"(z_), "+s"(F.bid), "+s"(F.G), "+s"(F.wave)); F.ws = F0.ws + z_; F.out = F0.out + z_; }
    if (F.G == 256) {
        if (F.bid < 192) rwkv_task(F, li, F.bid >> 2, (F.bid >> 1) & 1, F.bid & 1);
        else {
            const int j = F.bid - 192, b0 = 12 * j + F.wave;
            lru_block(F, li, b0 >> 4, (b0 >> 3) & 1, b0 & 7);
            if (F.wave < 4) { const int b1 = 12 * j + 8 + F.wave; lru_block(F, li, b1 >> 4, (b1 >> 3) & 1, b1 & 7); }
            __syncthreads(); }
    } else {
        for (int task = F.bid; task < 288; task += F.G) {
            if (task < 192) rwkv_task(F, li, task >> 2, (task >> 1) & 1, task & 1);
            else lru_task(F, li, (task - 192) >> 1, (task - 192) & 1);
        }
    }
}

__device__ __forceinline__ void phase_post1(const Frame& F0, int li) {
    Frame F = F0; { size_t z_ = 0; asm volatile("" : "+v"(F.tid), "+v"(F.lane), "+s"(z_), "+s"(F.bid), "+s"(F.G), "+s"(F.wave)); F.ws = F0.ws + z_; F.out = F0.out + z_; }
    const int lane = F.lane, fr = lane & 15, fq = lane >> 4;
    LAS bf16_t* SG = (LAS bf16_t*)F.lds + F.wave * (16 * 136);
    const bf16_t* U = F.ubuf(); const bf16_t* G2T = (const bf16_t*)(F.ws + WS_G2T) + (size_t)li * 512 * 128;
    const float* mu = F.in[I_MU] + (size_t)li * 1920; const float* bon = (const float*)(F.ws + WS_BON);
    const float* lng = F.in[I_LNXG] + (size_t)li * 512; const float* lnb = F.in[I_LNXB] + (size_t)li * 512;
    bf16_t* BR = F.br(); const bf16_t* BRX = F.brx();
    LAS float* PM = (LAS float*)(F.lds + 40960);
    for (int i = F.tid; i < 512; i += NTHREADS) { PM[i] = mu[1024 + i]; PM[512 + i] = lng[i]; PM[1024 + i] = lnb[i]; }
    __syncthreads();
    const int gw = F.bid * NWAVES + F.wave, nw = F.G * NWAVES;
    for (int tile = gw; tile < NTOK / 16; tile += nw) {
        const int row0 = tile * 16;
#pragma unroll 4
        for (int r = 0; r < 16; ++r) { bf16_t* p = BR + (size_t)(row0 + r) * 2048 + 8 * lane; const u32x4 a = *(const u32x4*)p, b = *(const u32x4*)(BRX + (size_t)(row0 + r) * 1024 + 8 * lane);
            const unsigned aw[4] = {a.x, a.y, a.z, a.w}, bw[4] = {b.x, b.y, b.z, b.w}; unsigned o[4];
#pragma unroll
            for (int j = 0; j < 4; ++j) o[j] = pk2(bf2f((bf16_t)(aw[j] & 0xffffu)) + bf2f((bf16_t)(bw[j] & 0xffffu)), bf2f((bf16_t)(aw[j] >> 16)) + bf2f((bf16_t)(bw[j] >> 16)));
            u32x4 w; w.x = o[0]; w.y = o[1]; w.z = o[2]; w.w = o[3]; *(u32x4*)p = w; }
#pragma unroll 4
        for (int r = 0; r < 16; ++r) { const int row = row0 + r, s = row / LSEQ, t = row - s * LSEQ; const bf16_t* up = U + (size_t)row * N1 + U1_GDN + 2 * lane;
            const unsigned x0 = *(const unsigned*)up, xm = (t > 0) ? *(const unsigned*)(up - N1) : 0u, xp = (t < LSEQ - 1) ? *(const unsigned*)(up + N1) : 0u;
            const float m0 = mu[1792 + 2 * lane], m1 = mu[1793 + 2 * lane];
            const float a0 = bf2f((bf16_t)(x0 & 0xffffu)), a1 = bf2f((bf16_t)(x0 >> 16));
            const float g0 = a0 + m0 * (0.5f * (bf2f((bf16_t)(xm & 0xffffu)) + bf2f((bf16_t)(xp & 0xffffu))) - a0), g1 = a1 + m1 * (0.5f * (bf2f((bf16_t)(xm >> 16)) + bf2f((bf16_t)(xp >> 16))) - a1);
            *(LAS unsigned*)(SG + r * 136 + 2 * lane) = pk2(sigmoidf_(g0), sigmoidf_(g1)); }
        bf16x8 Y[4];
#pragma unroll
        for (int ks = 0; ks < 4; ++ks) Y[ks] = *(const LAS bf16x8*)(SG + fr * 136 + ks * 32 + fq * 8);
        const int row = row0 + fr, s = row / LSEQ, t = row - s * LSEQ;
        struct HIn { u32x2 a[4], b[4], v0[4], vm[4], vp[4]; float b0, b1; };
        auto hload = [&](int h, HIn& I) __attribute__((always_inline)) {
#pragma unroll
            for (int ct = 0; ct < 4; ++ct) { const int col = 512 + 64 * h + ct * 16 + 4 * fq; I.a[ct] = *(const u32x2*)(BR + (size_t)row * 2048 + col); I.b[ct] = *(const u32x2*)(BRX + (size_t)row * 1024 + col);
                const bf16_t* up = U + (size_t)row * N1 + U1_V + 64 * h + ct * 16 + 4 * fq;
                I.v0[ct] = *(const u32x2*)up; I.vm[ct] = *(const u32x2*)(up - ((t > 0) ? N1 : 0)); I.vp[ct] = *(const u32x2*)(up + ((t < LSEQ - 1) ? N1 : 0)); }
            I.b0 = bon[(size_t)row * 16 + h]; I.b1 = bon[(size_t)row * 16 + 8 + h]; };
        auto hcomp = [&](int h, const HIn& I) __attribute__((always_inline)) {
            f32x4 gacc[4];
#pragma unroll
            for (int ct = 0; ct < 4; ++ct) { gacc[ct] = (f32x4){0.f, 0.f, 0.f, 0.f};
#pragma unroll
                for (int ks = 0; ks < 4; ++ks) { const bf16x8 X = *(const bf16x8*)(G2T + (size_t)(64 * h + ct * 16 + fr) * 128 + ks * 32 + fq * 8); gacc[ct] = mfma16(X, Y[ks], gacc[ct]); } }
            float y[16]; float sm = 0.f;
#pragma unroll
            for (int ct = 0; ct < 4; ++ct) { const u32x2 a = I.a[ct], b = I.b[ct];
                y[4 * ct] = bf2f((bf16_t)(a.x & 0xffffu)) + bf2f((bf16_t)(b.x & 0xffffu)); y[4 * ct + 1] = bf2f((bf16_t)(a.x >> 16)) + bf2f((bf16_t)(b.x >> 16));
                y[4 * ct + 2] = bf2f((bf16_t)(a.y & 0xffffu)) + bf2f((bf16_t)(b.y & 0xffffu)); y[4 * ct + 3] = bf2f((bf16_t)(a.y >> 16)) + bf2f((bf16_t)(b.y >> 16)); }
#pragma unroll
            for (int i = 0; i < 16; ++i) sm += y[i];
            sm = rows_sum(sm);
            const float mean = sm * (1.0f / 64.0f); float q = 0.f;
#pragma unroll
            for (int i = 0; i < 16; ++i) { const float dl = y[i] - mean; q += dl * dl; }
            q = rows_sum(q);
            const float rstd = rsqrtf(q * (1.0f / 64.0f) + 64e-5f);
            const float bsum = I.b0 + I.b1;
            const unsigned mkm = (t > 0) ? 0xffffffffu : 0u, mkp = (t < LSEQ - 1) ? 0xffffffffu : 0u;
#pragma unroll
            for (int ct = 0; ct < 4; ++ct) { const int cc = 64 * h + ct * 16 + 4 * fq;
                const f32x4 pmu = *(const LAS f32x4*)(PM + cc), pg = *(const LAS f32x4*)(PM + 512 + cc), pb = *(const LAS f32x4*)(PM + 1024 + cc);
                const unsigned v0w[2] = {I.v0[ct].x, I.v0[ct].y}, vmw[2] = {I.vm[ct].x & mkm, I.vm[ct].y & mkm}, vpw[2] = {I.vp[ct].x & mkp, I.vp[ct].y & mkp}; float o[4];
#pragma unroll
                for (int e = 0; e < 4; ++e) { const int sh = (e & 1) * 16; const float x0 = bf2f((bf16_t)((v0w[e >> 1] >> sh) & 0xffffu)), xm = bf2f((bf16_t)((vmw[e >> 1] >> sh) & 0xffffu)), xp = bf2f((bf16_t)((vpw[e >> 1] >> sh) & 0xffffu));
                    const float v = x0 + pmu[e] * (0.5f * (xm + xp) - x0);
                    const float yn = (y[4 * ct + e] - mean) * rstd * pg[e] + pb[e];
                    o[e] = (yn + bsum * v) * gacc[ct][e]; }
                u32x2 w; w.x = pk2(o[0], o[1]); w.y = pk2(o[2], o[3]);
                *(u32x2*)(BR + (size_t)row * 2048 + 512 + cc) = w; } };
        HIn hN, hC;
        hload(0, hN);
#pragma unroll 1
        for (int h = 0; h < 8; ++h) { hC = hN;
            if (h + 1 < 8) hload(h + 1, hN);
            hcomp(h, hC); }
    }
    __syncthreads();
}

template <int DK>
__device__ __forceinline__ void gla_task(const Frame& F1, int li, int s, int hd, int d) {
    Frame F = F1; asm volatile("" : "+v"(F.tid), "+v"(F.lane));
    constexpr bool RET = (DK == 64); constexpr int QS = DK + 8, TS = 72, NDT = DK / 16, NKS = DK / 32;
    LAS bf16_t* QT = (LAS bf16_t*)F.lds;
    LAS bf16_t* KT = QT + 64 * QS;
    LAS bf16_t* KBT = KT + 64 * QS;
    LAS bf16_t* VT = KBT + DK * TS;
    LAS float* DEC = (LAS float*)(VT + 128 * TS);
    const int lane = F.lane, w = F.wave, fr = lane & 15, fq = lane >> 4, tid = F.tid;
    const bf16_t* U = F.ubuf();
    bf16_t* oout = (d == 0 ? F.br() : F.brx()); const int ldy = (d == 0 ? 2048 : 1024);
    const int ocol = (d == 0 ? (RET ? 1536 : 1024) : (RET ? 512 : 0)) + 128 * hd;
    const size_t rowbase = (size_t)s * LSEQ;
    const int pd = tid & 127, pg = tid >> 7;
    float lbv = 0.f, lgam = 0.f, invf = 0.f, cth = 1.f, sth = 0.f;
    if constexpr (!RET) lbv = ((const float*)(F.ws + WS_LB))[(size_t)li * 512 + 128 * hd + pd];
    else { const float gam = sigmoidf_(F.in[I_RDEC][((size_t)li * 2 + d) * 4 + hd]); lgam = __logf(gam);
           invf = expf(-(float)(tid & 31) * (9.210340371976184f / 32.0f)); cth = cosf(invf); sth = (d == 0) ? sinf(invf) : -sinf(invf); }
    f32x4 Sacc[NDT];
#pragma unroll
    for (int i = 0; i < NDT; ++i) Sacc[i] = (f32x4){0.f, 0.f, 0.f, 0.f};
    unsigned short ra[16], rb[16], rc[16];
    const int ri = tid & 31; const bool risk = (tid & 32) != 0; const int rg2 = tid >> 6;
    auto prefetch = [&](int sc) { const int nt = (sc < 32) ? 64 : 16, tau0 = 64 * sc;
        if (16 * pg < nt) { const int tb = tau0 + 16 * pg;
#pragma unroll
            for (int i = 0; i < 16; ++i) { const int t = d ? (LSEQ - 1 - (tb + i)) : (tb + i); const bf16_t* up = U + (rowbase + t) * N2 + 128 * hd + pd;
                if constexpr (!RET) { ra[i] = up[U2_CQ]; rb[i] = up[U2_CF + 512 * d]; rc[i] = up[U2_CI]; } else rc[i] = up[U2_DV]; } }
        if constexpr (RET) { if (8 * rg2 < nt) { const int tb = tau0 + 8 * rg2; const int tfirst = d ? (LSEQ - 1 - tb) : tb;
#pragma unroll
            for (int j = 0; j < 8; ++j) { const int t = d ? (tfirst - j) : (tfirst + j); const bf16_t* up = U + (rowbase + t) * N2 + (risk ? U2_DK : U2_DQ) + 64 * hd + ri; ra[j] = up[0]; rb[j] = up[32]; } } } };
    prefetch(0);
    for (int sc = 0; sc < 33; ++sc) {
        const int nt = (sc < 32) ? 64 : 16, nsub = nt >> 4, tau0 = 64 * sc;
        if (16 * pg < nt) {
            if constexpr (!RET) {
                float kk[16]; float eb = 1.0f;
#pragma unroll
                for (int i = 0; i < 16; ++i) { const float fr_ = bf2f(rb[i]), sg = sigmoidf_(fr_); const float f = lbv + (1.0f - lbv) * sg, k = (1.0f - lbv) * (1.0f - sg);
                    eb *= f; const float enb = __builtin_amdgcn_rcpf(eb); const float q = siluf_(bf2f(ra[i])) * 0.08838834764831845f;
                    QT[(16 * pg + i) * QS + pd] = f2bf(q * eb); KT[(16 * pg + i) * QS + pd] = f2bf(k * enb); kk[i] = k * enb;
                    VT[pd * TS + 16 * pg + i] = rc[i]; }
#pragma unroll
                for (int i = 0; i < 16; i += 2) *(LAS unsigned*)(KBT + pd * TS + 16 * pg + i) = pk2(kk[i] * eb, kk[i + 1] * eb);
                DEC[pg * DK + pd] = eb;
            } else {
#pragma unroll
                for (int i = 0; i < 16; ++i) VT[pd * TS + 16 * pg + i] = rc[i];
                if (pd < 64) DEC[pg * DK + pd] = __expf(16.0f * lgam);
            }
        }
        if constexpr (RET) {
            if (8 * rg2 < nt) {
                const int tb = tau0 + 8 * rg2; const int tfirst = d ? (LSEQ - 1 - tb) : tb;
                const float ang = (float)tfirst * invf; float cs = cosf(ang), sn = sinf(ang);
#pragma unroll
                for (int j = 0; j < 8; ++j) { const int tl = 8 * rg2 + j, il = tl & 15; const float x1 = bf2f(ra[j]), x2 = bf2f(rb[j]);
                    const float o1 = x1 * cs - x2 * sn, o2 = x1 * sn + x2 * cs;
                    if (!risk) { const float sc_ = __expf((float)(il + 1) * lgam); QT[tl * QS + ri] = f2bf(o1 * sc_); QT[tl * QS + ri + 32] = f2bf(o2 * sc_); }
                    else { const float s1 = 0.125f * __expf(-(float)(il + 1) * lgam), s2 = 0.125f * __expf((float)(15 - il) * lgam);
                        KT[tl * QS + ri] = f2bf(o1 * s1); KT[tl * QS + ri + 32] = f2bf(o2 * s1); KBT[ri * TS + tl] = f2bf(o1 * s2); KBT[(ri + 32) * TS + tl] = f2bf(o2 * s2); }
                    const float cn = cs * cth - sn * sth; sn = sn * cth + cs * sth; cs = cn; }
            }
        }
        if (sc + 1 < 33) prefetch(sc + 1);
        __syncthreads();
#pragma unroll 2
        for (int g = 0; g < nsub; ++g) {
            const int r0 = 16 * g;
            f32x4 aacc = (f32x4){0.f, 0.f, 0.f, 0.f};
#pragma unroll
            for (int ks = 0; ks < NKS; ++ks) { const bf16x8 X = *(const LAS bf16x8*)(KT + (r0 + fr) * QS + 32 * ks + 8 * fq), Y = *(const LAS bf16x8*)(QT + (r0 + fr) * QS + 32 * ks + 8 * fq); aacc = mfma16(X, Y, aacc); }
#pragma unroll
            for (int e = 0; e < 4; ++e) aacc[e] = (4 * fq + e <= fr) ? aacc[e] : 0.f;
            u32x4 ya; ya.x = pk2(aacc[0], aacc[1]); ya.y = pk2(aacc[2], aacc[3]); ya.z = 0u; ya.w = 0u;
            const u32x2 vv = *(const LAS u32x2*)(VT + (16 * w + fr) * TS + r0 + 4 * fq);
            u32x4 xv; xv.x = vv.x; xv.y = vv.y; xv.z = 0u; xv.w = 0u;
            f32x4 o = (f32x4){0.f, 0.f, 0.f, 0.f};
            o = mfma16(__builtin_bit_cast(bf16x8, xv), __builtin_bit_cast(bf16x8, ya), o);
#pragma unroll
            for (int ks = 0; ks < NKS; ++ks) { u32x4 xs; xs.x = pk2(Sacc[2 * ks][0], Sacc[2 * ks][1]); xs.y = pk2(Sacc[2 * ks][2], Sacc[2 * ks][3]); xs.z = pk2(Sacc[2 * ks + 1][0], Sacc[2 * ks + 1][1]); xs.w = pk2(Sacc[2 * ks + 1][2], Sacc[2 * ks + 1][3]);
                const u32x2 q0 = *(const LAS u32x2*)(QT + (r0 + fr) * QS + 32 * ks + 4 * fq), q1 = *(const LAS u32x2*)(QT + (r0 + fr) * QS + 32 * ks + 16 + 4 * fq);
                u32x4 yq; yq.x = q0.x; yq.y = q0.y; yq.z = q1.x; yq.w = q1.y;
                o = mfma16(__builtin_bit_cast(bf16x8, xs), __builtin_bit_cast(bf16x8, yq), o); }
            { const int tau = tau0 + r0 + fr, t = d ? (LSEQ - 1 - tau) : tau; u32x2 ov; ov.x = pk2(o[0], o[1]); ov.y = pk2(o[2], o[3]);
              *(u32x2*)(oout + (rowbase + t) * ldy + ocol + 16 * w + 4 * fq) = ov; }
#pragma unroll
            for (int dt = 0; dt < NDT; ++dt) { const f32x4 dc = *(const LAS f32x4*)(DEC + g * DK + 16 * dt + 4 * fq);
                const u32x2 kb = *(const LAS u32x2*)(KBT + (16 * dt + fr) * TS + r0 + 4 * fq); u32x4 xk; xk.x = kb.x; xk.y = kb.y; xk.z = 0u; xk.w = 0u;
                Sacc[dt] = mfma16(__builtin_bit_cast(bf16x8, xk), __builtin_bit_cast(bf16x8, xv), Sacc[dt] * dc); }
        }
        __syncthreads();
    }
}
__device__ __forceinline__ void phase_scan2(const Frame& F0, int li) {
    Frame F = F0; { size_t z_ = 0; asm volatile("" : "+v"(F.tid), "+v"(F.lane), "+s"(z_), "+s"(F.bid), "+s"(F.G), "+s"(F.wave)); F.ws = F0.ws + z_; F.out = F0.out + z_; }
    for (int task = F.bid; task < 768; task += F.G) {
        const int k = task % 384, s = k >> 3, hd = (k >> 1) & 3, d = k & 1;
                if (task < 384) gla_task<128>(F, li, s, hd, d); else gla_task<64>(F, li, s, hd, d);
    }
}
__device__ __forceinline__ void phase_post2(const Frame& F0, int li) {
    Frame F = F0; { size_t z_ = 0; asm volatile("" : "+v"(F.tid), "+v"(F.lane), "+s"(z_), "+s"(F.bid), "+s"(F.G), "+s"(F.wave)); F.ws = F0.ws + z_; F.out = F0.out + z_; }
    const int lane = F.lane; bf16_t* BR = F.br(); const bf16_t* BRX = F.brx();
    { unsigned* hist = (unsigned*)(F.ws + WS_HIST); for (int i = F.bid * NTHREADS + F.tid; i < 32 * 1024; i += F.G * NTHREADS) hist[i] = 0u; }
    const float* ng = F.in[I_HNG] + (size_t)li * 512 + 8 * lane;
    float g8[8];
#pragma unroll
    for (int i = 0; i < 8; ++i) g8[i] = ng[i];
    const int gw = F.bid * NWAVES + F.wave, nw = F.G * NWAVES;
    for (int row0 = gw; row0 < NTOK; row0 += 4 * nw) {
        u32x4 A[4][2], B[4][2];
#pragma unroll
        for (int j = 0; j < 4; ++j) { const int row = row0 + j * nw; if (row < NTOK) {
#pragma unroll
            for (int sec = 0; sec < 2; ++sec) { A[j][sec] = __builtin_nontemporal_load((const u32x4*)(BR + (size_t)row * 2048 + 1024 + 512 * sec + 8 * lane)); B[j][sec] = __builtin_nontemporal_load((const u32x4*)(BRX + (size_t)row * 1024 + 512 * sec + 8 * lane)); } } }
#pragma unroll
        for (int j = 0; j < 4; ++j) { const int row = row0 + j * nw; if (row < NTOK) {
#pragma unroll
            for (int sec = 0; sec < 2; ++sec) {
                const unsigned aw[4] = {A[j][sec].x, A[j][sec].y, A[j][sec].z, A[j][sec].w}, bw[4] = {B[j][sec].x, B[j][sec].y, B[j][sec].z, B[j][sec].w}; float o[8];
#pragma unroll
                for (int i = 0; i < 4; ++i) { o[2 * i] = bf2f((bf16_t)(aw[i] & 0xffffu)) + bf2f((bf16_t)(bw[i] & 0xffffu)); o[2 * i + 1] = bf2f((bf16_t)(aw[i] >> 16)) + bf2f((bf16_t)(bw[i] >> 16)); }
                float sm = 0.f;
                if (sec == 1) {
#pragma unroll
                    for (int i = 0; i < 8; ++i) sm += o[i];
                    sm += dppx(sm, 0); sm += dppx(sm, 1); sm += dppx(sm, 2); sm += dppx(sm, 3);
                    sm *= (1.0f / 128.0f); }
                float q = 0.f;
#pragma unroll
                for (int i = 0; i < 8; ++i) { o[i] -= sm; q += o[i] * o[i]; }
                q += dppx(q, 0); q += dppx(q, 1); q += dppx(q, 2); q += dppx(q, 3);
                const float rs = rsqrtf(q * (1.0f / 128.0f) + 1e-6f);
#pragma unroll
                for (int i = 0; i < 8; ++i) o[i] = o[i] * rs * (sec == 0 ? g8[i] : 1.0f);
                u32x4 wv; wv.x = pk2(o[0], o[1]); wv.y = pk2(o[2], o[3]); wv.z = pk2(o[4], o[5]); wv.w = pk2(o[6], o[7]);
                *(u32x4*)(BR + (size_t)row * 2048 + 1024 + 512 * sec + 8 * lane) = wv; } } }
    }
}

constexpr int NPL = 17, NPHASE = 1 + NLAYER * NPL;
__global__ void __launch_bounds__(NTHREADS, 2) mega(Args args) {
    extern __shared__ __attribute__((aligned(16))) unsigned char lds_raw[];
    Frame F; F.in = args.in; F.out = args.out; F.ws = args.ws; F.lds = (LAS unsigned char*)lds_raw; F.ldsg = lds_raw;
    F.tid = threadIdx.x; F.lane = F.tid & 63; F.wave = __builtin_amdgcn_readfirstlane(F.tid >> 6); F.G = gridDim.x; F.bid = blockIdx.x;
    const int lo = args.ph_lo, hi = args.ph_hi;
    const bool single = (hi - lo) > 1;
    volatile LAS unsigned* misc = (volatile LAS unsigned*)(F.lds + LDS_MISC);
    if (F.tid < 8) misc[F.tid] = 0u;
    __syncthreads();
    XcdBarrier bar; bar.bar = (unsigned*)(F.ws + WS_CTL) + CW_BAR; bar.x = 0; bar.st = misc;
    if (single) bar = xcd_barrier_post((unsigned*)(F.ws + WS_CTL) + CW_BAR, misc);
#ifndef PH_MASK
#define PH_MASK 0xFFFFFFu
#endif
#define PHON(o) (((PH_MASK) >> (o)) & 1u)
#ifndef DUP_MASK
#define DUP_MASK 0u
#endif
#define DUPN(o) (1 + (int)(((DUP_MASK) >> (o)) & 1u))
#define CJ_A1 1130
#define CJ_A2 2230
#define CJ_G  3658
#define CJ_P  4074
#define CJ_M  4096
#define IN(k) (lo <= (k) && (k) < hi)
#define SEAM(k) do { if (IN(k) && IN((k) + 1)) xcd_barrier(bar); } while (0)
    LAS unsigned char* glds = F.lds;
    if (PHON(20) && IN(0)) { phase_prep_weights(F); phase_embed(F); }
    SEAM(0);
    if (single) {
        if (F.tid == 0) { unsigned ok = ((F.G & 7) == 0) ? 1u : 0u;
            for (int j = 0; j < 16; ++j) { const unsigned cj = xb_ld(bar.bar + XB_XCNT(j)); if (j < 8 ? (cj != (unsigned)F.G / 8u) : (cj != 0u)) ok = 0u; }
            const unsigned r = misc[2]; misc[3] = (ok && bar.x < 8u && r < (unsigned)F.G / 8u) ? (r * 8u + bar.x) : (unsigned)F.bid; }
        __syncthreads();
        F.bid = __builtin_amdgcn_readfirstlane((int)misc[3]);
    }
    for (int li = 0; li < NLAYER; ++li) {
        const int pb = 1 + li * NPL;
        for (int rep = 0; rep < DUPN(0); ++rep) if (PHON(0) && IN(pb + 0)) { Frame Fq = F; { size_t z_ = 0; asm volatile("" : "+s"(z_), "+s"(Fq.bid), "+s"(Fq.G)); Fq.ws = F.ws + z_; Fq.out = F.out + z_; } const Frame& F = Fq;
            SchedPlain S; S.T.init(NTILE_M, N1 / 256, F.G, F.bid); S.A = (const char*)F.hbuf(); S.B = (const char*)(F.ws + WS_W1T + (size_t)li * N1 * D * 2); S.astep = (size_t)256 * D * 2; S.bstep = (size_t)256 * D * 2;
            EpiStoreBf16 E; E.O0 = E.O1 = E.O2 = E.O3 = F.ubuf(); E.ldo = N1;
            pg8::gemm_phase<EpiStoreBf16, SchedPlain, false>(glds, D, D, D, S, E); }
        if (PHON(0) && IN(pb + 0)) phase_prep_experts(F, li, 0, CJ_A1, NTILE_M * (N1 / 256));
        SEAM(pb + 0);
        for (int rep = 0; rep < DUPN(1); ++rep) if (PHON(1) && IN(pb + 1)) phase_scan1(F, li);
        SEAM(pb + 1);
        if (PHON(2) && IN(pb + 2)) phase_post1(F, li);
        SEAM(pb + 2);
        for (int rep = 0; rep < DUPN(3); ++rep) if (PHON(3) && IN(pb + 3)) { Frame Fq = F; { size_t z_ = 0; asm volatile("" : "+s"(z_), "+s"(Fq.bid), "+s"(Fq.G)); Fq.ws = F.ws + z_; Fq.out = F.out + z_; } const Frame& F = Fq;
            SchedPlain S; S.T.init(NTILE_M, N2 / 256, F.G, F.bid); S.A = (const char*)F.hbuf(); S.B = (const char*)(F.ws + WS_W2T + (size_t)li * N2 * D * 2); S.astep = (size_t)256 * D * 2; S.bstep = (size_t)256 * D * 2;
            EpiStoreBf16 E; E.O0 = E.O1 = E.O2 = E.O3 = F.ubuf(); E.ldo = N2;
            pg8::gemm_phase<EpiStoreBf16, SchedPlain, false>(glds, D, D, D, S, E); }
        if (PHON(3) && IN(pb + 3)) phase_prep_experts(F, li, CJ_A1, CJ_A2, NTILE_M * (N2 / 256));
        SEAM(pb + 3);
        for (int rep = 0; rep < DUPN(4); ++rep) if (PHON(4) && IN(pb + 4)) phase_scan2(F, li);
        SEAM(pb + 4);
        if (PHON(5) && IN(pb + 5)) phase_post2(F, li);
        SEAM(pb + 5);
        if (PHON(6) && IN(pb + 6)) { Frame Fq = F; { size_t z_ = 0; asm volatile("" : "+s"(z_), "+s"(Fq.bid), "+s"(Fq.G)); Fq.ws = F.ws + z_; Fq.out = F.out + z_; } const Frame& F = Fq;
            SchedPlain S; S.T.init(NTILE_M, NG / 256, F.G, F.bid); S.A = (const char*)F.hbuf(); S.B = (const char*)(F.ws + WS_WGT + (size_t)li * NG * D * 2); S.astep = (size_t)256 * D * 2; S.bstep = (size_t)256 * D * 2;
            EpiGate E; E.BR = F.br();
            pg8::gemm_phase<EpiGate, SchedPlain, false>(glds, D, D, D, S, E); }
        if (PHON(6) && IN(pb + 6)) phase_prep_experts(F, li, CJ_A2, CJ_G, NTILE_M * (NG / 256));
        SEAM(pb + 6);
        for (int rep = 0; rep < DUPN(7); ++rep) if (PHON(7) && IN(pb + 7)) { Frame Fq = F; { size_t z_ = 0; asm volatile("" : "+s"(z_), "+s"(Fq.bid), "+s"(Fq.G)); Fq.ws = F.ws + z_; Fq.out = F.out + z_; } const Frame& F = Fq;
            SchedP S; S.T.init(NTILE_M, 16, F.G, F.bid); S.A = (const char*)F.br(); S.B = (const char*)(F.ws + WS_WBT + (size_t)li * 4 * D * 512 * 2);
            EpiStoreBf16 E; E.O0 = F.pb(0); E.O1 = F.pb(1); E.O2 = F.pb(2); E.O3 = F.pb(3); E.ldo = D;
            pg8::gemm_phase<EpiStoreBf16, SchedP, false>(glds, 512, 2048, 512, S, E); }
        if (PHON(7) && IN(pb + 7)) phase_prep_experts(F, li, CJ_G, CJ_P, NTILE_M * 16);
        SEAM(pb + 7);
        for (int rep = 0; rep < DUPN(8); ++rep) if (PHON(8) && IN(pb + 8)) { Frame Fq = F; { size_t z_ = 0; asm volatile("" : "+s"(z_), "+s"(Fq.bid), "+s"(Fq.G)); Fq.ws = F.ws + z_; Fq.out = F.out + z_; } const Frame& F = Fq;
            SchedPlain S; S.T.init(NTILE_M, NM / 256, F.G, F.bid); S.A = (const char*)F.out + OUT_HIN8; S.B = (const char*)(F.ws + WS_WMT + (size_t)li * NM * D); S.astep = (size_t)256 * D; S.bstep = (size_t)256 * D;
            EpiMerge E; E.PB0 = F.pb(0); E.PB1 = F.pb(1); E.PB2 = F.pb(2); E.PB3 = F.pb(3); E.MG = (bf16_t*)(F.ws + R_MERGED);
            pg8::gemm_phase<EpiMerge, SchedPlain, false, true>(glds, D / 2, D / 2, D / 2, S, E); }
        if (PHON(8) && IN(pb + 8)) phase_prep_experts(F, li, CJ_P, CJ_M, NTILE_M * (NM / 256));
        SEAM(pb + 8);
        if (PHON(9) && IN(pb + 9) && ((F.bid & 1) == 0)) phase_prep_experts(F, li, CJ_M, NE * 384, 4 * NTILE_M);
        for (int rep = 0; rep < DUPN(9); ++rep) if (PHON(9) && IN(pb + 9)) { Frame Fq = F; { size_t z_ = 0; asm volatile("" : "+s"(z_), "+s"(Fq.bid), "+s"(Fq.G)); Fq.ws = F.ws + z_; Fq.out = F.out + z_; } const Frame& F = Fq;
            SchedPlain S; S.T.init(NTILE_M, D / 256, F.G, F.bid); S.A = (const char*)(F.ws + R_MERGED); S.B = (const char*)(F.ws + WS_WOT + (size_t)li * D * D * 2); S.astep = (size_t)256 * D * 2; S.bstep = (size_t)256 * D * 2;
            EpiOut E; E.H = F.hbuf(); E.X1 = (bf16_t*)(F.ws + R_X1);
            pg8::gemm_phase<EpiOut, SchedPlain, false>(glds, D, D, D, S, E); }
        if (PHON(9) && IN(pb + 9) && ((F.bid & 1) == 1)) phase_prep_experts(F, li, CJ_M, NE * 384, 4 * NTILE_M);
        SEAM(pb + 9);
        if (PHON(10) && IN(pb + 10)) phase_ln1_router(F, li);
        SEAM(pb + 10);
        for (int p = 1; p < 4; ++p) { if (PHON(11) && IN(pb + 10 + p)) phase_topk(F, p); SEAM(pb + 10 + p); }
        for (int rnd = 0; rnd < 1; ++rnd) {
            for (int rep = 0; rep < DUPN(15); ++rep) if (PHON(15) && IN(pb + 14 + 2 * rnd)) { Frame Fq = F; { size_t z_ = 0; asm volatile("" : "+s"(z_), "+s"(Fq.bid), "+s"(Fq.G)); Fq.ws = F.ws + z_; Fq.out = F.out + z_; } const Frame& F = Fq;
                SchedE1 S; S.T.init(NE * ETILES, 16, F.G, F.bid); S.A = (const char*)(F.ws + R_H8); S.B = (const char*)F.out + OUT_W13; S.stok = (const int*)(F.ws + WS_STOK); S.e0 = 0;
                EpiSwiglu E; E.HE = (unsigned char*)(F.ws + R_HE);
                pg8::gemm_phase<EpiSwiglu, SchedE1, true, true>(glds, D / 2, D / 2, D / 2, S, E); }
            SEAM(pb + 14 + 2 * rnd);
            for (int rep = 0; rep < DUPN(16); ++rep) if (PHON(16) && IN(pb + 15 + 2 * rnd)) { Frame Fq = F; { size_t z_ = 0; asm volatile("" : "+s"(z_), "+s"(Fq.bid), "+s"(Fq.G)); Fq.ws = F.ws + z_; Fq.out = F.out + z_; } const Frame& F = Fq;
                SchedE2 S; S.T.init(NE * ETILES, 4, F.G, F.bid); S.A = (const char*)(F.ws + R_HE); S.B = (const char*)F.out + OUT_W2; S.e0 = 0;
                EpiScale E; E.YE = (bf16_t*)(F.ws + R_YE); E.SG = (const float*)(F.ws + WS_SGATE);
                pg8::gemm_phase<EpiScale, SchedE2, false, true>(glds, DFF / 2, DFF / 2, DFF / 2, S, E); }
            SEAM(pb + 15 + 2 * rnd);
        }
        if (PHON(19) && IN(pb + 16)) phase_combine(F, li);
        SEAM(pb + 16);
    }
}

#ifndef MK_SINGLE
#define MK_SINGLE 1
#endif
extern "C" void kernel_launch(void* const* d_in, const int* in_sizes, int n_in, void* d_out, int out_size, void* d_ws, size_t ws_size, hipStream_t stream) {
    static int grid = 0;
    if (grid == 0) {
        if (n_in != 37 || in_sizes[0] != NSEQ0 * SEQ * D || out_size != NSEQ * SEQ * D || ws_size < WS_END) {
            fprintf(stderr, "kernel_launch: unexpected shapes: n_in %d in0 %d out %d ws %zu (need %zu); nothing launched\n", n_in, n_in > 0 ? in_sizes[0] : -1, out_size, ws_size, (size_t)WS_END); grid = -1; return; }
        int dev = 0, cus = 0, per_cu = 0;
        if (hipGetDevice(&dev) != hipSuccess || hipDeviceGetAttribute(&cus, hipDeviceAttributeMultiprocessorCount, dev) != hipSuccess) { grid = -1; return; }
        if (hipFuncSetAttribute((const void*)mega, hipFuncAttributeMaxDynamicSharedMemorySize, LDS_BYTES) != hipSuccess) { fprintf(stderr, "kernel_launch: hipFuncSetAttribute failed\n"); grid = -1; return; }
        if (hipOccupancyMaxActiveBlocksPerMultiprocessor(&per_cu, (const void*)mega, NTHREADS, LDS_BYTES) != hipSuccess || per_cu < 1) fprintf(stderr, "kernel_launch: occupancy query reports %d\n", per_cu);
        (void)hipGetLastError();
        grid = cus;
    }
    if (grid < 0) return;
    if (hipMemsetAsync((char*)d_ws + WS_CTL, 0, CTL_BYTES, stream) != hipSuccess) return;
    Args a{};
    for (int i = 0; i < 37; ++i) a.in[i] = (const float*)d_in[i];
    a.out = (float*)d_out; a.ws = (unsigned char*)d_ws;
#if MK_SINGLE
    a.ph_lo = 0; a.ph_hi = NPHASE;
    hipLaunchKernelGGL(mega, dim3(grid), dim3(NTHREADS), LDS_BYTES, stream, a);
#else
    for (int p = 0; p < NPHASE; ++p) { a.ph_lo = p; a.ph_hi = p + 1; hipLaunchKernelGGL(mega, dim3(grid), dim3(NTHREADS), LDS_BYTES, stream, a); }
#endif
}
```

```cpp
#include <hip/hip_runtime.h>
#include <cstdio>
#include <cstdint>
#include <cstddef>

#define LAS __attribute__((address_space(3)))
typedef unsigned short bf16_t;
typedef short bf16x8 __attribute__((ext_vector_type(8)));
typedef float f32x4 __attribute__((ext_vector_type(4)));
typedef float f32x2 __attribute__((ext_vector_type(2)));
typedef unsigned u32x4 __attribute__((ext_vector_type(4)));
typedef unsigned u32x2 __attribute__((ext_vector_type(2)));

constexpr int D = 1024, LSEQ = 2064, NSEQ = 48, NTOK = NSEQ * LSEQ, NMETA = 16, SEQ = 2048, NSEQ0 = 32, TOK0 = NSEQ0 * LSEQ;
constexpr int N_IN = 11136, NLAYER = 2;
constexpr int N1 = 2560, N2 = 3072, NG = 1536, NM = 4096;
constexpr int NE = 16, DFF = 2048, CAP0 = 8256, CAP1 = 4128, EVALID = CAP0 + CAP1, EROWS = 12544, ETILES = EROWS / 256;
constexpr int NTILE_M = NTOK / 256;
static_assert(NTOK % 256 == 0, "token tiling");
constexpr float ALPHA = 1.41421356237f;
constexpr int NTHREADS = 512, NWAVES = 8;
constexpr int LDS_BYTES = 147456;
constexpr int LDS_MISC = LDS_BYTES - 64;

constexpr int U1_AX = 0, U1_R = 512, U1_K = 1024, U1_V = 1536, U1_WDN = 2048, U1_ADN = 2176, U1_GDN = 2304;
constexpr int U2_CQ = 0, U2_CF = 512, U2_CI = 1536, U2_DQ = 2048, U2_DK = 2304, U2_DV = 2560;

constexpr size_t al256(size_t x) { return (x + 255) & ~(size_t)255; }
constexpr size_t WS_CTL = 0, CTL_BYTES = 65536;
constexpr size_t WS_AFF = WS_CTL + CTL_BYTES;
constexpr size_t WS_INV = WS_AFF + al256((size_t)NTOK * 16 * 4);
constexpr size_t WS_STOK = WS_INV + al256((size_t)NTOK * 16 * 4);
constexpr size_t WS_SGATE = WS_STOK + al256((size_t)NE * EROWS * 4);
constexpr size_t WS_HIST = WS_SGATE + al256((size_t)NE * EROWS * 4);
constexpr size_t WS_BON = WS_HIST + al256((size_t)3 * 32 * 1024 * 4);
constexpr size_t WS_G2T = WS_BON + al256((size_t)NTOK * 16 * 4);
constexpr size_t WS_LB = WS_G2T + al256((size_t)2 * 512 * 128 * 2);
constexpr size_t WS_RW2T = WS_LB + al256((size_t)2 * 512 * 4);
constexpr size_t WS_LRUT = WS_RW2T + al256((size_t)2 * 2 * 2 * 512 * 64 * 2);
constexpr size_t WS_HBUF = WS_LRUT + al256((size_t)2 * 2 * 2 * 8 * 64 * 64 * 2);
constexpr size_t WS_W1T = WS_HBUF + al256((size_t)NTOK * D * 2);
constexpr size_t WS_W2T = WS_W1T + al256((size_t)2 * N1 * D * 2);
constexpr size_t WS_WGT = WS_W2T + al256((size_t)2 * N2 * D * 2);
constexpr size_t WS_WMT = WS_WGT + al256((size_t)2 * NG * D * 2);
constexpr size_t WS_WBT = WS_WMT + al256((size_t)2 * NM * D * 2);
constexpr size_t WS_WOT = WS_WBT + al256((size_t)2 * 4 * D * 512 * 2);
constexpr size_t WS_R = WS_WOT + al256((size_t)2 * D * D * 2);
constexpr size_t SZ_TD2 = (size_t)NTOK * D * 2;
constexpr size_t R_BR = WS_R;
constexpr size_t R_U = WS_R + 2 * SZ_TD2;
constexpr size_t R_PB = R_U;
constexpr size_t R_MERGED = WS_R;
constexpr size_t R_H8 = WS_R;
constexpr size_t OUT_HIN8 = SZ_TD2;
constexpr size_t OUT_W13 = OUT_HIN8 + (size_t)NTOK * D;
constexpr size_t OUT_W2 = (size_t)NE * 4096 * D;
static_assert(OUT_W13 + (size_t)NE * 4096 * D <= (size_t)NSEQ * SEQ * D * 4, "W13t must fit in d_out");
constexpr float WM_SCALE = 32.0f;
constexpr float W13_SCALE = 32.0f, W2_SCALE = 64.0f;
constexpr size_t R_X1 = R_U;
constexpr size_t R_WEXP = WS_R;
constexpr size_t SZ_W13 = (size_t)NE * 4096 * D * 2, SZ_W2E = (size_t)NE * D * DFF * 2;
constexpr size_t R_YE = R_WEXP + SZ_W13 + SZ_W2E;
constexpr size_t SZ_YE = (size_t)NE * EROWS * D * 2;
constexpr size_t R_HE = R_YE + SZ_YE;
constexpr size_t SZ_HE = (size_t)8 * EROWS * DFF * 2;
constexpr size_t WS_END_A = R_U + (size_t)NTOK * N2 * 2;
constexpr size_t WS_END_B = R_HE + SZ_HE;
constexpr size_t WS_END = WS_END_A > WS_END_B ? WS_END_A : WS_END_B;

constexpr int CW_BAR = 0;
constexpr int CW_CNT = 4096;
constexpr int CW_TIE = 4160;

__device__ __forceinline__ float bf2f(bf16_t v) { return __uint_as_float(((unsigned)v) << 16); }
typedef __bf16 bf16n2 __attribute__((ext_vector_type(2)));
__device__ __forceinline__ unsigned pk2(float lo, float hi) { const f32x2 v = {lo, hi}; return __builtin_bit_cast(unsigned, __builtin_convertvector(v, bf16n2)); }
__device__ __forceinline__ bf16_t f2bf(float f) { return (bf16_t)(pk2(f, 0.f) & 0xffffu); }
__device__ __forceinline__ unsigned pk4_fp8(float a, float b, float c, float d) { int p = __builtin_amdgcn_cvt_pk_fp8_f32(a, b, 0, false); p = __builtin_amdgcn_cvt_pk_fp8_f32(c, d, p, true); return (unsigned)p; }
__device__ __forceinline__ float sigmoidf_(float x) { return __builtin_amdgcn_rcpf(1.0f + __expf(-x)); }
__device__ __forceinline__ float siluf_(float x) { return x * __builtin_amdgcn_rcpf(1.0f + __expf(-x)); }
__device__ __forceinline__ float gelu_tanh_(float x) { const float u = 1.5957691216f * (x + 0.044715f * x * x * x); return x * __builtin_amdgcn_rcpf(1.0f + __expf(-u)); }
__device__ __forceinline__ float softplusf_(float x) { return fmaxf(x, 0.f) + log1pf(__expf(-fabsf(x))); }
__device__ __forceinline__ float dppx(float v, int sel) {
    const int x = __float_as_int(v); int r;
    if (sel == 0) r = __builtin_amdgcn_update_dpp(0, x, 0xB1, 0xF, 0xF, true);
    else if (sel == 1) r = __builtin_amdgcn_update_dpp(0, x, 0x4E, 0xF, 0xF, true);
    else if (sel == 2) r = __builtin_amdgcn_update_dpp(0, x, 0x141, 0xF, 0xF, true);
    else r = __builtin_amdgcn_update_dpp(0, x, 0x140, 0xF, 0xF, true);
    return __int_as_float(r);
}
typedef unsigned u32x2_pl __attribute__((ext_vector_type(2)));
__device__ __forceinline__ float rows_sum(float v) {
    const unsigned x = __float_as_uint(v);
    const u32x2_pl a = __builtin_amdgcn_permlane16_swap(x, x, false, false);
    const float s = __uint_as_float(a[0]) + __uint_as_float(a[1]);
    const unsigned y = __float_as_uint(s);
    const u32x2_pl b = __builtin_amdgcn_permlane32_swap(y, y, false, false);
    return __uint_as_float(b[0]) + __uint_as_float(b[1]);
}
__device__ __forceinline__ float wave_sum(float v) {
    v += dppx(v, 0); v += dppx(v, 1); v += dppx(v, 2); v += dppx(v, 3);
    return rows_sum(v);
}

#define XB_TMO      128
#define XB_XCNT(j)  (256  + 64 * (j))
#define XB_XSUB(j)  (1280 + 64 * (j))
#define XB_XGEN(j)  (2304 + 64 * (j))
#define XB_TOP      3328
#define XB_TOPGEN   3392
#define XCD_BAR_WORDS 3456
#define XB_SPIN_CAP (1u << 23)
__device__ __forceinline__ unsigned xb_ld(unsigned* p)              { return __hip_atomic_load(p, __ATOMIC_RELAXED, __HIP_MEMORY_SCOPE_AGENT); }
__device__ __forceinline__ unsigned xb_add(unsigned* p, unsigned v) { return __hip_atomic_fetch_add(p, v, __ATOMIC_RELAXED, __HIP_MEMORY_SCOPE_AGENT); }
__device__ __forceinline__ unsigned xb_xcc_id() { return (unsigned)__builtin_amdgcn_s_getreg((3 << 11) | 20) & 0xFu; }
#define XB_SPIN(cond, bar) do { unsigned _sp = 0; while (cond) { __builtin_amdgcn_s_sleep(1); \
    if ((++_sp & 255u) == 0u) { if (xb_ld(&(bar)[XB_TMO])) break; if (_sp > XB_SPIN_CAP) { atomicAdd(&(bar)[XB_TMO], 1u); break; } } } } while (0)
struct XcdBarrier { unsigned* bar; unsigned x; volatile LAS unsigned* st; };
__device__ __forceinline__ XcdBarrier xcd_barrier_post(unsigned* bar, volatile LAS unsigned* st) {
    XcdBarrier b; b.bar = bar; b.x = xb_xcc_id(); b.st = st;
    if (threadIdx.x == 0) st[2] = xb_add(&bar[XB_XCNT(b.x)], 1u);
    return b;
}
__device__ __forceinline__ void xcd_barrier_complete(unsigned* bar, unsigned x, unsigned& nloc, unsigned& nx) {
    const unsigned G = gridDim.x * gridDim.y * gridDim.z;
    unsigned sum, cnt, mine, sp = 0u;
    for (;;) {
        sum = 0u; cnt = 0u; mine = 0u;
#pragma unroll
        for (unsigned j = 0; j < 16; ++j) { const unsigned c = xb_ld(&bar[XB_XCNT(j)]); sum += c; cnt += (c > 0u) ? 1u : 0u; mine = (j == x) ? c : mine; }
        if (sum == G) break;
        __builtin_amdgcn_s_sleep(1);
        if ((++sp & 255u) == 0u) { if (xb_ld(&bar[XB_TMO])) break; if (sp > XB_SPIN_CAP) { atomicAdd(&bar[XB_TMO], 1u); break; } }
    }
    nloc = mine > 0u ? mine : 1u; nx = cnt > 0u ? cnt : 1u;
}
__device__ __forceinline__ void xcd_barrier(const XcdBarrier& b) {
    asm volatile("s_waitcnt vmcnt(0)" ::: "memory");
    __syncthreads();
    if (threadIdx.x == 0) {
        unsigned* bar = b.bar;
        __builtin_amdgcn_s_waitcnt(0);
        unsigned nloc = b.st[0], nx = b.st[1];
        if (nloc == 0u) { xcd_barrier_complete(bar, b.x, nloc, nx); b.st[0] = nloc; b.st[1] = nx; }
        const unsigned old = xb_add(&bar[XB_XSUB(b.x)], 1u);
        const unsigned gen = old / nloc;
        if (old + 1u == (gen + 1u) * nloc) {
            __builtin_amdgcn_fence(__ATOMIC_RELEASE, "agent");
            asm volatile("s_waitcnt vmcnt(0)" ::: "memory");
            const unsigned og = xb_add(&bar[XB_TOP], 1u);
            const unsigned tg = og / nx;
            if (og + 1u == (tg + 1u) * nx) xb_add(&bar[XB_TOPGEN], 1u);
            else XB_SPIN(xb_ld(&bar[XB_TOPGEN]) == tg, bar);
            __builtin_amdgcn_fence(__ATOMIC_ACQUIRE, "agent");
            xb_add(&bar[XB_XGEN(b.x)], 1u);
            asm volatile("s_waitcnt vmcnt(0)" ::: "memory");
        } else {
            XB_SPIN(xb_ld(&bar[XB_XGEN(b.x)]) == gen, bar);
            __builtin_amdgcn_fence(__ATOMIC_ACQUIRE, "agent");
            asm volatile("s_waitcnt vmcnt(0)" ::: "memory");
        }
    }
    __syncthreads();
}

namespace pg8 {
constexpr int BM = 256, BK = 64, HALF = 128, HTB = HALF * BK * 2, STAGE_BYTES = 8 * HTB, NXCD = 8, WGM = 8;
__host__ __device__ __forceinline__ int lds_byte(int r, int c) { const int st = (r >> 4) * 2 + (c >> 5), rr = r & 15, cc = c & 31, ob = rr * 64 + cc * 2; return st * 1024 + (ob ^ (((ob >> 9) & 1) << 5)); }
__host__ __device__ __forceinline__ void stage_rc(int b, int& R, int& C) { const int st = b / 1024, sb = b % 1024, swz = sb ^ (((sb >> 9) & 1) << 5); R = (st >> 1) * 16 + swz / 64; C = (st & 1) * 32 + (swz % 64) / 2; }
__host__ __device__ __forceinline__ int perm32(int rho) { const int n = rho >> 4, i = rho & 15; return 8 * (i >> 2) + 4 * n + (i & 3); }

struct Unit { int pm, pn, aux; const char* A; const char* B; const int* rows; };

struct TileOrder {
    int nM, nN, nwg, G, c;
    __device__ __forceinline__ void init(int nM_, int nN_, int G_, int c_) { nM = nM_; nN = nN_; nwg = nM * nN; G = G_; c = c_; }
    __device__ __forceinline__ bool tile(int i, int& pm, int& pn) const {
        const long L = (long)i * G + c; if (L >= nwg) return false;
        int wgid = (int)L; { const int q = nwg / NXCD, r = nwg % NXCD, xcd = wgid % NXCD, off = wgid / NXCD; wgid = (xcd < r ? xcd * (q + 1) : r * (q + 1) + (xcd - r) * q) + off; }
        const int nig = WGM * nN, gid = wgid / nig, fm = gid * WGM, gsz = (nM - fm) < WGM ? (nM - fm) : WGM;
        pm = fm + ((wgid % nig) % gsz); pn = (wgid % nig) / gsz; return true;
    }
};

typedef int i32x4_ __attribute__((ext_vector_type(4)));
typedef int i32x8_ __attribute__((ext_vector_type(8)));
__device__ __forceinline__ i32x8_ cat8(bf16x8 a, bf16x8 b) { const i32x4_ x = __builtin_bit_cast(i32x4_, a), y = __builtin_bit_cast(i32x4_, b); return __builtin_shufflevector(x, y, 0, 1, 2, 3, 4, 5, 6, 7); }
template <class Epi, class Sched, bool GATHER, bool F8 = false>
__device__ __forceinline__ void gemm_phase(LAS unsigned char* lds, const int K, const int lda, const int ldb, const Sched& S, const Epi& E) {
    int tid = threadIdx.x; asm volatile("" : "+v"(tid));
    const int wid = __builtin_amdgcn_readfirstlane(tid >> 6), lane = tid & 63, wr = wid >> 2, wc = wid & 3, fr = lane & 15, fq = lane >> 4;
    const int nt = K / BK;
    unsigned voffA[2][2], nvA[2][2], voffB[2];
#pragma unroll
    for (int i = 0; i < 2; ++i) { int R, C; stage_rc(tid * 16 + i * 8192, R, C); const int Rb = Epi::PERM ? ((R & ~31) + perm32(R & 31)) : R;
        voffB[i] = (unsigned)(Rb * ldb + C) * 2u;
#pragma unroll
        for (int h = 0; h < 2; ++h) { voffA[h][i] = (unsigned)((R + h * HALF) * lda + C) * 2u; nvA[h][i] = voffA[h][i]; } }
    const size_t kstep = (size_t)(BK * 2);
    const size_t hstepB = (size_t)HALF * ldb * 2;
    const unsigned ldsw = (unsigned)wid * 1024u;
    const int aoff = lds_byte(wr * 64 + fr, fq * 8), boff = lds_byte(wc * 32 + fr, fq * 8);
#define PG8_SA(b, h) (((b) * 2 + (h)) * HTB)
#define PG8_SB(b, h) ((4 + (b) * 2 + (h)) * HTB)
#define PG8_STAGE(bufoff, gbase, voff) do { _Pragma("unroll") for (int _i = 0; _i < 2; ++_i) \
        __builtin_amdgcn_global_load_lds((const unsigned*)((const char*)(gbase) + (voff)[_i]), (LAS unsigned*)(lds + (bufoff) + ldsw + _i * 8192), 16, 0, 0); } while (0)
#define PG8_LDA(dst, b, h) do { _Pragma("unroll") for (int m = 0; m < 4; ++m) { if constexpr (F8) { const i32x4_ lo_ = *(const LAS i32x4_*)(lds + PG8_SA(b, h) + aoff + m * 2048), hi_ = *(const LAS i32x4_*)(lds + PG8_SA(b, h) + aoff + m * 2048 + 1024); \
            dst##8[m] = __builtin_shufflevector(lo_, hi_, 0, 1, 2, 3, 4, 5, 6, 7); } else { _Pragma("unroll") for (int k = 0; k < 2; ++k) dst[m][k] = *(const LAS bf16x8*)(lds + PG8_SA(b, h) + aoff + m * 2048 + k * 1024); } } } while (0)
#define PG8_LDB(dst, b, h) do { _Pragma("unroll") for (int n = 0; n < 2; ++n) { if constexpr (F8) { const i32x4_ lo_ = *(const LAS i32x4_*)(lds + PG8_SB(b, h) + boff + n * 2048), hi_ = *(const LAS i32x4_*)(lds + PG8_SB(b, h) + boff + n * 2048 + 1024); \
            dst##8[n] = __builtin_shufflevector(lo_, hi_, 0, 1, 2, 3, 4, 5, 6, 7); } else { _Pragma("unroll") for (int k = 0; k < 2; ++k) dst[n][k] = *(const LAS bf16x8*)(lds + PG8_SB(b, h) + boff + n * 2048 + k * 1024); } } } while (0)
#define PG8_MMA(ai, bj, At, Bt) do { __builtin_amdgcn_s_setprio(1); _Pragma("unroll") for (int m = 0; m < 4; ++m) _Pragma("unroll") for (int n = 0; n < 2; ++n) { \
        if constexpr (F8) asm volatile("v_mfma_scale_f32_16x16x128_f8f6f4 %0, %1, %2, %0, %3, %3 op_sel_hi:[0,0,0]" : "+v"(acc[ai][bj][m][n]) : "v"(Bt##8[n]), "v"(At##8[m]), "v"(f8scale));   \
        else { _Pragma("unroll") for (int k = 0; k < 2; ++k) acc[ai][bj][m][n] = __builtin_amdgcn_mfma_f32_16x16x32_bf16(Bt[n][k], At[m][k], acc[ai][bj][m][n], 0, 0, 0); } } \
        __builtin_amdgcn_s_setprio(0); } while (0)
#define PG8_WAIT_V(n) asm volatile("s_waitcnt vmcnt(" #n ")" ::: "memory")
#define PG8_WAIT_L(n) asm volatile("s_waitcnt lgkmcnt(" #n ")" ::: "memory")
#define PG8_BAR __builtin_amdgcn_s_barrier()
#define PG8_SCHED __builtin_amdgcn_sched_barrier(0)
#define PG8_GATHER(dst, u) do { if constexpr (GATHER) { _Pragma("unroll") for (int _i = 0; _i < 2; ++_i) { int _R, _C; stage_rc(tid * 16 + _i * 8192, _R, _C); _Pragma("unroll") for (int _h = 0; _h < 2; ++_h) \
        dst[_h][_i] = ((unsigned)(u).rows[_R + _h * HALF] * (unsigned)lda + (unsigned)_C) * 2u; } } } while (0)
#define PG8_GATHER_LD(dst, u) do { _Pragma("unroll") for (int _i = 0; _i < 2; ++_i) { int _R, _C; stage_rc(tid * 16 + _i * 8192, _R, _C); _Pragma("unroll") for (int _h = 0; _h < 2; ++_h) dst[_h][_i] = (unsigned)(u).rows[_R + _h * HALF]; } } while (0)
#define PG8_GATHER_CV(dst, srcv) do { _Pragma("unroll") for (int _i = 0; _i < 2; ++_i) { int _R, _C; stage_rc(tid * 16 + _i * 8192, _R, _C); _Pragma("unroll") for (int _h = 0; _h < 2; ++_h) dst[_h][_i] = (srcv[_h][_i] * (unsigned)lda + (unsigned)_C) * 2u; } } while (0)
    Unit cur, nxt; int ui = 0;
    if (!S.next(0, cur)) return;
    f32x4 acc[2][2][4][2];
#pragma unroll
    for (int a = 0; a < 2; ++a)
#pragma unroll
        for (int b = 0; b < 2; ++b)
#pragma unroll
            for (int m = 0; m < 4; ++m)
#pragma unroll
                for (int n = 0; n < 2; ++n) acc[a][b][m][n] = (f32x4){0.f, 0.f, 0.f, 0.f};
    bf16x8 At[4][2], B0[2][2], B1[2][2];
    const int f8scale = 0x7f7f7f7f;
    i32x8_ At8[4], B08[2], B18[2];
    const char* cA = cur.A; const char* cB = cur.B;
    PG8_GATHER(voffA, cur);
    unsigned raw1[2][2];
    if constexpr (GATHER) { Unit n1; if (S.next(1, n1)) { PG8_GATHER_LD(raw1, n1); } }
    PG8_STAGE(PG8_SB(0, 0), cB, voffB); PG8_STAGE(PG8_SA(0, 0), cA, voffA[0]); PG8_STAGE(PG8_SB(0, 1), cB + hstepB, voffB); PG8_STAGE(PG8_SA(0, 1), cA, voffA[1]);
    if (wr == 1) PG8_BAR;
    PG8_WAIT_V(4); PG8_BAR;
    PG8_STAGE(PG8_SB(1, 0), cB + kstep, voffB); PG8_STAGE(PG8_SA(1, 0), cA + kstep, voffA[0]); PG8_STAGE(PG8_SB(1, 1), cB + hstepB + kstep, voffB);
    PG8_WAIT_V(6); PG8_BAR;
    for (;;) {
        const bool has_next = S.next(ui + 1, nxt);
        const char* nA = has_next ? nxt.A : cA; const char* nB = has_next ? nxt.B : cB;
        if constexpr (GATHER) {
            if (has_next) { PG8_GATHER_CV(nvA, raw1); } else {
#pragma unroll
            for (int h = 0; h < 2; ++h)
#pragma unroll
                for (int i = 0; i < 2; ++i) nvA[h][i] = voffA[h][i]; }
            { Unit n2; if (S.next(ui + 2, n2)) { PG8_GATHER_LD(raw1, n2); } } }
        for (int t = 0; t < nt; t += 2) {
            const bool last = (t == nt - 2);
            const char* a1 = cA + (size_t)(t + 1) * kstep;
            const char* a2 = last ? nA : cA + (size_t)(t + 2) * kstep; const char* b2 = last ? nB : cB + (size_t)(t + 2) * kstep;
            const char* a3 = a2 + kstep; const char* b3 = b2 + kstep;
            unsigned vA0[2], vA1[2];
            if constexpr (GATHER) { vA0[0] = last ? nvA[0][0] : voffA[0][0]; vA0[1] = last ? nvA[0][1] : voffA[0][1]; vA1[0] = last ? nvA[1][0] : voffA[1][0]; vA1[1] = last ? nvA[1][1] : voffA[1][1]; }
            else { vA0[0] = voffA[0][0]; vA0[1] = voffA[0][1]; vA1[0] = voffA[1][0]; vA1[1] = voffA[1][1]; }
            PG8_LDB(B0, 0, 0); PG8_SCHED; PG8_LDA(At, 0, 0); PG8_STAGE(PG8_SA(1, 1), a1, voffA[1]);
            PG8_WAIT_L(8); PG8_BAR; PG8_WAIT_L(0); PG8_MMA(0, 0, At, B0); PG8_BAR; PG8_SCHED;
            PG8_LDB(B1, 0, 1); PG8_STAGE(PG8_SB(0, 0), b2, voffB);
            PG8_BAR; PG8_WAIT_L(0); PG8_MMA(0, 1, At, B1); PG8_BAR;
            PG8_LDA(At, 0, 1); PG8_STAGE(PG8_SA(0, 0), a2, vA0);
            PG8_BAR; PG8_WAIT_L(0); PG8_MMA(1, 0, At, B0); PG8_BAR; PG8_SCHED;
            PG8_STAGE(PG8_SB(0, 1), b2 + hstepB, voffB);
            PG8_WAIT_V(6); PG8_BAR; PG8_MMA(1, 1, At, B1); PG8_BAR;
            PG8_LDB(B0, 1, 0); PG8_SCHED; PG8_LDA(At, 1, 0); PG8_STAGE(PG8_SA(0, 1), a2, vA1);
            PG8_WAIT_L(8); PG8_BAR; PG8_WAIT_L(0); PG8_MMA(0, 0, At, B0); PG8_BAR; PG8_SCHED;
            PG8_LDB(B1, 1, 1); PG8_STAGE(PG8_SB(1, 0), b3, voffB);
            PG8_BAR; PG8_WAIT_L(0); PG8_MMA(0, 1, At, B1); PG8_BAR;
            PG8_LDA(At, 1, 1); PG8_STAGE(PG8_SA(1, 0), a3, vA0);
            PG8_BAR; PG8_WAIT_L(0); PG8_MMA(1, 0, At, B0); PG8_BAR; PG8_SCHED;
            PG8_STAGE(PG8_SB(1, 1), b3 + hstepB, voffB);
            PG8_WAIT_V(6); PG8_BAR; PG8_MMA(1, 1, At, B1); PG8_BAR;
        }
        if constexpr (F8) asm volatile("s_nop 15\n\ts_nop 7" ::: "memory");
        { int tl_e = (int)threadIdx.x; asm volatile("" : "+v"(tl_e));
          const int fr_e = tl_e & 15, fq_e = (tl_e >> 4) & 3;
          E(acc, cur, wr, wc, fr_e, fq_e); }
        if (!has_next) break;
#pragma unroll
        for (int a = 0; a < 2; ++a)
#pragma unroll
            for (int b = 0; b < 2; ++b)
#pragma unroll
                for (int m = 0; m < 4; ++m)
#pragma unroll
                    for (int n = 0; n < 2; ++n) acc[a][b][m][n] = (f32x4){0.f, 0.f, 0.f, 0.f};
        cur = nxt; cA = nA; cB = nB; ++ui;
        if constexpr (GATHER) {
#pragma unroll
            for (int h = 0; h < 2; ++h)
#pragma unroll
                for (int i = 0; i < 2; ++i) voffA[h][i] = nvA[h][i]; }
    }
    PG8_WAIT_V(0);
    if (wr == 0) PG8_BAR;
    PG8_BAR;
#undef PG8_SA
#undef PG8_SB
#undef PG8_STAGE
#undef PG8_LDA
#undef PG8_LDB
#undef PG8_MMA
#undef PG8_WAIT_V
#undef PG8_WAIT_L
#undef PG8_BAR
#undef PG8_SCHED
#undef PG8_GATHER
#undef PG8_GATHER_LD
#undef PG8_GATHER_CV
}
}
using pg8::Unit;

struct Args { const float* in[37]; float* out; unsigned char* ws; int ph_lo, ph_hi; };
enum { I_XP = 0, I_XS, I_META, I_LNEG, I_LNEB, I_HLB, I_WIN, I_CONVW, I_CONVB, I_WR, I_BR, I_WI, I_BI, I_LAM, I_MU, I_W0, I_W2, I_A0, I_A2, I_G2, I_KK, I_KA, I_RK,
       I_LNXG, I_LNXB, I_HNG, I_RDEC, I_WBR, I_WOUT, I_LN1G, I_LN1B, I_ROUTER, I_EW1, I_EW3, I_EW2, I_LN2G, I_LN2B };
struct Frame {
    const float* const* in; float* out; unsigned char* ws; LAS unsigned char* lds; unsigned char* ldsg;
    int tid, lane, wave, G, bid;
    __device__ __forceinline__ bf16_t* hbuf() const { return (bf16_t*)(ws + WS_HBUF); }
    __device__ __forceinline__ bf16_t* br() const { return (bf16_t*)(ws + R_BR); }
    __device__ __forceinline__ bf16_t* brx() const { return (bf16_t*)out; }
    __device__ __forceinline__ bf16_t* ubuf() const { return (bf16_t*)(ws + R_U); }
    __device__ __forceinline__ bf16_t* pb(int n) const { return n < 3 ? (bf16_t*)(ws + R_PB + (size_t)n * SZ_TD2) : (bf16_t*)out; }
};

struct SchedPlain {
    pg8::TileOrder T; const char* A; const char* B; size_t astep, bstep;
    __device__ __forceinline__ bool next(int i, Unit& u) const { int pm, pn; if (!T.tile(i, pm, pn)) return false; u.pm = pm; u.pn = pn; u.aux = 0; u.A = A + (size_t)pm * astep; u.B = B + (size_t)pn * bstep; u.rows = nullptr; return true; }
};
struct SchedP {
    pg8::TileOrder T; const char* A; const char* B;
    __device__ __forceinline__ bool next(int i, Unit& u) const { int pm, pn; if (!T.tile(i, pm, pn)) return false; const int nb = pn >> 2, pl = pn & 3; u.pm = pm; u.pn = pl; u.aux = nb;
        u.A = A + (size_t)pm * 256 * 2048 * 2 + (size_t)nb * 512 * 2; u.B = B + (size_t)nb * 1024 * 512 * 2 + (size_t)pl * 256 * 512 * 2; u.rows = nullptr; return true; }
};
struct SchedE1 {
    pg8::TileOrder T; const char* A; const char* B; const int* stok; int e0;
    __device__ __forceinline__ bool next(int i, Unit& u) const { int pm, pn; if (!T.tile(i, pm, pn)) return false; const int el = pm / ETILES, pl = pm - el * ETILES, e = e0 + el; u.pm = pl; u.pn = pn; u.aux = el;
        u.A = A; u.B = B + (size_t)e * 4096 * D + (size_t)pn * 256 * D; u.rows = stok + (size_t)e * EROWS + pl * 256; return true; }
};
struct SchedE2 {
    pg8::TileOrder T; const char* A; const char* B; int e0;
    __device__ __forceinline__ bool next(int i, Unit& u) const { int pm, pn; if (!T.tile(i, pm, pn)) return false; const int el = pm / ETILES, pl = pm - el * ETILES, e = e0 + el; u.pm = pl; u.pn = pn; u.aux = e;
        u.A = A + ((size_t)el * EROWS + (size_t)pl * 256) * DFF; u.B = B + (size_t)e * D * DFF + (size_t)pn * 256 * DFF; u.rows = nullptr; return true; }
};

#define EPI_LOOP_AM _Pragma("unroll") for (int ai = 0; ai < 2; ++ai) _Pragma("unroll") for (int m = 0; m < 4; ++m)
struct EpiStoreBf16 {
    static constexpr bool PERM = true;
    bf16_t* O0; bf16_t* O1; bf16_t* O2; bf16_t* O3; int ldo;
    __device__ __forceinline__ void operator()(const f32x4 (&acc)[2][2][4][2], const Unit& u, int wr, int wc, int fr, int fq) const {
        bf16_t* base = (u.aux == 0) ? O0 : ((u.aux == 1) ? O1 : ((u.aux == 2) ? O2 : O3));
        const int row0 = u.pm * 256 + wr * 64 + fr, col0 = u.pn * 256 + wc * 32 + 8 * fq;
        EPI_LOOP_AM { bf16_t* rowp = base + (size_t)(row0 + ai * 128 + m * 16) * ldo + col0;
#pragma unroll
            for (int bj = 0; bj < 2; ++bj) { const f32x4 v0 = acc[ai][bj][m][0], v1 = acc[ai][bj][m][1];
                u32x4 w; w.x = pk2(v0[0], v0[1]); w.y = pk2(v0[2], v0[3]); w.z = pk2(v1[0], v1[1]); w.w = pk2(v1[2], v1[3]);
                *(u32x4*)(rowp + bj * 128) = w; } }
    }
};
struct EpiGate {
    static constexpr bool PERM = true;
    bf16_t* BR;
    __device__ __forceinline__ void operator()(const f32x4 (&acc)[2][2][4][2], const Unit& u, int wr, int wc, int fr, int fq) const {
        const int sec = u.pn >> 1;
        const int cbase = (sec == 0 ? 0 : (sec == 1 ? 1024 : 1536)) + (u.pn & 1) * 256 + wc * 32 + 8 * fq;
        const int row0 = u.pm * 256 + wr * 64 + fr;
        u32x4 xv[2][4][2];
        EPI_LOOP_AM { const bf16_t* rowp = BR + (size_t)(row0 + ai * 128 + m * 16) * 2048 + cbase; xv[ai][m][0] = *(const u32x4*)rowp; xv[ai][m][1] = *(const u32x4*)(rowp + 128); }
        EPI_LOOP_AM { bf16_t* rowp = BR + (size_t)(row0 + ai * 128 + m * 16) * 2048 + cbase;
#pragma unroll
            for (int bj = 0; bj < 2; ++bj) {
                const u32x4 x = xv[ai][m][bj];
                float g[8];
#pragma unroll
                for (int j = 0; j < 4; ++j) { g[j] = acc[ai][bj][m][0][j]; g[4 + j] = acc[ai][bj][m][1][j]; }
#pragma unroll
                for (int j = 0; j < 8; ++j) g[j] = (sec == 0) ? gelu_tanh_(g[j]) : siluf_(g[j]);
                const unsigned xs[4] = {x.x, x.y, x.z, x.w}; unsigned ws_[4];
#pragma unroll
                for (int j = 0; j < 4; ++j) ws_[j] = pk2(bf2f((bf16_t)(xs[j] & 0xffffu)) * g[2 * j], bf2f((bf16_t)(xs[j] >> 16)) * g[2 * j + 1]);
                u32x4 w; w.x = ws_[0]; w.y = ws_[1]; w.z = ws_[2]; w.w = ws_[3];
                *(u32x4*)(rowp + bj * 128) = w; } }
    }
};
struct EpiMerge {
    static constexpr bool PERM = false;
    const bf16_t* PB0; const bf16_t* PB1; const bf16_t* PB2; const bf16_t* PB3; bf16_t* MG;
    __device__ __forceinline__ void operator()(const f32x4 (&acc)[2][2][4][2], const Unit& u, int wr, int wc, int fr, int fq) const {
        const int row0 = u.pm * 256 + wr * 64 + fr, d0 = u.pn * 64 + wc * 16 + 4 * fq;
        u32x2 pbv[2][4][4];
        EPI_LOOP_AM { const size_t off = (size_t)(row0 + ai * 128 + m * 16) * D + d0;
            pbv[ai][m][0] = *(const u32x2*)(PB0 + off); pbv[ai][m][1] = *(const u32x2*)(PB1 + off); pbv[ai][m][2] = *(const u32x2*)(PB2 + off); pbv[ai][m][3] = *(const u32x2*)(PB3 + off); }
        EPI_LOOP_AM { const size_t off = (size_t)(row0 + ai * 128 + m * 16) * D + d0;
            float s[4] = {0.f, 0.f, 0.f, 0.f};
#pragma unroll
            for (int bj = 0; bj < 2; ++bj)
#pragma unroll
                for (int n = 0; n < 2; ++n) { const u32x2 p = pbv[ai][m][2 * bj + n]; const f32x4 a = acc[ai][bj][m][n];
                    constexpr float IS = 1.0f / WM_SCALE;
                    s[0] += sigmoidf_(a[0] * IS) * bf2f((bf16_t)(p.x & 0xffffu)); s[1] += sigmoidf_(a[1] * IS) * bf2f((bf16_t)(p.x >> 16));
                    s[2] += sigmoidf_(a[2] * IS) * bf2f((bf16_t)(p.y & 0xffffu)); s[3] += sigmoidf_(a[3] * IS) * bf2f((bf16_t)(p.y >> 16)); }
            u32x2 w; w.x = pk2(s[0], s[1]); w.y = pk2(s[2], s[3]);
            *(u32x2*)(MG + off) = w; }
    }
};
struct EpiOut {
    static constexpr bool PERM = true;
    const bf16_t* H; bf16_t* X1;
    __device__ __forceinline__ void operator()(const f32x4 (&acc)[2][2][4][2], const Unit& u, int wr, int wc, int fr, int fq) const {
        const int row0 = u.pm * 256 + wr * 64 + fr, col0 = u.pn * 256 + wc * 32 + 8 * fq;
        u32x4 hv[2][4][2];
        EPI_LOOP_AM { const size_t off = (size_t)(row0 + ai * 128 + m * 16) * D + col0; hv[ai][m][0] = *(const u32x4*)(H + off); hv[ai][m][1] = *(const u32x4*)(H + off + 128); }
        EPI_LOOP_AM { const size_t off = (size_t)(row0 + ai * 128 + m * 16) * D + col0;
#pragma unroll
            for (int bj = 0; bj < 2; ++bj) { const u32x4 p = hv[ai][m][bj]; const f32x4 a0 = acc[ai][bj][m][0], a1 = acc[ai][bj][m][1];
                u32x4 w;
                w.x = pk2(ALPHA * bf2f((bf16_t)(p.x & 0xffffu)) + a0[0], ALPHA * bf2f((bf16_t)(p.x >> 16)) + a0[1]);
                w.y = pk2(ALPHA * bf2f((bf16_t)(p.y & 0xffffu)) + a0[2], ALPHA * bf2f((bf16_t)(p.y >> 16)) + a0[3]);
                w.z = pk2(ALPHA * bf2f((bf16_t)(p.z & 0xffffu)) + a1[0], ALPHA * bf2f((bf16_t)(p.z >> 16)) + a1[1]);
                w.w = pk2(ALPHA * bf2f((bf16_t)(p.w & 0xffffu)) + a1[2], ALPHA * bf2f((bf16_t)(p.w >> 16)) + a1[3]);
                *(u32x4*)(X1 + off + bj * 128) = w; } }
    }
};
struct EpiSwiglu {
    static constexpr bool PERM = true;
    unsigned char* HE;
    __device__ __forceinline__ void operator()(const f32x4 (&acc)[2][2][4][2], const Unit& u, int wr, int wc, int fr, int fq) const {
        const int row0 = u.pm * 256 + wr * 64 + fr, col0 = u.pn * 128 + wc * 32 + 8 * fq;
        unsigned char* base = HE + (size_t)u.aux * EROWS * DFF;
        constexpr float IS = 1.0f / W13_SCALE;
        EPI_LOOP_AM { unsigned char* rowp = base + (size_t)(row0 + ai * 128 + m * 16) * DFF + col0;
            float h[8];
#pragma unroll
            for (int n = 0; n < 2; ++n)
#pragma unroll
                for (int j = 0; j < 4; ++j) h[4 * n + j] = siluf_(acc[ai][0][m][n][j] * IS) * (acc[ai][1][m][n][j] * IS);
            u32x2 w; w.x = pk4_fp8(h[0], h[1], h[2], h[3]); w.y = pk4_fp8(h[4], h[5], h[6], h[7]);
            *(u32x2*)rowp = w; }
    }
};
struct EpiScale {
    static constexpr bool PERM = true;
    bf16_t* YE; const float* SG;
    __device__ __forceinline__ void operator()(const f32x4 (&acc)[2][2][4][2], const Unit& u, int wr, int wc, int fr, int fq) const {
        const int row0 = u.pm * 256 + wr * 64 + fr, col0 = u.pn * 256 + wc * 32 + 8 * fq;
        bf16_t* base = YE + (size_t)u.aux * EROWS * D; const float* sg = SG + (size_t)u.aux * EROWS;
        float gv[2][4];
        EPI_LOOP_AM { gv[ai][m] = sg[row0 + ai * 128 + m * 16]; }
        EPI_LOOP_AM { const int row = row0 + ai * 128 + m * 16; const float g = gv[ai][m] * (1.0f / W2_SCALE); bf16_t* rowp = base + (size_t)row * D + col0;
#pragma unroll
            for (int bj = 0; bj < 2; ++bj) { const f32x4 v0 = acc[ai][bj][m][0] * g, v1 = acc[ai][bj][m][1] * g;
                u32x4 w; w.x = pk2(v0[0], v0[1]); w.y = pk2(v0[2], v0[3]); w.z = pk2(v1[0], v1[1]); w.w = pk2(v1[2], v1[3]);
                *(u32x4*)(rowp + bj * 128) = w; } }
    }
};

template <class ColMap>
__device__ __forceinline__ void tr_tile(const Frame& F, const float* src, size_t ld_src, bf16_t* dst, size_t ldd, int n0, int k0, const ColMap& cm) {
    LAS float* tile = (LAS float*)F.lds;
    const int a = F.tid >> 6, b = F.tid & 63;
    const int col = cm(n0 + b);
#pragma unroll
    for (int j = 0; j < 8; ++j) { const int kk = a + 8 * j; tile[b * 65 + kk] = (col >= 0) ? src[(size_t)(k0 + kk) * ld_src + col] : 0.f; }
    __syncthreads();
#pragma unroll
    for (int j = 0; j < 8; ++j) { const int nn = a + 8 * j; dst[(size_t)(n0 + nn) * ldd + k0 + b] = f2bf(tile[nn * 65 + b]); }
    __syncthreads();
}
template <class ColMap>
__device__ __forceinline__ void tr_strip(const Frame& F, const float* src, size_t ld_src, bf16_t* dst, size_t ldd, int n0, int k0, const ColMap& cm) {
    LAS float* tile = (LAS float*)F.lds;
    const int a = F.tid >> 6, b = F.tid & 63;
    const int col = cm(n0 + b);
    float v[32];
#pragma unroll
    for (int j = 0; j < 32; ++j) v[j] = (col >= 0) ? src[(size_t)(k0 + a + 8 * j) * ld_src + col] : 0.f;
#pragma unroll
    for (int j = 0; j < 32; ++j) tile[b * 257 + a + 8 * j] = v[j];
    __syncthreads();
#pragma unroll
    for (int j = 0; j < 8; ++j) { const int nn = a + 8 * j;
#pragma unroll
        for (int m = 0; m < 2; ++m) { const int kk = 2 * b + 128 * m; *(unsigned*)(dst + (size_t)(n0 + nn) * ldd + k0 + kk) = pk2(tile[nn * 257 + kk], tile[nn * 257 + kk + 1]); } }
    __syncthreads();
}
template <class ColMap>
__device__ __forceinline__ void tr_strip8m(const Frame& F, const float* src, size_t ld_src, unsigned char* dst, size_t ldd, int n0, int k0, const ColMap& cm, float scale) {
    LAS float* tile = (LAS float*)F.lds;
    const int a = F.tid >> 6, b = F.tid & 63; const int col = cm(n0 + b);
    float v[32];
#pragma unroll
    for (int j = 0; j < 32; ++j) v[j] = src[(size_t)(k0 + a + 8 * j) * ld_src + col];
#pragma unroll
    for (int j = 0; j < 32; ++j) tile[b * 257 + a + 8 * j] = v[j] * scale;
    __syncthreads();
#pragma unroll
    for (int j = 0; j < 8; ++j) { const int nn = a + 8 * j; const LAS float* tp = tile + nn * 257 + 4 * b;
        *(unsigned*)(dst + (size_t)(n0 + nn) * ldd + k0 + 4 * b) = pk4_fp8(tp[0], tp[1], tp[2], tp[3]); }
    __syncthreads();
}
__device__ __forceinline__ void tr_strip8(const Frame& F, const float* src, size_t ld_src, unsigned char* dst, size_t ldd, int n0, int k0, int coff, float scale) {
    LAS float* tile = (LAS float*)F.lds;
    const int a = F.tid >> 6, b = F.tid & 63;
    float v[32];
#pragma unroll
    for (int j = 0; j < 32; ++j) v[j] = src[(size_t)(k0 + a + 8 * j) * ld_src + coff + n0 + b];
#pragma unroll
    for (int j = 0; j < 32; ++j) tile[b * 257 + a + 8 * j] = v[j] * scale;
    __syncthreads();
#pragma unroll
    for (int j = 0; j < 8; ++j) { const int nn = a + 8 * j; const LAS float* tp = tile + nn * 257 + 4 * b;
        *(unsigned*)(dst + (size_t)(n0 + nn) * ldd + k0 + 4 * b) = pk4_fp8(tp[0], tp[1], tp[2], tp[3]); }
    __syncthreads();
}
struct CmId { int off; __device__ __forceinline__ int operator()(int n) const { return off + n; } };
struct CmW1 { __device__ __forceinline__ int operator()(int n) const { return n < 512 ? n : (n < 2432 ? n + 512 : -1); } };
struct CmW2 { __device__ __forceinline__ int operator()(int n) const { return n < 2048 ? 2944 + n : 3456 + n; } };
struct CmWG { __device__ __forceinline__ int operator()(int n) const { return n < 512 ? 512 + n : (n < 1024 ? 4480 + n : 5504 + n); } };
struct CmWM { __device__ __forceinline__ int operator()(int n) const { const int pn = n >> 8, c = n & 255, bj = c >> 7, wc = (c >> 5) & 3, nn = (c >> 4) & 1, fq = (c >> 2) & 3, j = c & 3;
        return 7040 + (2 * bj + nn) * 1024 + 64 * pn + 16 * wc + 4 * fq + j; } };

__device__ __forceinline__ void phase_prep_weights(const Frame& F0) {
    Frame F = F0; { size_t z_ = 0; asm volatile("" : "+v"(F.tid), "+v"(F.lane), "+s"(z_), "+s"(F.bid), "+s"(F.G), "+s"(F.wave)); F.ws = F0.ws + z_; F.out = F0.out + z_; }
    for (int job = F.bid; job < 2 * 912; job += F.G) {
        const int li = job / 912; int j = job - li * 912;
        const float* win = F.in[I_WIN] + (size_t)li * D * N_IN;
        if (j < 160) { tr_strip(F, win, N_IN, (bf16_t*)(F.ws + WS_W1T) + (size_t)li * N1 * D, D, (j >> 2) * 64, (j & 3) * 256, CmW1()); continue; } j -= 160;
        if (j < 192) { tr_strip(F, win, N_IN, (bf16_t*)(F.ws + WS_W2T) + (size_t)li * N2 * D, D, (j >> 2) * 64, (j & 3) * 256, CmW2()); continue; } j -= 192;
        if (j < 96) { tr_strip(F, win, N_IN, (bf16_t*)(F.ws + WS_WGT) + (size_t)li * NG * D, D, (j >> 2) * 64, (j & 3) * 256, CmWG()); continue; } j -= 96;
        if (j < 256) { tr_strip8m(F, win, N_IN, (unsigned char*)(F.ws + WS_WMT) + (size_t)li * NM * D, D, (j >> 2) * 64, (j & 3) * 256, CmWM(), WM_SCALE); continue; } j -= 256;
        if (j < 128) { const int nb = j >> 5, r = j & 31;
            tr_strip(F, F.in[I_WBR] + ((size_t)li * 4 + nb) * 512 * D, D, (bf16_t*)(F.ws + WS_WBT) + ((size_t)li * 4 + nb) * D * 512, 512, (r >> 1) * 64, (r & 1) * 256, CmId{0}); continue; } j -= 128;
        if (j < 64) { tr_strip(F, F.in[I_WOUT] + (size_t)li * D * D, D, (bf16_t*)(F.ws + WS_WOT) + (size_t)li * D * D, D, (j >> 2) * 64, (j & 3) * 256, CmId{0}); continue; } j -= 64;
        tr_tile(F, F.in[I_G2] + (size_t)li * 128 * 512, 512, (bf16_t*)(F.ws + WS_G2T) + (size_t)li * 512 * 128, 128, (j >> 1) * 64, (j & 1) * 64, CmId{0});
    }
    for (int job = F.bid; job < 128; job += F.G) {
        if (job < 64) { const int li = job >> 5, d = (job >> 4) & 1, m = (job >> 3) & 1, nt = job & 7;
            tr_tile(F, F.in[m ? I_A2 : I_W2] + ((size_t)li * 2 + d) * 64 * 512, 512, (bf16_t*)(F.ws + WS_RW2T) + (((size_t)li * 2 + d) * 2 + m) * 512 * 64, 64, nt * 64, 0, CmId{0});
        } else { const int j = job - 64, li = j >> 5, d = (j >> 4) & 1, m = (j >> 3) & 1, g = j & 7;
            tr_tile(F, F.in[m ? I_WI : I_WR] + (((size_t)li * 2 + d) * 8 + g) * 64 * 64, 64, (bf16_t*)(F.ws + WS_LRUT) + ((((size_t)li * 2 + d) * 2 + m) * 8 + g) * 64 * 64, 64, 0, 0, CmId{0}); }
    }
    if (F.bid == 0) { float* lb = (float*)(F.ws + WS_LB); const float* h = F.in[I_HLB];
        for (int c = F.tid; c < 512; c += NTHREADS) { lb[c] = 0.f; lb[512 + c] = 1.0f / (1.0f + expf(h[c] - h[512 + c])); } }
}
__device__ __forceinline__ void phase_prep_experts(const Frame& F0, int li, int jlo, int jhi, int units) {
    Frame F = F0; { size_t z_ = 0; asm volatile("" : "+v"(F.tid), "+v"(F.lane), "+s"(z_), "+s"(F.bid), "+s"(F.G), "+s"(F.wave)); F.ws = F0.ws + z_; F.out = F0.out + z_; }
    const int nskip = (units > F.G && F.G > 64) ? units % F.G : 0;
    if (F.bid < nskip) return;
    for (int job = jlo + F.bid - nskip; job < jhi; job += F.G - nskip) {
        const bool is13 = job < NE * 256; const int e = is13 ? (job >> 8) : ((job - NE * 256) >> 7); int j = is13 ? (job & 255) : 256 + ((job - NE * 256) & 127);
        if (j < 256) { const int nt = j >> 2, ks = j & 3, p = nt >> 2, r = nt & 3, which = r >> 1, nsub = r & 1;
            const float* src = F.in[which ? I_EW3 : I_EW1] + ((size_t)li * NE + e) * D * DFF;
            const int n0 = 64 * nt;
            tr_strip8(F, src, DFF, (unsigned char*)F.out + OUT_W13 + (size_t)e * 4096 * D, D, n0, ks * 256, 128 * p + 64 * nsub - n0, W13_SCALE);
        } else { j -= 256;
            tr_strip8(F, F.in[I_EW2] + ((size_t)li * NE + e) * DFF * D, D, (unsigned char*)F.out + OUT_W2 + (size_t)e * D * DFF, DFF, (j >> 3) * 64, (j & 7) * 256, 0, W2_SCALE); }
    }
}

__device__ __forceinline__ void ln_stats(const float (&x)[16], float& mu, float& rstd) {
    float s = 0.f;
#pragma unroll
    for (int i = 0; i < 16; ++i) s += x[i];
    mu = wave_sum(s) * (1.0f / 1024.0f);
    float q = 0.f;
#pragma unroll
    for (int i = 0; i < 16; ++i) { const float dlt = x[i] - mu; q += dlt * dlt; }
    rstd = rsqrtf(wave_sum(q) * (1.0f / 1024.0f) + 1e-5f);
}
__device__ __forceinline__ void ld16_f32(const float* p, int lane, float (&x)[16]) {
#pragma unroll
    for (int j = 0; j < 2; ++j) { const f32x4 a = *(const f32x4*)(p + 512 * j + 8 * lane), b = *(const f32x4*)(p + 512 * j + 8 * lane + 4);
#pragma unroll
        for (int i = 0; i < 4; ++i) { x[8 * j + i] = a[i]; x[8 * j + 4 + i] = b[i]; } }
}
__device__ __forceinline__ void ld16_bf16(const bf16_t* p, int lane, float (&x)[16]) {
#pragma unroll
    for (int j = 0; j < 2; ++j) { const u32x4 a = *(const u32x4*)(p + 512 * j + 8 * lane); const unsigned w[4] = {a.x, a.y, a.z, a.w};
#pragma unroll
        for (int i = 0; i < 4; ++i) { x[8 * j + 2 * i] = bf2f((bf16_t)(w[i] & 0xffffu)); x[8 * j + 2 * i + 1] = bf2f((bf16_t)(w[i] >> 16)); } }
}
__device__ __forceinline__ void unpack16(const u32x4 (&a)[2], float (&x)[16]) {
#pragma unroll
    for (int j = 0; j < 2; ++j) { const unsigned w[4] = {a[j].x, a[j].y, a[j].z, a[j].w};
#pragma unroll
        for (int i = 0; i < 4; ++i) { x[8 * j + 2 * i] = bf2f((bf16_t)(w[i] & 0xffffu)); x[8 * j + 2 * i + 1] = bf2f((bf16_t)(w[i] >> 16)); } }
}
__device__ __forceinline__ void ldraw16(const bf16_t* p, int lane, u32x4 (&a)[2]) { a[0] = __builtin_nontemporal_load((const u32x4*)(p + 8 * lane)); a[1] = __builtin_nontemporal_load((const u32x4*)(p + 512 + 8 * lane)); }
__device__ __forceinline__ void st16_bf16(bf16_t* p, int lane, const float (&x)[16]) {
#pragma unroll
    for (int j = 0; j < 2; ++j) { u32x4 w; w.x = pk2(x[8 * j], x[8 * j + 1]); w.y = pk2(x[8 * j + 2], x[8 * j + 3]); w.z = pk2(x[8 * j + 4], x[8 * j + 5]); w.w = pk2(x[8 * j + 6], x[8 * j + 7]);
        *(u32x4*)(p + 512 * j + 8 * lane) = w; }
}
__device__ __forceinline__ void st16_fp8(unsigned char* p, int lane, const float (&x)[16]) {
#pragma unroll
    for (int j = 0; j < 2; ++j) { u32x2 w8; w8.x = pk4_fp8(x[8 * j], x[8 * j + 1], x[8 * j + 2], x[8 * j + 3]); w8.y = pk4_fp8(x[8 * j + 4], x[8 * j + 5], x[8 * j + 6], x[8 * j + 7]); *(u32x2*)(p + 512 * j + 8 * lane) = w8; }
}
__device__ __forceinline__ void st16_f32(float* p, int lane, const float (&x)[16]) {
#pragma unroll
    for (int j = 0; j < 2; ++j) { *(f32x4*)(p + 512 * j + 8 * lane) = (f32x4){x[8 * j], x[8 * j + 1], x[8 * j + 2], x[8 * j + 3]}; *(f32x4*)(p + 512 * j + 8 * lane + 4) = (f32x4){x[8 * j + 4], x[8 * j + 5], x[8 * j + 6], x[8 * j + 7]}; }
}
__device__ __forceinline__ void ln_apply(float (&x)[16], float mu, float rstd, const float (&gg)[16], const float (&bb)[16]) {
#pragma unroll
    for (int i = 0; i < 16; ++i) x[i] = (x[i] - mu) * rstd * gg[i] + bb[i];
}

__device__ __forceinline__ void phase_embed(const Frame& F0) {
    Frame F = F0; { size_t z_ = 0; asm volatile("" : "+v"(F.tid), "+v"(F.lane), "+s"(z_), "+s"(F.bid), "+s"(F.G), "+s"(F.wave)); F.ws = F0.ws + z_; F.out = F0.out + z_; }
    const int gw = F.bid * NWAVES + F.wave, nw = F.G * NWAVES;
    float gg[16], bb[16]; ld16_f32(F.in[I_LNEG], F.lane, gg); ld16_f32(F.in[I_LNEB], F.lane, bb);
    for (int row0 = gw; row0 < NTOK; row0 += 2 * nw) {
        float xs[2][16];
#pragma unroll
        for (int j = 0; j < 2; ++j) { const int row = row0 + j * nw; if (row < NTOK) { const int s = row / LSEQ, t = row - s * LSEQ;
            const float* src = (t < NMETA) ? F.in[I_META] + (size_t)t * D : ((s < NSEQ0) ? F.in[I_XP] + ((size_t)s * SEQ + (t - NMETA)) * D : F.in[I_XS] + ((size_t)(s - NSEQ0) * SEQ + (t - NMETA)) * D);
            ld16_f32(src, F.lane, xs[j]); } }
#pragma unroll
        for (int j = 0; j < 2; ++j) { const int row = row0 + j * nw; if (row < NTOK) {
            float mu, rstd; ln_stats(xs[j], mu, rstd); ln_apply(xs[j], mu, rstd, gg, bb);
            st16_bf16(F.hbuf() + (size_t)row * D, F.lane, xs[j]); st16_fp8((unsigned char*)F.out + OUT_HIN8 + (size_t)row * D, F.lane, xs[j]); } }
    }
}

__device__ __forceinline__ void phase_ln1_router(const Frame& F0, int li) {
    Frame F = F0; { size_t z_ = 0; asm volatile("" : "+v"(F.tid), "+v"(F.lane), "+s"(z_), "+s"(F.bid), "+s"(F.G), "+s"(F.wave)); F.ws = F0.ws + z_; F.out = F0.out + z_; }
    LAS float* RW = (LAS float*)F.lds;
    LAS unsigned* hl0 = (LAS unsigned*)(F.lds + 65536);
    for (int i = F.tid; i < 32 * 512; i += NTHREADS) hl0[i] = 0u;
    const float* router = F.in[I_ROUTER] + (size_t)li * D * NE;
    {
        float rv[32];
#pragma unroll
        for (int j = 0; j < 32; ++j) rv[j] = router[F.tid + j * NTHREADS];
#pragma unroll
        for (int j = 0; j < 32; ++j) { const int i = F.tid + j * NTHREADS; RW[(i & 15) * D + (i >> 4)] = rv[j]; } }
    { unsigned* hist = (unsigned*)(F.ws + WS_HIST); for (int i = F.bid * NTHREADS + F.tid; i < 2 * 32 * 1024; i += F.G * NTHREADS) hist[32 * 1024 + i] = 0u;
      if (F.bid == 0 && F.tid < 64) { unsigned* ctl = (unsigned*)(F.ws + WS_CTL); ctl[CW_CNT + F.tid] = 0u; ctl[CW_TIE + F.tid] = 0u; }
      int* stok = (int*)(F.ws + WS_STOK); float* sg = (float*)(F.ws + WS_SGATE);
      for (int i = F.bid * NTHREADS + F.tid; i < NE * (EROWS - EVALID); i += F.G * NTHREADS) { const int e = i / (EROWS - EVALID), r = EVALID + i % (EROWS - EVALID); stok[e * EROWS + r] = 0; sg[e * EROWS + r] = 0.f; } }
    __syncthreads();
    const bf16_t* X1 = (const bf16_t*)(F.ws + R_X1); float* aff = (float*)(F.ws + WS_AFF);
    float gg[16], bb[16]; ld16_f32(F.in[I_LN1G] + (size_t)li * D, F.lane, gg); ld16_f32(F.in[I_LN1B] + (size_t)li * D, F.lane, bb);
    const int gw = F.bid * NWAVES + F.wave, nw = F.G * NWAVES;
    for (int row0 = gw; row0 < NTOK; row0 += 4 * nw) {
      u32x4 XR[4][2];
#pragma unroll
      for (int jr = 0; jr < 4; ++jr) { const int row = row0 + jr * nw; if (row < NTOK) ldraw16(X1 + (size_t)row * D, F.lane, XR[jr]); }
#pragma unroll
      for (int jr = 0; jr < 4; ++jr) { const int row = row0 + jr * nw; if (row < NTOK) {
        float x[16]; unpack16(XR[jr], x);
        float mu, rstd; ln_stats(x, mu, rstd); ln_apply(x, mu, rstd, gg, bb);
        st16_bf16(F.hbuf() + (size_t)row * D, F.lane, x);
        { unsigned char* h8 = F.ws + R_H8 + (size_t)row * D;
#pragma unroll
          for (int j = 0; j < 2; ++j) { u32x2 w8; w8.x = pk4_fp8(x[8 * j], x[8 * j + 1], x[8 * j + 2], x[8 * j + 3]); w8.y = pk4_fp8(x[8 * j + 4], x[8 * j + 5], x[8 * j + 6], x[8 * j + 7]); *(u32x2*)(h8 + 512 * j + 8 * F.lane) = w8; } }
        float lg[16];
#pragma unroll
        for (int e = 0; e < 16; ++e) lg[e] = 0.f;
#pragma unroll 4
        for (int e = 0; e < 16; ++e) { float a = 0.f;
#pragma unroll
            for (int j = 0; j < 2; ++j) { const f32x4 w0 = *(const LAS f32x4*)(RW + e * D + 512 * j + 8 * F.lane), w1 = *(const LAS f32x4*)(RW + e * D + 512 * j + 8 * F.lane + 4);
                a += x[8 * j] * w0[0] + x[8 * j + 1] * w0[1] + x[8 * j + 2] * w0[2] + x[8 * j + 3] * w0[3] + x[8 * j + 4] * w1[0] + x[8 * j + 5] * w1[1] + x[8 * j + 6] * w1[2] + x[8 * j + 7] * w1[3]; }
            lg[e] = a; }
        float mx = -1e30f;
#pragma unroll
        for (int e = 0; e < 16; ++e) { lg[e] = wave_sum(lg[e]); mx = fmaxf(mx, lg[e]); }
        float den = 0.f;
#pragma unroll
        for (int e = 0; e < 16; ++e) { lg[e] = __expf(lg[e] - mx); den += lg[e]; }
        const float inv = __builtin_amdgcn_rcpf(den);
        float mine = 0.f;
#pragma unroll
        for (int e = 0; e < 16; ++e) mine = (F.lane == e) ? lg[e] * inv : mine;
        if (F.lane < 16) { aff[(size_t)row * 16 + F.lane] = mine;
            unsigned bin = __float_as_uint(mine) >> 20; if (bin > 1023u) bin = 1023u;
            (void)__hip_atomic_fetch_add(hl0 + ((row >= TOK0 ? 16 : 0) + F.lane) * 512 + (bin >> 1), 1u << (16 * (bin & 1u)), __ATOMIC_RELAXED, __HIP_MEMORY_SCOPE_WORKGROUP); }
      } }
    }
    __syncthreads();
    { unsigned* gh = (unsigned*)(F.ws + WS_HIST); for (int i = F.tid; i < 32 * 512; i += NTHREADS) { const unsigned v = hl0[i]; if (v & 0xffffu) atomicAdd(gh + 2 * i, v & 0xffffu); if (v >> 16) atomicAdd(gh + 2 * i + 1, v >> 16); } }
    __syncthreads();
}

__device__ __forceinline__ void find_bin(const unsigned* h, unsigned target, int lane, unsigned& bin, unsigned& rem, unsigned& bincnt) {
    unsigned c[16]; unsigned ls = 0;
#pragma unroll
    for (int i = 0; i < 16; ++i) { c[i] = __hip_atomic_load(h + 16 * lane + i, __ATOMIC_RELAXED, __HIP_MEMORY_SCOPE_AGENT); ls += c[i]; }
    unsigned x = ls;
#pragma unroll
    for (int o = 1; o < 64; o <<= 1) { const unsigned v = __shfl_down(x, o); if (lane + o < 64) x += v; }
    const unsigned above = x - ls;
    const bool own = (above < target) && (target <= above + ls);
    unsigned b = 0, r = 1, bc = 1;
    if (own) { unsigned cum = above; bool done = false;
#pragma unroll
        for (int i = 15; i >= 0; --i) { if (!done && target <= cum + c[i]) { b = 16 * lane + i; r = target - cum; bc = c[i]; done = true; } cum += c[i]; } }
    const unsigned long long m = __ballot(own);
    const int src = m ? (int)__builtin_ctzll(m) : 0;
    bin = __shfl(b, src); rem = __shfl(r, src); bincnt = __shfl(bc, src);
}
__device__ __forceinline__ void phase_topk(const Frame& F0, int pass) {
    Frame F = F0; { size_t z_ = 0; asm volatile("" : "+v"(F.tid), "+v"(F.lane), "+s"(z_), "+s"(F.bid), "+s"(F.G), "+s"(F.wave)); F.ws = F0.ws + z_; F.out = F0.out + z_; }
    LAS unsigned* hl = (LAS unsigned*)F.lds;
    LAS unsigned* selp = (LAS unsigned*)(F.lds + 131072);
    unsigned* hist = (unsigned*)(F.ws + WS_HIST);
    const float* aff = (const float*)(F.ws + WS_AFF);
    for (int i = F.tid; i < 32 * 1024; i += NTHREADS) hl[i] = 0u;
    for (int q = F.wave; q < 32; q += NWAVES) {
        const unsigned cap = (q < 16) ? CAP0 : CAP1; unsigned prefix = 0, rem = cap, bcnt = 0;
        if (pass > 1) { prefix = selp[q]; rem = selp[32 + q]; }
        { unsigned bin, r; find_bin(hist + ((size_t)(pass - 1) * 32 + q) * 1024, rem, F.lane, bin, r, bcnt); prefix = (pass == 1) ? bin : ((prefix << 10) | bin); rem = r; }
        if (F.lane == 0) { selp[q] = prefix; selp[32 + q] = rem; selp[64 + q] = bcnt; }
    }
    __syncthreads();
    if (pass < 3) {
        for (int tb0 = F.bid; tb0 < NTOK / 32; tb0 += 4 * F.G) {
            unsigned bv[4];
#pragma unroll
            for (int u = 0; u < 4; ++u) { const int tb = tb0 + u * F.G, tbc = tb < NTOK / 32 ? tb : NTOK / 32 - 1; bv[u] = __float_as_uint(aff[((size_t)tbc * 32 + (F.tid >> 4)) * 16 + (F.tid & 15)]); }
#pragma unroll
            for (int u = 0; u < 4; ++u) { const int tb = tb0 + u * F.G;
                const int t = tb * 32 + (F.tid >> 4), e = F.tid & 15, q = (t >= TOK0 ? 16 : 0) + e;
                const unsigned bits = bv[u];
                unsigned bin; bool ok;
                if (pass == 0) { bin = bits >> 20; ok = true; }
                else if (pass == 1) { bin = (bits >> 10) & 1023u; ok = (bits >> 20) == selp[q]; }
                else { bin = bits & 1023u; ok = (bits >> 10) == selp[q]; }
                if (bin > 1023u) bin = 1023u;
                if (ok && tb < NTOK / 32) (void)__hip_atomic_fetch_add(hl + q * 1024 + bin, 1u, __ATOMIC_RELAXED, __HIP_MEMORY_SCOPE_WORKGROUP); }
        }
        __syncthreads();
        unsigned* gh = hist + (size_t)pass * 32 * 1024;
        for (int i = F.tid; i < 32 * 1024; i += NTHREADS) { const unsigned v = hl[i]; if (v) atomicAdd(gh + i, v); }
    } else {
        unsigned* ctl = (unsigned*)(F.ws + WS_CTL); int* stok = (int*)(F.ws + WS_STOK); float* sg = (float*)(F.ws + WS_SGATE); int* inv = (int*)(F.ws + WS_INV);
        LAS unsigned* lcnt = selp + 96;
        LAS unsigned* lbase = selp + 128;
        if (F.tid < 32) lcnt[F.tid] = 0u;
        __syncthreads();
        auto selected = [&](int t, int e, int set, int q, unsigned bits) -> bool {
            const unsigned thr = selp[q]; bool sel = bits > thr; const bool tie = (bits == thr); if (tie) sel = true;
            unsigned long long need = __ballot(tie && (selp[64 + q] != selp[32 + q]));
            while (need) { const int src = (int)__builtin_ctzll(need); need &= need - 1;
                const int t_s = __shfl(t, src), e_s = __shfl(e, src), set_s = __shfl(set, src); const unsigned thr_s = __shfl(thr, src);
                unsigned c = 0; for (int t2 = (set_s ? TOK0 : 0) + F.lane; t2 < t_s; t2 += 64) c += (__float_as_uint(aff[(size_t)t2 * 16 + e_s]) == thr_s) ? 1u : 0u;
#pragma unroll
                for (int o = 32; o > 0; o >>= 1) c += __shfl_xor(c, o);
                if (F.lane == src) sel = c < selp[32 + q]; }
            return sel; };
        for (int tb = F.bid; tb < NTOK / 32; tb += F.G) {
            const int t = tb * 32 + (F.tid >> 4), e = F.tid & 15, set = (t >= TOK0) ? 1 : 0, q = set * 16 + e;
            if (selected(t, e, set, q, __float_as_uint(aff[(size_t)t * 16 + e]))) (void)__hip_atomic_fetch_add(lcnt + q, 1u, __ATOMIC_RELAXED, __HIP_MEMORY_SCOPE_WORKGROUP); }
        __syncthreads();
        if (F.tid < 32) { const unsigned n = lcnt[F.tid]; lbase[F.tid] = n ? atomicAdd(ctl + CW_CNT + F.tid, n) : 0u; lcnt[F.tid] = 0u; }
        __syncthreads();
        for (int tb = F.bid; tb < NTOK / 32; tb += F.G) {
            const int t = tb * 32 + (F.tid >> 4), e = F.tid & 15, set = (t >= TOK0) ? 1 : 0, q = set * 16 + e;
            const float a = aff[(size_t)t * 16 + e];
            int pos = -1;
            if (selected(t, e, set, q, __float_as_uint(a))) { const unsigned sl = lbase[q] + __hip_atomic_fetch_add(lcnt + q, 1u, __ATOMIC_RELAXED, __HIP_MEMORY_SCOPE_WORKGROUP); const unsigned cap = set ? CAP1 : CAP0;
                if (sl < cap) { pos = (int)(set ? CAP0 + sl : sl); stok[e * EROWS + pos] = t; sg[e * EROWS + pos] = a; } }
            inv[(size_t)t * 16 + e] = pos;
        }
    }
    __syncthreads();
}

__device__ __forceinline__ void phase_combine(const Frame& F0, int li) {
    Frame F = F0; { size_t z_ = 0; asm volatile("" : "+v"(F.tid), "+v"(F.lane), "+s"(z_), "+s"(F.bid), "+s"(F.G), "+s"(F.wave)); F.ws = F0.ws + z_; F.out = F0.out + z_; }
    const bf16_t* ye = (const bf16_t*)(F.ws + R_YE); const int* inv = (const int*)(F.ws + WS_INV);
    float gg[16], bb[16]; ld16_f32(F.in[I_LN2G] + (size_t)li * D, F.lane, gg); ld16_f32(F.in[I_LN2B] + (size_t)li * D, F.lane, bb);
    const int gw = F.bid * NWAVES + F.wave, nw = F.G * NWAVES;
    for (int row0 = gw; row0 < NTOK; row0 += 4 * nw) {
        u32x4 HR[4][2]; int iv[4];
#pragma unroll
        for (int j = 0; j < 4; ++j) { const int row = row0 + j * nw; iv[j] = -1; if (row < NTOK) { ldraw16(F.hbuf() + (size_t)row * D, F.lane, HR[j]); if (F.lane < 16) iv[j] = inv[(size_t)row * 16 + F.lane]; } }
        u32x4 Y0[4][2], Y1[4][2]; unsigned long long rest[4]; bool h0[4], h1[4];
#pragma unroll
        for (int j = 0; j < 4; ++j) { unsigned long long em = __ballot(iv[j] >= 0) & 0xFFFFull; h0[j] = false; h1[j] = false;
            if (em) { const int e = (int)__builtin_ctzll(em); em &= em - 1; const int p = __shfl(iv[j], e); ldraw16(ye + ((size_t)e * EROWS + p) * D, F.lane, Y0[j]); h0[j] = true; }
            if (em) { const int e = (int)__builtin_ctzll(em); em &= em - 1; const int p = __shfl(iv[j], e); ldraw16(ye + ((size_t)e * EROWS + p) * D, F.lane, Y1[j]); h1[j] = true; }
            rest[j] = em; }
#pragma unroll
        for (int j = 0; j < 4; ++j) { const int row = row0 + j * nw; if (row < NTOK) {
            float x[16]; unpack16(HR[j], x);
#pragma unroll
            for (int i = 0; i < 16; ++i) x[i] *= ALPHA;
            if (h0[j]) { float y[16]; unpack16(Y0[j], y);
#pragma unroll
                for (int i = 0; i < 16; ++i) x[i] += y[i]; }
            if (h1[j]) { float y[16]; unpack16(Y1[j], y);
#pragma unroll
                for (int i = 0; i < 16; ++i) x[i] += y[i]; }
            unsigned long long em = rest[j];
            while (em) { const int e = (int)__builtin_ctzll(em); em &= em - 1; const int p = __shfl(iv[j], e); float y[16]; ld16_bf16(ye + ((size_t)e * EROWS + p) * D, F.lane, y);
#pragma unroll
                for (int i = 0; i < 16; ++i) x[i] += y[i]; }
            float mu, rstd; ln_stats(x, mu, rstd); ln_apply(x, mu, rstd, gg, bb);
            if (li == NLAYER - 1) { const int s = row / LSEQ, t = row - s * LSEQ; if (t >= NMETA) st16_f32(F.out + ((size_t)s * SEQ + (t - NMETA)) * D, F.lane, x); }
            else { st16_bf16(F.hbuf() + (size_t)row * D, F.lane, x); st16_fp8((unsigned char*)F.out + OUT_HIN8 + (size_t)row * D, F.lane, x); } } }
    }
}

__device__ __forceinline__ f32x4 mfma16(bf16x8 x, bf16x8 y, f32x4 c) { return __builtin_amdgcn_mfma_f32_16x16x32_bf16(x, y, c, 0, 0, 0); }
__device__ __forceinline__ float dpp_f(float v, int ctrl_sel) {
    const int x = __float_as_int(v); int r;
    if (ctrl_sel == 0) r = __builtin_amdgcn_update_dpp(0, x, 0xB1, 0xF, 0xF, true);
    else if (ctrl_sel == 1) r = __builtin_amdgcn_update_dpp(0, x, 0x4E, 0xF, 0xF, true);
    else r = __builtin_amdgcn_update_dpp(0, x, 0x141, 0xF, 0xF, true);
    return __int_as_float(r);
}
__device__ __forceinline__ float red8(float v) { v += dpp_f(v, 0); v += dpp_f(v, 1); v += dpp_f(v, 2); return v; }
__device__ __forceinline__ float ldbf(const bf16_t* p) { return bf2f(*p); }

__device__ __forceinline__ bf16x8 pack4_(f32x4 a) { u32x4 r; r.x = pk2(a[0], a[1]); r.y = pk2(a[2], a[3]); r.z = 0u; r.w = 0u; return __builtin_bit_cast(bf16x8, r); }
__device__ __forceinline__ bf16x8 pack8_(f32x4 a, f32x4 b) { u32x4 r; r.x = pk2(a[0], a[1]); r.y = pk2(a[2], a[3]); r.z = pk2(b[0], b[1]); r.w = pk2(b[2], b[3]); return __builtin_bit_cast(bf16x8, r); }
__device__ __forceinline__ bf16x8 ld4_(const LAS bf16_t* p) { const u32x2 v = *(const LAS u32x2*)p; u32x4 r; r.x = v.x; r.y = v.y; r.z = 0u; r.w = 0u; return __builtin_bit_cast(bf16x8, r); }
__device__ __forceinline__ bf16x8 ld44_(const LAS bf16_t* p, const LAS bf16_t* q) { const u32x2 v = *(const LAS u32x2*)p, w = *(const LAS u32x2*)q; u32x4 r; r.x = v.x; r.y = v.y; r.z = w.x; r.w = w.y; return __builtin_bit_cast(bf16x8, r); }
__device__ __forceinline__ void rwkv_task(const Frame& F1, int li, int s, int d, int hg) {
    Frame F = F1; asm volatile("" : "+v"(F.tid), "+v"(F.lane));
    constexpr int DER = 17152;
    LAS float* ST = (LAS float*)(F.lds + 4 * DER);
    constexpr int STS = 260, STB = 2 * 16 * STS * 4;
    LAS bf16_t* TW = (LAS bf16_t*)(F.lds + 4 * DER + STB);
    LAS bf16_t* AD = TW + 16 * 72;
    LAS float* HS = (LAS float*)(F.lds + 4 * DER + STB + 4608);
    const int w = F.wave, hl = w >> 1, half = w & 1, h = 4 * hg + hl, lane = F.lane, fr = lane & 15, fq = lane >> 4, c = 64 * h + lane;
    LAS bf16_t* KAP = (LAS bf16_t*)(F.lds + hl * DER);
    LAS bf16_t* BH = KAP + 16 * 72; LAS bf16_t* KH = BH + 16 * 72; LAS bf16_t* RTL = KH + 16 * 72;
    LAS bf16_t* KBT = RTL + 16 * 72;
    LAS bf16_t* BBT = KBT + 64 * 20; LAS bf16_t* VT = BBT + 64 * 20;
    LAS float* GC = (LAS float*)(VT + 64 * 20);
    const bf16_t* U = F.ubuf();
    const float* mu = F.in[I_MU] + (size_t)li * 1920;
    const bf16_t* W2T = (const bf16_t*)(F.ws + WS_RW2T) + (((size_t)li * 2 + d) * 2 + 0) * 512 * 64 + (size_t)(64 * h + 32 * half + fr) * 64 + fq * 8; const bf16_t* A2T = W2T + (size_t)512 * 64;
    const float mu_r = mu[c], mu_k = mu[512 + c], mu_v = mu[1024 + c];
    const float w0c = F.in[I_W0][((size_t)li * 2 + d) * 512 + c], a0c = F.in[I_A0][((size_t)li * 2 + d) * 512 + c];
    const float kkc = F.in[I_KK][(size_t)li * 512 + c], kac = F.in[I_KA][(size_t)li * 512 + c], rkc = F.in[I_RK][(size_t)li * 512 + c];
    const int p_tt = F.tid >> 5, p_j = (F.tid & 31) * 2;
    const float mu_wd0 = mu[1536 + d * 64 + p_j], mu_wd1 = mu[1537 + d * 64 + p_j], mu_ad0 = mu[1664 + d * 64 + p_j], mu_ad1 = mu[1665 + d * 64 + p_j];
    float* bon = (float*)(F.ws + WS_BON);
    bf16_t* yout = (d == 0 ? F.br() : F.brx());
    const int ldy = (d == 0 ? 2048 : 1024);
    f32x4 Sacc[2][4];
#pragma unroll
    for (int it = 0; it < 2; ++it)
#pragma unroll
        for (int jt = 0; jt < 4; ++jt) Sacc[it][jt] = (f32x4){0.f, 0.f, 0.f, 0.f};
    const size_t rowbase = (size_t)s * LSEQ;
    const bool second = (d == 0) ? (half == 1) : (half == 0);
    unsigned pw[3], pa[3]; unsigned short pr[10], pk_[10], pv[10];
    auto prefetchA = [&](int t0) __attribute__((always_inline)) {
        { const int t = t0 + p_tt; const bf16_t* up = U + (rowbase + t) * N1 + 64 * d + p_j;
          const bf16_t* um = up - ((t > 0) ? N1 : 0); const bf16_t* upl = up + ((t < LSEQ - 1) ? N1 : 0);
          pw[1] = *(const unsigned*)(up + U1_WDN); pa[1] = *(const unsigned*)(up + U1_ADN);
          pw[0] = *(const unsigned*)(um + U1_WDN); pa[0] = *(const unsigned*)(um + U1_ADN);
          pw[2] = *(const unsigned*)(upl + U1_WDN); pa[2] = *(const unsigned*)(upl + U1_ADN); }
    };
    auto prefetchB = [&](int t0) __attribute__((always_inline)) {
        { const int tb = t0 + 8 * half - 1;
#pragma unroll
          for (int i = 0; i < 10; ++i) { int t = tb + i; t = t < 0 ? 0 : (t > LSEQ - 1 ? LSEQ - 1 : t); const bf16_t* up = U + (rowbase + t) * N1 + c;
            pr[i] = up[U1_R]; pk_[i] = up[U1_K]; pv[i] = up[U1_V]; } }
    };
    bf16x8 Xw[2][2], Xa[2][2];
#pragma unroll
    for (int ct = 0; ct < 2; ++ct)
#pragma unroll
        for (int ks = 0; ks < 2; ++ks) { Xw[ct][ks] = *(const bf16x8*)(W2T + ct * 16 * 64 + ks * 32); Xa[ct][ks] = *(const bf16x8*)(A2T + ct * 16 * 64 + ks * 32);
            asm volatile("" : "+v"(Xw[ct][ks]), "+v"(Xa[ct][ks])); }
    auto do_p1 = [&](int t0) __attribute__((always_inline)) {
        { float x[2], y[2];
          const unsigned mkm = (t0 + p_tt > 0) ? 0xffffffffu : 0u, mkp = (t0 + p_tt < LSEQ - 1) ? 0xffffffffu : 0u;
          const unsigned pw0 = pw[0] & mkm, pw2 = pw[2] & mkp, pa0 = pa[0] & mkm, pa2 = pa[2] & mkp;
#pragma unroll
          for (int e = 0; e < 2; ++e) { const int sh = 16 * e;
            const float x0 = bf2f((bf16_t)((pw[1] >> sh) & 0xffffu)), xm = bf2f((bf16_t)((pw0 >> sh) & 0xffffu)), xp = bf2f((bf16_t)((pw2 >> sh) & 0xffffu));
            const float y0 = bf2f((bf16_t)((pa[1] >> sh) & 0xffffu)), ym = bf2f((bf16_t)((pa0 >> sh) & 0xffffu)), yp = bf2f((bf16_t)((pa2 >> sh) & 0xffffu));
            { const float xa_ = x0 + (e ? mu_wd1 : mu_wd0) * (0.5f * (xm + xp) - x0); x[e] = 1.0f - 2.0f * __builtin_amdgcn_rcpf(1.0f + __expf(2.0f * xa_)); } y[e] = y0 + (e ? mu_ad1 : mu_ad0) * (0.5f * (ym + yp) - y0); }
          *(LAS unsigned*)(TW + p_tt * 72 + p_j) = pk2(x[0], x[1]); *(LAS unsigned*)(AD + p_tt * 72 + p_j) = pk2(y[0], y[1]); }
    };
    { const int t00 = (d == 0) ? 0 : LSEQ - 16, t01 = (d == 0) ? 16 : LSEQ - 32;
      prefetchA(t00); prefetchB(t00); do_p1(t00); prefetchA(t01); }
    __syncthreads();
    for (int ci = 0; ci < LSEQ / 16; ++ci) {
        const int t0 = (d == 0) ? 16 * ci : LSEQ - 16 - 16 * ci;
        { bf16x8 Yt[2], Ya[2];
#pragma unroll
          for (int ks = 0; ks < 2; ++ks) { Yt[ks] = *(const LAS bf16x8*)(TW + fr * 72 + ks * 32 + fq * 8); Ya[ks] = *(const LAS bf16x8*)(AD + fr * 72 + ks * 32 + fq * 8); }
#pragma unroll
          for (int ct = 0; ct < 2; ++ct) { f32x4 aw = (f32x4){0.f, 0.f, 0.f, 0.f}, aa = aw;
            aw = mfma16(Xw[ct][0], Yt[0], aw); aw = mfma16(Xw[ct][1], Yt[1], aw); aa = mfma16(Xa[ct][0], Ya[0], aa); aa = mfma16(Xa[ct][1], Ya[1], aa);
            *(LAS f32x4*)(ST + fr * STS + 64 * hl + 32 * half + ct * 16 + 4 * fq) = aw; *(LAS f32x4*)(ST + 16 * STS + fr * STS + 64 * hl + 32 * half + ct * 16 + 4 * fq) = aa; } }
        __syncthreads();
        { const bool lo_ok = (t0 + 8 * half - 1 >= 0), hi_ok = (t0 + 8 * half + 8 < LSEQ);
          if (!lo_ok) { pr[0] = 0; pk_[0] = 0; pv[0] = 0; }
          if (!hi_ok) { pr[9] = 0; pk_[9] = 0; pv[9] = 0; } }
        float lwv[8]; float tot = 0.f, other = 0.f;
#pragma unroll
        for (int i = 0; i < 8; ++i) { lwv[i] = -0.60653065971f * sigmoidf_(ST[(8 * half + i) * STS + 64 * hl + lane] + w0c); tot += lwv[i];
            other += -0.60653065971f * sigmoidf_(ST[(8 * (half ^ 1) + i) * STS + 64 * hl + lane] + w0c); }
        { const float off = second ? other : 0.f, glast = tot + other, eglast = __expf(glast);
          float run = 0.f, bsel = 0.f;
#pragma unroll
          for (int i = 0; i < 8; i += 2) {
            const int tt0 = 8 * half + i;
            const f32x2 rm = (f32x2){bf2f(pr[i]), bf2f(pr[i + 1])}, r1 = (f32x2){bf2f(pr[i + 1]), bf2f(pr[i + 2])}, rp = (f32x2){bf2f(pr[i + 2]), bf2f(pr[i + 3])};
            const f32x2 km = (f32x2){bf2f(pk_[i]), bf2f(pk_[i + 1])}, k1 = (f32x2){bf2f(pk_[i + 1]), bf2f(pk_[i + 2])}, kp = (f32x2){bf2f(pk_[i + 2]), bf2f(pk_[i + 3])};
            const f32x2 vm = (f32x2){bf2f(pv[i]), bf2f(pv[i + 1])}, v1 = (f32x2){bf2f(pv[i + 1]), bf2f(pv[i + 2])}, vp = (f32x2){bf2f(pv[i + 2]), bf2f(pv[i + 3])};
            const f32x2 r = r1 + mu_r * (0.5f * (rm + rp) - r1), k = k1 + mu_k * (0.5f * (km + kp) - k1), v = v1 + mu_v * (0.5f * (vm + vp) - v1);
            const f32x2 al = (f32x2){ST[16 * STS + tt0 * STS + 64 * hl + lane], ST[16 * STS + (tt0 + 1) * STS + 64 * hl + lane]} + a0c;
            const f32x2 a = (f32x2){sigmoidf_(al.x), sigmoidf_(al.y)};
            const f32x2 kd = k * (1.0f + (a - 1.0f) * kac), kk = k * kkc, sq = kk * kk, bs = r * kd * rkc;
            const f32x2 inrm = (f32x2){__builtin_amdgcn_rsqf(fmaxf(wave_sum(sq.x), 1e-24f)), __builtin_amdgcn_rsqf(fmaxf(wave_sum(sq.y), 1e-24f))};
            const float b0 = wave_sum(bs.x), b1 = wave_sum(bs.y);
            bsel = ((lane & 7) == i) ? b0 : (((lane & 7) == i + 1) ? b1 : bsel);
            const f32x2 kkn = kk * inrm, bt = kkn * a;
            run += lwv[i]; const float g0 = off + ((d == 0) ? run : (tot - run + lwv[i]));
            run += lwv[i + 1]; const float g1 = off + ((d == 0) ? run : (tot - run + lwv[i + 1]));
            const f32x2 eg = (f32x2){__expf(g0), __expf(g1)}, eng = (f32x2){__builtin_amdgcn_rcpf(eg.x), __builtin_amdgcn_rcpf(eg.y)}, ebar = eglast * eng;
            const f32x2 egm1 = (f32x2){__expf(g0 - lwv[i]), __expf(g1 - lwv[i + 1])};
            const f32x2 kap = kkn * egm1, bh = bt * eng, kh = kd * eng, rt = r * eg, kb = kd * ebar, bbn = -(bt * ebar);
            const int u0 = (d == 0) ? tt0 : 15 - tt0, u1 = (d == 0) ? u0 + 1 : u0 - 1, ulo = (d == 0) ? u0 : u1;
            { const unsigned p = pk2(kap.x, kap.y); KAP[u0 * 72 + lane] = (bf16_t)(p & 0xffffu); KAP[u1 * 72 + lane] = (bf16_t)(p >> 16); }
            { const unsigned p = pk2(bh.x, bh.y); BH[u0 * 72 + lane] = (bf16_t)(p & 0xffffu); BH[u1 * 72 + lane] = (bf16_t)(p >> 16); }
            { const unsigned p = pk2(kh.x, kh.y); KH[u0 * 72 + lane] = (bf16_t)(p & 0xffffu); KH[u1 * 72 + lane] = (bf16_t)(p >> 16); }
            { const unsigned p = pk2(rt.x, rt.y); RTL[u0 * 72 + lane] = (bf16_t)(p & 0xffffu); RTL[u1 * 72 + lane] = (bf16_t)(p >> 16); }
            { unsigned p = pk2(kb.x, kb.y); if (d) p = (p >> 16) | (p << 16); *(LAS unsigned*)(KBT + lane * 20 + ulo) = p; }
            { unsigned p = pk2(bbn.x, bbn.y); if (d) p = (p >> 16) | (p << 16); *(LAS unsigned*)(BBT + lane * 20 + ulo) = p; }
            { unsigned p = pk2(v.x, v.y); if (d) p = (p >> 16) | (p << 16); *(LAS unsigned*)(VT + lane * 20 + ulo) = p; } }
          bon[(rowbase + t0 + 8 * half + (lane & 7)) * 16 + d * 8 + h] = bsel;
          if (half == 0) GC[lane] = eglast; }
        if (ci + 1 < LSEQ / 16) { const int t1 = (d == 0) ? t0 + 16 : t0 - 16;
            prefetchB(t1);
            do_p1(t1);
            if (ci + 2 < LSEQ / 16) prefetchA((d == 0) ? t0 + 32 : t0 - 32); }
        __syncthreads();
        f32x4 aA = (f32x4){0.f, 0.f, 0.f, 0.f}, aAT = aA, aBT = aA, aC1 = aA, aC2 = aA;
#pragma unroll
        for (int ks = 0; ks < 2; ++ks) { const int o = fr * 72 + 32 * ks + 8 * fq;
            const bf16x8 fK = *(const LAS bf16x8*)(KAP + o), fB = *(const LAS bf16x8*)(BH + o), fH = *(const LAS bf16x8*)(KH + o), fR = *(const LAS bf16x8*)(RTL + o);
            aA = mfma16(fK, fB, aA); aAT = mfma16(fB, fK, aAT); aBT = mfma16(fH, fK, aBT); aC1 = mfma16(fH, fR, aC1); aC2 = mfma16(fB, fR, aC2); }
        f32x4 N, NT, H1;
#pragma unroll
        for (int e = 0; e < 4; ++e) { const int row = 4 * fq + e;
            N[e] = (fr < row) ? -aA[e] : 0.f; NT[e] = (row < fr) ? -aAT[e] : 0.f; aBT[e] = (row < fr) ? aBT[e] : 0.f;
            aC1[e] = (row <= fr) ? aC1[e] : 0.f; aC2[e] = (row <= fr) ? aC2[e] : 0.f; H1[e] = NT[e] + ((row == fr) ? 1.0f : 0.f); }
        const f32x4 Z4 = (f32x4){0.f, 0.f, 0.f, 0.f};
        const bf16x8 pN = pack4_(N), pNT = pack4_(NT);
        const f32x4 N2 = mfma16(pNT, pN, Z4), N2T = mfma16(pN, pNT, Z4);
        const bf16x8 pN2 = pack4_(N2), pN2T = pack4_(N2T);
        const f32x4 N4 = mfma16(pN2T, pN2, Z4), N4T = mfma16(pN2, pN2T, Z4);
        const bf16x8 pN4 = pack4_(N4);
        const f32x4 N8 = mfma16(pack4_(N4T), pN4, Z4);
        const f32x4 G1T = mfma16(pN2, pack4_(H1), H1);
        const f32x4 G2T = mfma16(pN4, pack4_(G1T), G1T);
        const f32x4 TT = mfma16(pack4_(N8), pack4_(G2T), G2T);
        const bf16x8 pTT = pack4_(TT), pBT = pack4_(aBT), pC1 = pack4_(aC1), pC2 = pack4_(aC2);
#pragma unroll
        for (int it = 0; it < 2; ++it) {
            const int i0 = 32 * half + 16 * it;
            const bf16x8 Vf = ld4_(VT + (i0 + fr) * 20 + 4 * fq);
            const bf16x8 Sf0 = pack8_(Sacc[it][0], Sacc[it][1]), Sf1 = pack8_(Sacc[it][2], Sacc[it][3]);
            f32x4 R = mfma16(ld44_(KAP + fr * 72 + 4 * fq, KAP + fr * 72 + 16 + 4 * fq), Sf0, Z4);
            R = mfma16(ld44_(KAP + fr * 72 + 32 + 4 * fq, KAP + fr * 72 + 48 + 4 * fq), Sf1, R);
            R = mfma16(pBT, Vf, R);
            const f32x4 Uu = mfma16(pTT, pack4_(R), Z4);
            f32x4 y = mfma16(Sf0, ld44_(RTL + fr * 72 + 4 * fq, RTL + fr * 72 + 16 + 4 * fq), Z4);
            y = mfma16(Sf1, ld44_(RTL + fr * 72 + 32 + 4 * fq, RTL + fr * 72 + 48 + 4 * fq), y);
            y = mfma16(Vf, pC1, y);
            const bf16x8 pU = pack4_(Uu), pUn = pack4_(-Uu);
            y = mfma16(pUn, pC2, y);
            { const int t = (d == 0) ? (t0 + fr) : (t0 + 15 - fr); u32x2 o; o.x = pk2(y[0], y[1]); o.y = pk2(y[2], y[3]);
              *(u32x2*)(yout + (rowbase + t) * ldy + 512 + 64 * h + i0 + 4 * fq) = o; }
#pragma unroll
            for (int jt = 0; jt < 4; ++jt) { const f32x4 dc = *(const LAS f32x4*)(GC + 16 * jt + 4 * fq);
                f32x4 acc = Sacc[it][jt] * dc;
                acc = mfma16(ld4_(KBT + (16 * jt + fr) * 20 + 4 * fq), Vf, acc);
                acc = mfma16(ld4_(BBT + (16 * jt + fr) * 20 + 4 * fq), pU, acc);
                Sacc[it][jt] = acc; }
            __builtin_amdgcn_sched_barrier(0);
        }
    }
    __syncthreads();
}

__device__ __forceinline__ void lru_block(const Frame& F1, int li, int s, int d, int g) {
    Frame F = F1; asm volatile("" : "+v"(F.tid), "+v"(F.lane));
    const int lane = F.lane, fr = lane & 15, fq = lane >> 4, c = 64 * g + lane;
    LAS bf16_t* XCT = (LAS bf16_t*)F.lds + F.wave * (16 * 72);
    constexpr int RSS = 68;
    LAS float* RS = (LAS float*)(F.lds + 18432) + F.wave * (3 * 16 * RSS);
    const bf16_t* U = F.ubuf();
    bf16x8 Xr[4][2], Xi[4][2];
    { const bf16_t* wrt = (const bf16_t*)(F.ws + WS_LRUT) + ((((size_t)li * 2 + d) * 2 + 0) * 8 + g) * 64 * 64; const bf16_t* wit = wrt + (size_t)8 * 64 * 64;
#pragma unroll
      for (int ct = 0; ct < 4; ++ct)
#pragma unroll
        for (int ks = 0; ks < 2; ++ks) { Xr[ct][ks] = *(const bf16x8*)(wrt + (ct * 16 + fr) * 64 + ks * 32 + fq * 8); Xi[ct][ks] = *(const bf16x8*)(wit + (ct * 16 + fr) * 64 + ks * 32 + fq * 8); } }
    const float* cw = F.in[I_CONVW] + (size_t)li * 4 * 512;
    const float cw0 = cw[c], cw1 = cw[512 + c], cw2 = cw[1024 + c], cw3 = cw[1536 + c], cb = F.in[I_CONVB][(size_t)li * 512 + c];
    const float brc = F.in[I_BR][((size_t)li * 2 + d) * 512 + c], bic = F.in[I_BI][((size_t)li * 2 + d) * 512 + c];
    const float lamfac = -8.0f * softplusf_(-F.in[I_LAM][((size_t)li * 2 + d) * 512 + c]);
    bf16_t* hout = (d == 0 ? F.br() : F.brx()); const int ldy = (d == 0 ? 2048 : 1024);
    const size_t rowbase = (size_t)s * LSEQ;
    float hs = 0.f;
    unsigned short px[19];
    auto lru_prefetch = [&](int t0) {
#pragma unroll
        for (int i = 0; i < 19; ++i) { int t = t0 - 2 + i; t = t < 0 ? 0 : (t > LSEQ - 1 ? LSEQ - 1 : t); px[i] = U[(rowbase + t) * N1 + U1_AX + c]; } };
    lru_prefetch((d == 0) ? 0 : LSEQ - 16);
    for (int ci = 0; ci < LSEQ / 16; ++ci) {
        const int t0 = (d == 0) ? 16 * ci : LSEQ - 16 - 16 * ci;
        { float xa[19];
#pragma unroll
          for (int i = 0; i < 19; ++i) { const int t = t0 - 2 + i; xa[i] = (t >= 0 && t < LSEQ) ? bf2f(px[i]) : 0.f; }
          if (ci + 1 < LSEQ / 16) lru_prefetch((d == 0) ? t0 + 16 : t0 - 16);
#pragma unroll
          for (int tt = 0; tt < 16; ++tt) { const float xc = cb + cw0 * xa[tt] + cw1 * xa[tt + 1] + cw2 * xa[tt + 2] + cw3 * xa[tt + 3];
            XCT[tt * 72 + lane] = f2bf(xc); RS[32 * RSS + tt * RSS + lane] = xc; } }
        { bf16x8 Y[2];
#pragma unroll
          for (int ks = 0; ks < 2; ++ks) Y[ks] = *(const LAS bf16x8*)(XCT + fr * 72 + ks * 32 + fq * 8);
#pragma unroll
          for (int ct = 0; ct < 4; ++ct) { f32x4 ar = (f32x4){0.f, 0.f, 0.f, 0.f}, ai = ar;
            ar = mfma16(Xr[ct][0], Y[0], ar); ar = mfma16(Xr[ct][1], Y[1], ar); ai = mfma16(Xi[ct][0], Y[0], ai); ai = mfma16(Xi[ct][1], Y[1], ai);
            *(LAS f32x4*)(RS + fr * RSS + ct * 16 + 4 * fq) = ar; *(LAS f32x4*)(RS + 16 * RSS + fr * RSS + ct * 16 + 4 * fq) = ai; } }
        { float av[16], bbv[16];
#pragma unroll
          for (int i = 0; i < 16; ++i) { const int tt = (d == 0) ? i : 15 - i;
            const float r = sigmoidf_(RS[tt * RSS + lane] + brc), ig = sigmoidf_(RS[16 * RSS + tt * RSS + lane] + bic), xc = RS[32 * RSS + tt * RSS + lane];
            const float a = __expf(lamfac * r); av[i] = a; bbv[i] = __builtin_amdgcn_sqrtf(fmaxf(1.0f - a * a, 0.f)) * ig * xc; }
#pragma unroll
          for (int i = 0; i < 16; ++i) { const int tt = (d == 0) ? i : 15 - i; hs = av[i] * hs + bbv[i]; hout[(rowbase + t0 + tt) * ldy + c] = f2bf(hs); } }
    }
}
__device__ __forceinline__ void lru_task(const Frame& F, int li, int s, int d) { lru_block(F, li, s, d, F.wave); __syncthreads(); }

__device__ __forceinline__ void phase_scan1(const Frame& F0, int li) {
    Frame F = F0; { size_t z_ = 0; asm volatile("" : "+v"(F.tid), "+v"(F.lane), "+s"(z_), "+s"(F.bid), "+s"(F.G), "+s"(F.wave)); F.ws = F0.ws + z_; F.out = F0.out + z_; }
    if (F.G == 256) {
        if (F.bid < 192) rwkv_task(F, li, F.bid >> 2, (F.bid >> 1) & 1, F.bid & 1);
        else {
            const int j = F.bid - 192, b0 = 12 * j + F.wave;
            lru_block(F, li, b0 >> 4, (b0 >> 3) & 1, b0 & 7);
            if (F.wave < 4) { const int b1 = 12 * j + 8 + F.wave; lru_block(F, li, b1 >> 4, (b1 >> 3) & 1, b1 & 7); }
            __syncthreads(); }
    } else {
        for (int task = F.bid; task < 288; task += F.G) {
            if (task < 192) rwkv_task(F, li, task >> 2, (task >> 1) & 1, task & 1);
            else lru_task(F, li, (task - 192) >> 1, (task - 192) & 1);
        }
    }
}

__device__ __forceinline__ void phase_post1(const Frame& F0, int li) {
    Frame F = F0; { size_t z_ = 0; asm volatile("" : "+v"(F.tid), "+v"(F.lane), "+s"(z_), "+s"(F.bid), "+s"(F.G), "+s"(F.wave)); F.ws = F0.ws + z_; F.out = F0.out + z_; }
    const int lane = F.lane, fr = lane & 15, fq = lane >> 4;
    LAS bf16_t* SG = (LAS bf16_t*)F.lds + F.wave * (16 * 136);
    const bf16_t* U = F.ubuf(); const bf16_t* G2T = (const bf16_t*)(F.ws + WS_G2T) + (size_t)li * 512 * 128;
    const float* mu = F.in[I_MU] + (size_t)li * 1920; const float* bon = (const float*)(F.ws + WS_BON);
    const float* lng = F.in[I_LNXG] + (size_t)li * 512; const float* lnb = F.in[I_LNXB] + (size_t)li * 512;
    bf16_t* BR = F.br(); const bf16_t* BRX = F.brx();
    LAS float* PM = (LAS float*)(F.lds + 40960);
    for (int i = F.tid; i < 512; i += NTHREADS) { PM[i] = mu[1024 + i]; PM[512 + i] = lng[i]; PM[1024 + i] = lnb[i]; }
    __syncthreads();
    const int gw = F.bid * NWAVES + F.wave, nw = F.G * NWAVES;
    for (int tile = gw; tile < NTOK / 16; tile += nw) {
        const int row0 = tile * 16;
#pragma unroll 4
        for (int r = 0; r < 16; ++r) { bf16_t* p = BR + (size_t)(row0 + r) * 2048 + 8 * lane; const u32x4 a = *(const u32x4*)p, b = *(const u32x4*)(BRX + (size_t)(row0 + r) * 1024 + 8 * lane);
            const unsigned aw[4] = {a.x, a.y, a.z, a.w}, bw[4] = {b.x, b.y, b.z, b.w}; unsigned o[4];
#pragma unroll
            for (int j = 0; j < 4; ++j) o[j] = pk2(bf2f((bf16_t)(aw[j] & 0xffffu)) + bf2f((bf16_t)(bw[j] & 0xffffu)), bf2f((bf16_t)(aw[j] >> 16)) + bf2f((bf16_t)(bw[j] >> 16)));
            u32x4 w; w.x = o[0]; w.y = o[1]; w.z = o[2]; w.w = o[3]; *(u32x4*)p = w; }
#pragma unroll 4
        for (int r = 0; r < 16; ++r) { const int row = row0 + r, s = row / LSEQ, t = row - s * LSEQ; const bf16_t* up = U + (size_t)row * N1 + U1_GDN + 2 * lane;
            const unsigned x0 = *(const unsigned*)up, xm = (t > 0) ? *(const unsigned*)(up - N1) : 0u, xp = (t < LSEQ - 1) ? *(const unsigned*)(up + N1) : 0u;
            const float m0 = mu[1792 + 2 * lane], m1 = mu[1793 + 2 * lane];
            const float a0 = bf2f((bf16_t)(x0 & 0xffffu)), a1 = bf2f((bf16_t)(x0 >> 16));
            const float g0 = a0 + m0 * (0.5f * (bf2f((bf16_t)(xm & 0xffffu)) + bf2f((bf16_t)(xp & 0xffffu))) - a0), g1 = a1 + m1 * (0.5f * (bf2f((bf16_t)(xm >> 16)) + bf2f((bf16_t)(xp >> 16))) - a1);
            *(LAS unsigned*)(SG + r * 136 + 2 * lane) = pk2(sigmoidf_(g0), sigmoidf_(g1)); }
        bf16x8 Y[4];
#pragma unroll
        for (int ks = 0; ks < 4; ++ks) Y[ks] = *(const LAS bf16x8*)(SG + fr * 136 + ks * 32 + fq * 8);
        const int row = row0 + fr, s = row / LSEQ, t = row - s * LSEQ;
        struct HIn { u32x2 a[4], b[4], v0[4], vm[4], vp[4]; float b0, b1; };
        auto hload = [&](int h, HIn& I) __attribute__((always_inline)) {
#pragma unroll
            for (int ct = 0; ct < 4; ++ct) { const int col = 512 + 64 * h + ct * 16 + 4 * fq; I.a[ct] = *(const u32x2*)(BR + (size_t)row * 2048 + col); I.b[ct] = *(const u32x2*)(BRX + (size_t)row * 1024 + col);
                const bf16_t* up = U + (size_t)row * N1 + U1_V + 64 * h + ct * 16 + 4 * fq;
                I.v0[ct] = *(const u32x2*)up; I.vm[ct] = *(const u32x2*)(up - ((t > 0) ? N1 : 0)); I.vp[ct] = *(const u32x2*)(up + ((t < LSEQ - 1) ? N1 : 0)); }
            I.b0 = bon[(size_t)row * 16 + h]; I.b1 = bon[(size_t)row * 16 + 8 + h]; };
        auto hcomp = [&](int h, const HIn& I) __attribute__((always_inline)) {
            f32x4 gacc[4];
#pragma unroll
            for (int ct = 0; ct < 4; ++ct) { gacc[ct] = (f32x4){0.f, 0.f, 0.f, 0.f};
#pragma unroll
                for (int ks = 0; ks < 4; ++ks) { const bf16x8 X = *(const bf16x8*)(G2T + (size_t)(64 * h + ct * 16 + fr) * 128 + ks * 32 + fq * 8); gacc[ct] = mfma16(X, Y[ks], gacc[ct]); } }
            float y[16]; float sm = 0.f;
#pragma unroll
            for (int ct = 0; ct < 4; ++ct) { const u32x2 a = I.a[ct], b = I.b[ct];
                y[4 * ct] = bf2f((bf16_t)(a.x & 0xffffu)) + bf2f((bf16_t)(b.x & 0xffffu)); y[4 * ct + 1] = bf2f((bf16_t)(a.x >> 16)) + bf2f((bf16_t)(b.x >> 16));
                y[4 * ct + 2] = bf2f((bf16_t)(a.y & 0xffffu)) + bf2f((bf16_t)(b.y & 0xffffu)); y[4 * ct + 3] = bf2f((bf16_t)(a.y >> 16)) + bf2f((bf16_t)(b.y >> 16)); }
#pragma unroll
            for (int i = 0; i < 16; ++i) sm += y[i];
            sm = rows_sum(sm);
            const float mean = sm * (1.0f / 64.0f); float q = 0.f;
#pragma unroll
            for (int i = 0; i < 16; ++i) { const float dl = y[i] - mean; q += dl * dl; }
            q = rows_sum(q);
            const float rstd = rsqrtf(q * (1.0f / 64.0f) + 64e-5f);
            const float bsum = I.b0 + I.b1;
            const unsigned mkm = (t > 0) ? 0xffffffffu : 0u, mkp = (t < LSEQ - 1) ? 0xffffffffu : 0u;
#pragma unroll
            for (int ct = 0; ct < 4; ++ct) { const int cc = 64 * h + ct * 16 + 4 * fq;
                const f32x4 pmu = *(const LAS f32x4*)(PM + cc), pg = *(const LAS f32x4*)(PM + 512 + cc), pb = *(const LAS f32x4*)(PM + 1024 + cc);
                const unsigned v0w[2] = {I.v0[ct].x, I.v0[ct].y}, vmw[2] = {I.vm[ct].x & mkm, I.vm[ct].y & mkm}, vpw[2] = {I.vp[ct].x & mkp, I.vp[ct].y & mkp}; float o[4];
#pragma unroll
                for (int e = 0; e < 4; ++e) { const int sh = (e & 1) * 16; const float x0 = bf2f((bf16_t)((v0w[e >> 1] >> sh) & 0xffffu)), xm = bf2f((bf16_t)((vmw[e >> 1] >> sh) & 0xffffu)), xp = bf2f((bf16_t)((vpw[e >> 1] >> sh) & 0xffffu));
                    const float v = x0 + pmu[e] * (0.5f * (xm + xp) - x0);
                    const float yn = (y[4 * ct + e] - mean) * rstd * pg[e] + pb[e];
                    o[e] = (yn + bsum * v) * gacc[ct][e]; }
                u32x2 w; w.x = pk2(o[0], o[1]); w.y = pk2(o[2], o[3]);
                *(u32x2*)(BR + (size_t)row * 2048 + 512 + cc) = w; } };
        HIn hN, hC;
        hload(0, hN);
#pragma unroll 1
        for (int h = 0; h < 8; ++h) { hC = hN;
            if (h + 1 < 8) hload(h + 1, hN);
            hcomp(h, hC); }
    }
    __syncthreads();
}

template <int DK>
__device__ __forceinline__ void gla_task(const Frame& F1, int li, int s, int hd, int d) {
    Frame F = F1; asm volatile("" : "+v"(F.tid), "+v"(F.lane));
    constexpr bool RET = (DK == 64); constexpr int QS = DK + 8, TS = 72, NDT = DK / 16, NKS = DK / 32;
    LAS bf16_t* QT = (LAS bf16_t*)F.lds;
    LAS bf16_t* KT = QT + 64 * QS;
    LAS bf16_t* KBT = KT + 64 * QS;
    LAS bf16_t* VT = KBT + DK * TS;
    LAS float* DEC = (LAS float*)(VT + 128 * TS);
    const int lane = F.lane, w = F.wave, fr = lane & 15, fq = lane >> 4, tid = F.tid;
    const bf16_t* U = F.ubuf();
    bf16_t* oout = (d == 0 ? F.br() : F.brx()); const int ldy = (d == 0 ? 2048 : 1024);
    const int ocol = (d == 0 ? (RET ? 1536 : 1024) : (RET ? 512 : 0)) + 128 * hd;
    const size_t rowbase = (size_t)s * LSEQ;
    const int pd = tid & 127, pg = tid >> 7;
    float lbv = 0.f, lgam = 0.f, invf = 0.f, cth = 1.f, sth = 0.f;
    if constexpr (!RET) lbv = ((const float*)(F.ws + WS_LB))[(size_t)li * 512 + 128 * hd + pd];
    else { const float gam = sigmoidf_(F.in[I_RDEC][((size_t)li * 2 + d) * 4 + hd]); lgam = __logf(gam);
           invf = expf(-(float)(tid & 31) * (9.210340371976184f / 32.0f)); cth = cosf(invf); sth = (d == 0) ? sinf(invf) : -sinf(invf); }
    f32x4 Sacc[NDT];
#pragma unroll
    for (int i = 0; i < NDT; ++i) Sacc[i] = (f32x4){0.f, 0.f, 0.f, 0.f};
    unsigned short ra[16], rb[16], rc[16];
    const int ri = tid & 31; const bool risk = (tid & 32) != 0; const int rg2 = tid >> 6;
    auto prefetch = [&](int sc) { const int nt = (sc < 32) ? 64 : 16, tau0 = 64 * sc;
        if (16 * pg < nt) { const int tb = tau0 + 16 * pg;
#pragma unroll
            for (int i = 0; i < 16; ++i) { const int t = d ? (LSEQ - 1 - (tb + i)) : (tb + i); const bf16_t* up = U + (rowbase + t) * N2 + 128 * hd + pd;
                if constexpr (!RET) { ra[i] = up[U2_CQ]; rb[i] = up[U2_CF + 512 * d]; rc[i] = up[U2_CI]; } else rc[i] = up[U2_DV]; } }
        if constexpr (RET) { if (8 * rg2 < nt) { const int tb = tau0 + 8 * rg2; const int tfirst = d ? (LSEQ - 1 - tb) : tb;
#pragma unroll
            for (int j = 0; j < 8; ++j) { const int t = d ? (tfirst - j) : (tfirst + j); const bf16_t* up = U + (rowbase + t) * N2 + (risk ? U2_DK : U2_DQ) + 64 * hd + ri; ra[j] = up[0]; rb[j] = up[32]; } } } };
    prefetch(0);
    for (int sc = 0; sc < 33; ++sc) {
        const int nt = (sc < 32) ? 64 : 16, nsub = nt >> 4, tau0 = 64 * sc;
        if (16 * pg < nt) {
            if constexpr (!RET) {
                float kk[16]; float eb = 1.0f;
#pragma unroll
                for (int i = 0; i < 16; ++i) { const float fr_ = bf2f(rb[i]), sg = sigmoidf_(fr_); const float f = lbv + (1.0f - lbv) * sg, k = (1.0f - lbv) * (1.0f - sg);
                    eb *= f; const float enb = __builtin_amdgcn_rcpf(eb); const float q = siluf_(bf2f(ra[i])) * 0.08838834764831845f;
                    QT[(16 * pg + i) * QS + pd] = f2bf(q * eb); KT[(16 * pg + i) * QS + pd] = f2bf(k * enb); kk[i] = k * enb;
                    VT[pd * TS + 16 * pg + i] = rc[i]; }
#pragma unroll
                for (int i = 0; i < 16; i += 2) *(LAS unsigned*)(KBT + pd * TS + 16 * pg + i) = pk2(kk[i] * eb, kk[i + 1] * eb);
                DEC[pg * DK + pd] = eb;
            } else {
#pragma unroll
                for (int i = 0; i < 16; ++i) VT[pd * TS + 16 * pg + i] = rc[i];
                if (pd < 64) DEC[pg * DK + pd] = __expf(16.0f * lgam);
            }
        }
        if constexpr (RET) {
            if (8 * rg2 < nt) {
                const int tb = tau0 + 8 * rg2; const int tfirst = d ? (LSEQ - 1 - tb) : tb;
                const float ang = (float)tfirst * invf; float cs = cosf(ang), sn = sinf(ang);
#pragma unroll
                for (int j = 0; j < 8; ++j) { const int tl = 8 * rg2 + j, il = tl & 15; const float x1 = bf2f(ra[j]), x2 = bf2f(rb[j]);
                    const float o1 = x1 * cs - x2 * sn, o2 = x1 * sn + x2 * cs;
                    if (!risk) { const float sc_ = __expf((float)(il + 1) * lgam); QT[tl * QS + ri] = f2bf(o1 * sc_); QT[tl * QS + ri + 32] = f2bf(o2 * sc_); }
                    else { const float s1 = 0.125f * __expf(-(float)(il + 1) * lgam), s2 = 0.125f * __expf((float)(15 - il) * lgam);
                        KT[tl * QS + ri] = f2bf(o1 * s1); KT[tl * QS + ri + 32] = f2bf(o2 * s1); KBT[ri * TS + tl] = f2bf(o1 * s2); KBT[(ri + 32) * TS + tl] = f2bf(o2 * s2); }
                    const float cn = cs * cth - sn * sth; sn = sn * cth + cs * sth; cs = cn; }
            }
        }
        if (sc + 1 < 33) prefetch(sc + 1);
        __syncthreads();
#pragma unroll 2
        for (int g = 0; g < nsub; ++g) {
            const int r0 = 16 * g;
            f32x4 aacc = (f32x4){0.f, 0.f, 0.f, 0.f};
#pragma unroll
            for (int ks = 0; ks < NKS; ++ks) { const bf16x8 X = *(const LAS bf16x8*)(KT + (r0 + fr) * QS + 32 * ks + 8 * fq), Y = *(const LAS bf16x8*)(QT + (r0 + fr) * QS + 32 * ks + 8 * fq); aacc = mfma16(X, Y, aacc); }
#pragma unroll
            for (int e = 0; e < 4; ++e) aacc[e] = (4 * fq + e <= fr) ? aacc[e] : 0.f;
            u32x4 ya; ya.x = pk2(aacc[0], aacc[1]); ya.y = pk2(aacc[2], aacc[3]); ya.z = 0u; ya.w = 0u;
            const u32x2 vv = *(const LAS u32x2*)(VT + (16 * w + fr) * TS + r0 + 4 * fq);
            u32x4 xv; xv.x = vv.x; xv.y = vv.y; xv.z = 0u; xv.w = 0u;
            f32x4 o = (f32x4){0.f, 0.f, 0.f, 0.f};
            o = mfma16(__builtin_bit_cast(bf16x8, xv), __builtin_bit_cast(bf16x8, ya), o);
#pragma unroll
            for (int ks = 0; ks < NKS; ++ks) { u32x4 xs; xs.x = pk2(Sacc[2 * ks][0], Sacc[2 * ks][1]); xs.y = pk2(Sacc[2 * ks][2], Sacc[2 * ks][3]); xs.z = pk2(Sacc[2 * ks + 1][0], Sacc[2 * ks + 1][1]); xs.w = pk2(Sacc[2 * ks + 1][2], Sacc[2 * ks + 1][3]);
                const u32x2 q0 = *(const LAS u32x2*)(QT + (r0 + fr) * QS + 32 * ks + 4 * fq), q1 = *(const LAS u32x2*)(QT + (r0 + fr) * QS + 32 * ks + 16 + 4 * fq);
                u32x4 yq; yq.x = q0.x; yq.y = q0.y; yq.z = q1.x; yq.w = q1.y;
                o = mfma16(__builtin_bit_cast(bf16x8, xs), __builtin_bit_cast(bf16x8, yq), o); }
            { const int tau = tau0 + r0 + fr, t = d ? (LSEQ - 1 - tau) : tau; u32x2 ov; ov.x = pk2(o[0], o[1]); ov.y = pk2(o[2], o[3]);
              *(u32x2*)(oout + (rowbase + t) * ldy + ocol + 16 * w + 4 * fq) = ov; }
#pragma unroll
            for (int dt = 0; dt < NDT; ++dt) { const f32x4 dc = *(const LAS f32x4*)(DEC + g * DK + 16 * dt + 4 * fq);
                const u32x2 kb = *(const LAS u32x2*)(KBT + (16 * dt + fr) * TS + r0 + 4 * fq); u32x4 xk; xk.x = kb.x; xk.y = kb.y; xk.z = 0u; xk.w = 0u;
                Sacc[dt] = mfma16(__builtin_bit_cast(bf16x8, xk), __builtin_bit_cast(bf16x8, xv), Sacc[dt] * dc); }
        }
        __syncthreads();
    }
}
__device__ __forceinline__ void phase_scan2(const Frame& F0, int li) {
    Frame F = F0; { size_t z_ = 0; asm volatile("" : "+v"(F.tid), "+v"(F.lane), "+s"(z_), "+s"(F.bid), "+s"(F.G), "+s"(F.wave)); F.ws = F0.ws + z_; F.out = F0.out + z_; }
    for (int task = F.bid; task < 768; task += F.G) {
        const int k = task % 384, s = k >> 3, hd = (k >> 1) & 3, d = k & 1;
                if (task < 384) gla_task<128>(F, li, s, hd, d); else gla_task<64>(F, li, s, hd, d);
    }
}
__device__ __forceinline__ void phase_post2(const Frame& F0, int li) {
    Frame F = F0; { size_t z_ = 0; asm volatile("" : "+v"(F.tid), "+v"(F.lane), "+s"(z_), "+s"(F.bid), "+s"(F.G), "+s"(F.wave)); F.ws = F0.ws + z_; F.out = F0.out + z_; }
    const int lane = F.lane; bf16_t* BR = F.br(); const bf16_t* BRX = F.brx();
    { unsigned* hist = (unsigned*)(F.ws + WS_HIST); for (int i = F.bid * NTHREADS + F.tid; i < 32 * 1024; i += F.G * NTHREADS) hist[i] = 0u; }
    const float* ng = F.in[I_HNG] + (size_t)li * 512 + 8 * lane;
    float g8[8];
#pragma unroll
    for (int i = 0; i < 8; ++i) g8[i] = ng[i];
    const int gw = F.bid * NWAVES + F.wave, nw = F.G * NWAVES;
    for (int row0 = gw; row0 < NTOK; row0 += 4 * nw) {
        u32x4 A[4][2], B[4][2];
#pragma unroll
        for (int j = 0; j < 4; ++j) { const int row = row0 + j * nw; if (row < NTOK) {
#pragma unroll
            for (int sec = 0; sec < 2; ++sec) { A[j][sec] = __builtin_nontemporal_load((const u32x4*)(BR + (size_t)row * 2048 + 1024 + 512 * sec + 8 * lane)); B[j][sec] = __builtin_nontemporal_load((const u32x4*)(BRX + (size_t)row * 1024 + 512 * sec + 8 * lane)); } } }
#pragma unroll
        for (int j = 0; j < 4; ++j) { const int row = row0 + j * nw; if (row < NTOK) {
#pragma unroll
            for (int sec = 0; sec < 2; ++sec) {
                const unsigned aw[4] = {A[j][sec].x, A[j][sec].y, A[j][sec].z, A[j][sec].w}, bw[4] = {B[j][sec].x, B[j][sec].y, B[j][sec].z, B[j][sec].w}; float o[8];
#pragma unroll
                for (int i = 0; i < 4; ++i) { o[2 * i] = bf2f((bf16_t)(aw[i] & 0xffffu)) + bf2f((bf16_t)(bw[i] & 0xffffu)); o[2 * i + 1] = bf2f((bf16_t)(aw[i] >> 16)) + bf2f((bf16_t)(bw[i] >> 16)); }
                float sm = 0.f;
                if (sec == 1) {
#pragma unroll
                    for (int i = 0; i < 8; ++i) sm += o[i];
                    sm += dppx(sm, 0); sm += dppx(sm, 1); sm += dppx(sm, 2); sm += dppx(sm, 3);
                    sm *= (1.0f / 128.0f); }
                float q = 0.f;
#pragma unroll
                for (int i = 0; i < 8; ++i) { o[i] -= sm; q += o[i] * o[i]; }
                q += dppx(q, 0); q += dppx(q, 1); q += dppx(q, 2); q += dppx(q, 3);
                const float rs = rsqrtf(q * (1.0f / 128.0f) + 1e-6f);
#pragma unroll
                for (int i = 0; i < 8; ++i) o[i] = o[i] * rs * (sec == 0 ? g8[i] : 1.0f);
                u32x4 wv; wv.x = pk2(o[0], o[1]); wv.y = pk2(o[2], o[3]); wv.z = pk2(o[4], o[5]); wv.w = pk2(o[6], o[7]);
                *(u32x4*)(BR + (size_t)row * 2048 + 1024 + 512 * sec + 8 * lane) = wv; } } }
    }
}

constexpr int NPL = 17, NPHASE = 1 + NLAYER * NPL;
__global__ void __launch_bounds__(NTHREADS, 2) mega(Args args) {
    extern __shared__ __attribute__((aligned(16))) unsigned char lds_raw[];
    Frame F; F.in = args.in; F.out = args.out; F.ws = args.ws; F.lds = (LAS unsigned char*)lds_raw; F.ldsg = lds_raw;
    F.tid = threadIdx.x; F.lane = F.tid & 63; F.wave = __builtin_amdgcn_readfirstlane(F.tid >> 6); F.G = gridDim.x; F.bid = blockIdx.x;
    const int lo = args.ph_lo, hi = args.ph_hi;
    const bool single = (hi - lo) > 1;
    volatile LAS unsigned* misc = (volatile LAS unsigned*)(F.lds + LDS_MISC);
    if (F.tid < 8) misc[F.tid] = 0u;
    __syncthreads();
    XcdBarrier bar; bar.bar = (unsigned*)(F.ws + WS_CTL) + CW_BAR; bar.x = 0; bar.st = misc;
    if (single) bar = xcd_barrier_post((unsigned*)(F.ws + WS_CTL) + CW_BAR, misc);
#ifndef PH_MASK
#define PH_MASK 0xFFFFFFu
#endif
#define PHON(o) (((PH_MASK) >> (o)) & 1u)
#ifndef DUP_MASK
#define DUP_MASK 0u
#endif
#define DUPN(o) (1 + (int)(((DUP_MASK) >> (o)) & 1u))
#define CJ_A1 1130
#define CJ_A2 2230
#define CJ_G  3658
#define CJ_P  4074
#define CJ_M  4096
#define IN(k) (lo <= (k) && (k) < hi)
#define SEAM(k) do { if (IN(k) && IN((k) + 1)) xcd_barrier(bar); } while (0)
    LAS unsigned char* glds = F.lds;
    if (PHON(20) && IN(0)) { phase_prep_weights(F); phase_embed(F); }
    SEAM(0);
    if (single) {
        if (F.tid == 0) { unsigned ok = ((F.G & 7) == 0) ? 1u : 0u;
            for (int j = 0; j < 16; ++j) { const unsigned cj = xb_ld(bar.bar + XB_XCNT(j)); if (j < 8 ? (cj != (unsigned)F.G / 8u) : (cj != 0u)) ok = 0u; }
            const unsigned r = misc[2]; misc[3] = (ok && bar.x < 8u && r < (unsigned)F.G / 8u) ? (r * 8u + bar.x) : (unsigned)F.bid; }
        __syncthreads();
        F.bid = __builtin_amdgcn_readfirstlane((int)misc[3]);
    }
    for (int li = 0; li < NLAYER; ++li) {
        const int pb = 1 + li * NPL;
        for (int rep = 0; rep < DUPN(0); ++rep) if (PHON(0) && IN(pb + 0)) { Frame Fq = F; { size_t z_ = 0; asm volatile("" : "+s"(z_), "+s"(Fq.bid), "+s"(Fq.G)); Fq.ws = F.ws + z_; Fq.out = F.out + z_; } const Frame& F = Fq;
            SchedPlain S; S.T.init(NTILE_M, N1 / 256, F.G, F.bid); S.A = (const char*)F.hbuf(); S.B = (const char*)(F.ws + WS_W1T + (size_t)li * N1 * D * 2); S.astep = (size_t)256 * D * 2; S.bstep = (size_t)256 * D * 2;
            EpiStoreBf16 E; E.O0 = E.O1 = E.O2 = E.O3 = F.ubuf(); E.ldo = N1;
            pg8::gemm_phase<EpiStoreBf16, SchedPlain, false>(glds, D, D, D, S, E); }
        if (PHON(0) && IN(pb + 0)) phase_prep_experts(F, li, 0, CJ_A1, NTILE_M * (N1 / 256));
        SEAM(pb + 0);
        for (int rep = 0; rep < DUPN(1); ++rep) if (PHON(1) && IN(pb + 1)) phase_scan1(F, li);
        SEAM(pb + 1);
        if (PHON(2) && IN(pb + 2)) phase_post1(F, li);
        SEAM(pb + 2);
        for (int rep = 0; rep < DUPN(3); ++rep) if (PHON(3) && IN(pb + 3)) { Frame Fq = F; { size_t z_ = 0; asm volatile("" : "+s"(z_), "+s"(Fq.bid), "+s"(Fq.G)); Fq.ws = F.ws + z_; Fq.out = F.out + z_; } const Frame& F = Fq;
            SchedPlain S; S.T.init(NTILE_M, N2 / 256, F.G, F.bid); S.A = (const char*)F.hbuf(); S.B = (const char*)(F.ws + WS_W2T + (size_t)li * N2 * D * 2); S.astep = (size_t)256 * D * 2; S.bstep = (size_t)256 * D * 2;
            EpiStoreBf16 E; E.O0 = E.O1 = E.O2 = E.O3 = F.ubuf(); E.ldo = N2;
            pg8::gemm_phase<EpiStoreBf16, SchedPlain, false>(glds, D, D, D, S, E); }
        if (PHON(3) && IN(pb + 3)) phase_prep_experts(F, li, CJ_A1, CJ_A2, NTILE_M * (N2 / 256));
        SEAM(pb + 3);
        for (int rep = 0; rep < DUPN(4); ++rep) if (PHON(4) && IN(pb + 4)) phase_scan2(F, li);
        SEAM(pb + 4);
        if (PHON(5) && IN(pb + 5)) phase_post2(F, li);
        SEAM(pb + 5);
        if (PHON(6) && IN(pb + 6)) { Frame Fq = F; { size_t z_ = 0; asm volatile("" : "+s"(z_), "+s"(Fq.bid), "+s"(Fq.G)); Fq.ws = F.ws + z_; Fq.out = F.out + z_; } const Frame& F = Fq;
            SchedPlain S; S.T.init(NTILE_M, NG / 256, F.G, F.bid); S.A = (const char*)F.hbuf(); S.B = (const char*)(F.ws + WS_WGT + (size_t)li * NG * D * 2); S.astep = (size_t)256 * D * 2; S.bstep = (size_t)256 * D * 2;
            EpiGate E; E.BR = F.br();
            pg8::gemm_phase<EpiGate, SchedPlain, false>(glds, D, D, D, S, E); }
        if (PHON(6) && IN(pb + 6)) phase_prep_experts(F, li, CJ_A2, CJ_G, NTILE_M * (NG / 256));
        SEAM(pb + 6);
        for (int rep = 0; rep < DUPN(7); ++rep) if (PHON(7) && IN(pb + 7)) { Frame Fq = F; { size_t z_ = 0; asm volatile("" : "+s"(z_), "+s"(Fq.bid), "+s"(Fq.G)); Fq.ws = F.ws + z_; Fq.out = F.out + z_; } const Frame& F = Fq;
            SchedP S; S.T.init(NTILE_M, 16, F.G, F.bid); S.A = (const char*)F.br(); S.B = (const char*)(F.ws + WS_WBT + (size_t)li * 4 * D * 512 * 2);
            EpiStoreBf16 E; E.O0 = F.pb(0); E.O1 = F.pb(1); E.O2 = F.pb(2); E.O3 = F.pb(3); E.ldo = D;
            pg8::gemm_phase<EpiStoreBf16, SchedP, false>(glds, 512, 2048, 512, S, E); }
        if (PHON(7) && IN(pb + 7)) phase_prep_experts(F, li, CJ_G, CJ_P, NTILE_M * 16);
        SEAM(pb + 7);
        for (int rep = 0; rep < DUPN(8); ++rep) if (PHON(8) && IN(pb + 8)) { Frame Fq = F; { size_t z_ = 0; asm volatile("" : "+s"(z_), "+s"(Fq.bid), "+s"(Fq.G)); Fq.ws = F.ws + z_; Fq.out = F.out + z_; } const Frame& F = Fq;
            SchedPlain S; S.T.init(NTILE_M, NM / 256, F.G, F.bid); S.A = (const char*)F.out + OUT_HIN8; S.B = (const char*)(F.ws + WS_WMT + (size_t)li * NM * D); S.astep = (size_t)256 * D; S.bstep = (size_t)256 * D;
            EpiMerge E; E.PB0 = F.pb(0); E.PB1 = F.pb(1); E.PB2 = F.pb(2); E.PB3 = F.pb(3); E.MG = (bf16_t*)(F.ws + R_MERGED);
            pg8::gemm_phase<EpiMerge, SchedPlain, false, true>(glds, D / 2, D / 2, D / 2, S, E); }
        if (PHON(8) && IN(pb + 8)) phase_prep_experts(F, li, CJ_P, CJ_M, NTILE_M * (NM / 256));
        SEAM(pb + 8);
        if (PHON(9) && IN(pb + 9) && ((F.bid & 1) == 0)) phase_prep_experts(F, li, CJ_M, NE * 384, 4 * NTILE_M);
        for (int rep = 0; rep < DUPN(9); ++rep) if (PHON(9) && IN(pb + 9)) { Frame Fq = F; { size_t z_ = 0; asm volatile("" : "+s"(z_), "+s"(Fq.bid), "+s"(Fq.G)); Fq.ws = F.ws + z_; Fq.out = F.out + z_; } const Frame& F = Fq;
            SchedPlain S; S.T.init(NTILE_M, D / 256, F.G, F.bid); S.A = (const char*)(F.ws + R_MERGED); S.B = (const char*)(F.ws + WS_WOT + (size_t)li * D * D * 2); S.astep = (size_t)256 * D * 2; S.bstep = (size_t)256 * D * 2;
            EpiOut E; E.H = F.hbuf(); E.X1 = (bf16_t*)(F.ws + R_X1);
            pg8::gemm_phase<EpiOut, SchedPlain, false>(glds, D, D, D, S, E); }
        if (PHON(9) && IN(pb + 9) && ((F.bid & 1) == 1)) phase_prep_experts(F, li, CJ_M, NE * 384, 4 * NTILE_M);
        SEAM(pb + 9);
        if (PHON(10) && IN(pb + 10)) phase_ln1_router(F, li);
        SEAM(pb + 10);
        for (int p = 1; p < 4; ++p) { if (PHON(11) && IN(pb + 10 + p)) phase_topk(F, p); SEAM(pb + 10 + p); }
        for (int rnd = 0; rnd < 1; ++rnd) {
            for (int rep = 0; rep < DUPN(15); ++rep) if (PHON(15) && IN(pb + 14 + 2 * rnd)) { Frame Fq = F; { size_t z_ = 0; asm volatile("" : "+s"(z_), "+s"(Fq.bid), "+s"(Fq.G)); Fq.ws = F.ws + z_; Fq.out = F.out + z_; } const Frame& F = Fq;
                SchedE1 S; S.T.init(NE * ETILES, 16, F.G, F.bid); S.A = (const char*)(F.ws + R_H8); S.B = (const char*)F.out + OUT_W13; S.stok = (const int*)(F.ws + WS_STOK); S.e0 = 0;
                EpiSwiglu E; E.HE = (unsigned char*)(F.ws + R_HE);
                pg8::gemm_phase<EpiSwiglu, SchedE1, true, true>(glds, D / 2, D / 2, D / 2, S, E); }
            SEAM(pb + 14 + 2 * rnd);
            for (int rep = 0; rep < DUPN(16); ++rep) if (PHON(16) && IN(pb + 15 + 2 * rnd)) { Frame Fq = F; { size_t z_ = 0; asm volatile("" : "+s"(z_), "+s"(Fq.bid), "+s"(Fq.G)); Fq.ws = F.ws + z_; Fq.out = F.out + z_; } const Frame& F = Fq;
                SchedE2 S; S.T.init(NE * ETILES, 4, F.G, F.bid); S.A = (const char*)(F.ws + R_HE); S.B = (const char*)F.out + OUT_W2; S.e0 = 0;
                EpiScale E; E.YE = (bf16_t*)(F.ws + R_YE); E.SG = (const float*)(F.ws + WS_SGATE);
                pg8::gemm_phase<EpiScale, SchedE2, false, true>(glds, DFF / 2, DFF / 2, DFF / 2, S, E); }
            SEAM(pb + 15 + 2 * rnd);
        }
        if (PHON(19) && IN(pb + 16)) phase_combine(F, li);
        SEAM(pb + 16);
    }
}

#ifndef MK_SINGLE
#define MK_SINGLE 1
#endif
extern "C" void kernel_launch(void* const* d_in, const int* in_sizes, int n_in, void* d_out, int out_size, void* d_ws, size_t ws_size, hipStream_t stream) {
    static int grid = 0;
    if (grid == 0) {
        if (n_in != 37 || in_sizes[0] != NSEQ0 * SEQ * D || out_size != NSEQ * SEQ * D || ws_size < WS_END) {
            fprintf(stderr, "kernel_launch: unexpected shapes: n_in %d in0 %d out %d ws %zu (need %zu); nothing launched\n", n_in, n_in > 0 ? in_sizes[0] : -1, out_size, ws_size, (size_t)WS_END); grid = -1; return; }
        int dev = 0, cus = 0, per_cu = 0;
        if (hipGetDevice(&dev) != hipSuccess || hipDeviceGetAttribute(&cus, hipDeviceAttributeMultiprocessorCount, dev) != hipSuccess) { grid = -1; return; }
        if (hipFuncSetAttribute((const void*)mega, hipFuncAttributeMaxDynamicSharedMemorySize, LDS_BYTES) != hipSuccess) { fprintf(stderr, "kernel_launch: hipFuncSetAttribute failed\n"); grid = -1; return; }
        if (hipOccupancyMaxActiveBlocksPerMultiprocessor(&per_cu, (const void*)mega, NTHREADS, LDS_BYTES) != hipSuccess || per_cu < 1) fprintf(stderr, "kernel_launch: occupancy query reports %d\n", per_cu);
        (void)hipGetLastError();
        grid = cus;
    }
    if (grid < 0) return;
    if (hipMemsetAsync((char*)d_ws + WS_CTL, 0, CTL_BYTES, stream) != hipSuccess) return;
    Args a{};
    for (int i = 0; i < 37; ++i) a.in[i] = (const float*)d_in[i];
    a.out = (float*)d_out; a.ws = (unsigned char*)d_ws;
#if MK_SINGLE
    a.ph_lo = 0; a.ph_hi = NPHASE;
    hipLaunchKernelGGL(mega, dim3(grid), dim3(NTHREADS), LDS_BYTES, stream, a);
#else
    for (int p = 0; p < NPHASE; ++p) { a.ph_lo = p; a.ph_hi = p + 1; hipLaunchKernelGGL(mega, dim3(grid), dim3(NTHREADS), LDS_BYTES, stream, a); }
#endif
}
```

```cpp
#include <hip/hip_runtime.h>
#include <cstdio>
#include <cstdint>
#include <cstddef>

#define LAS __attribute__((address_space(3)))
typedef unsigned short bf16_t;
typedef short bf16x8 __attribute__((ext_vector_type(8)));
typedef float f32x4 __attribute__((ext_vector_type(4)));
typedef float f32x2 __attribute__((ext_vector_type(2)));
typedef unsigned u32x4 __attribute__((ext_vector_type(4)));
typedef unsigned u32x2 __attribute__((ext_vector_type(2)));

constexpr int D = 1024, LSEQ = 2064, NSEQ = 48, NTOK = NSEQ * LSEQ, NMETA = 16, SEQ = 2048, NSEQ0 = 32, TOK0 = NSEQ0 * LSEQ;
constexpr int N_IN = 11136, NLAYER = 2;
constexpr int N1 = 2560, N2 = 3072, NG = 1536, NM = 4096;
constexpr int NE = 16, DFF = 2048, CAP0 = 8256, CAP1 = 4128, EVALID = CAP0 + CAP1, EROWS = 12544, ETILES = EROWS / 256;
constexpr int NTILE_M = NTOK / 256;
static_assert(NTOK % 256 == 0, "token tiling");
constexpr float ALPHA = 1.41421356237f;
constexpr int NTHREADS = 512, NWAVES = 8;
constexpr int LDS_BYTES = 147456;
constexpr int LDS_MISC = LDS_BYTES - 64;

constexpr int U1_AX = 0, U1_R = 512, U1_K = 1024, U1_V = 1536, U1_WDN = 2048, U1_ADN = 2176, U1_GDN = 2304;
constexpr int U2_CQ = 0, U2_CF = 512, U2_CI = 1536, U2_DQ = 2048, U2_DK = 2304, U2_DV = 2560;

constexpr size_t al256(size_t x) { return (x + 255) & ~(size_t)255; }
constexpr size_t WS_CTL = 0, CTL_BYTES = 65536;
constexpr size_t WS_AFF = WS_CTL + CTL_BYTES;
constexpr size_t WS_INV = WS_AFF + al256((size_t)NTOK * 16 * 4);
constexpr size_t WS_STOK = WS_INV + al256((size_t)NTOK * 16 * 4);
constexpr size_t WS_SGATE = WS_STOK + al256((size_t)NE * EROWS * 4);
constexpr size_t WS_HIST = WS_SGATE + al256((size_t)NE * EROWS * 4);
constexpr size_t WS_BON = WS_HIST + al256((size_t)3 * 32 * 1024 * 4);
constexpr size_t WS_G2T = WS_BON + al256((size_t)NTOK * 16 * 4);
constexpr size_t WS_LB = WS_G2T + al256((size_t)2 * 512 * 128 * 2);
constexpr size_t WS_RW2T = WS_LB + al256((size_t)2 * 512 * 4);
constexpr size_t WS_LRUT = WS_RW2T + al256((size_t)2 * 2 * 2 * 512 * 64 * 2);
constexpr size_t WS_HBUF = WS_LRUT + al256((size_t)2 * 2 * 2 * 8 * 64 * 64 * 2);
constexpr size_t WS_W1T = WS_HBUF + al256((size_t)NTOK * D * 2);
constexpr size_t WS_W2T = WS_W1T + al256((size_t)2 * N1 * D * 2);
constexpr size_t WS_WGT = WS_W2T + al256((size_t)2 * N2 * D * 2);
constexpr size_t WS_WMT = WS_WGT + al256((size_t)2 * NG * D * 2);
constexpr size_t WS_WBT = WS_WMT + al256((size_t)2 * NM * D * 2);
constexpr size_t WS_WOT = WS_WBT + al256((size_t)2 * 4 * D * 512 * 2);
constexpr size_t WS_R = WS_WOT + al256((size_t)2 * D * D * 2);
constexpr size_t SZ_TD2 = (size_t)NTOK * D * 2;
constexpr size_t R_BR = WS_R;
constexpr size_t R_U = WS_R + 2 * SZ_TD2;
constexpr size_t R_PB = R_U;
constexpr size_t R_MERGED = WS_R;
constexpr size_t R_H8 = WS_R;
constexpr size_t OUT_HIN8 = SZ_TD2;
constexpr size_t OUT_W13 = OUT_HIN8 + (size_t)NTOK * D;
constexpr size_t OUT_W2 = (size_t)NE * 4096 * D;
static_assert(OUT_W13 + (size_t)NE * 4096 * D <= (size_t)NSEQ * SEQ * D * 4, "W13t must fit in d_out");
constexpr float WM_SCALE = 32.0f;
constexpr float W13_SCALE = 32.0f, W2_SCALE = 64.0f;
constexpr size_t R_X1 = R_U;
constexpr size_t R_WEXP = WS_R;
constexpr size_t SZ_W13 = (size_t)NE * 4096 * D * 2, SZ_W2E = (size_t)NE * D * DFF * 2;
constexpr size_t R_YE = R_WEXP + SZ_W13 + SZ_W2E;
constexpr size_t SZ_YE = (size_t)NE * EROWS * D * 2;
constexpr size_t R_HE = R_YE + SZ_YE;
constexpr size_t SZ_HE = (size_t)8 * EROWS * DFF * 2;
constexpr size_t WS_END_A = R_U + (size_t)NTOK * N2 * 2;
constexpr size_t WS_END_B = R_HE + SZ_HE;
constexpr size_t WS_END = WS_END_A > WS_END_B ? WS_END_A : WS_END_B;

constexpr int CW_BAR = 0;
constexpr int CW_CNT = 4096;
constexpr int CW_TIE = 4160;

__device__ __forceinline__ float bf2f(bf16_t v) { return __uint_as_float(((unsigned)v) << 16); }
typedef __bf16 bf16n2 __attribute__((ext_vector_type(2)));
__device__ __forceinline__ unsigned pk2(float lo, float hi) { const f32x2 v = {lo, hi}; return __builtin_bit_cast(unsigned, __builtin_convertvector(v, bf16n2)); }
__device__ __forceinline__ bf16_t f2bf(float f) { return (bf16_t)(pk2(f, 0.f) & 0xffffu); }
__device__ __forceinline__ unsigned pk4_fp8(float a, float b, float c, float d) { int p = __builtin_amdgcn_cvt_pk_fp8_f32(a, b, 0, false); p = __builtin_amdgcn_cvt_pk_fp8_f32(c, d, p, true); return (unsigned)p; }
__device__ __forceinline__ float sigmoidf_(float x) { return __builtin_amdgcn_rcpf(1.0f + __expf(-x)); }
__device__ __forceinline__ float siluf_(float x) { return x * __builtin_amdgcn_rcpf(1.0f + __expf(-x)); }
__device__ __forceinline__ float gelu_tanh_(float x) { const float u = 1.5957691216f * (x + 0.044715f * x * x * x); return x * __builtin_amdgcn_rcpf(1.0f + __expf(-u)); }
__device__ __forceinline__ float softplusf_(float x) { return fmaxf(x, 0.f) + log1pf(__expf(-fabsf(x))); }
__device__ __forceinline__ float dppx(float v, int sel) {
    const int x = __float_as_int(v); int r;
    if (sel == 0) r = __builtin_amdgcn_update_dpp(0, x, 0xB1, 0xF, 0xF, true);
    else if (sel == 1) r = __builtin_amdgcn_update_dpp(0, x, 0x4E, 0xF, 0xF, true);
    else if (sel == 2) r = __builtin_amdgcn_update_dpp(0, x, 0x141, 0xF, 0xF, true);
    else r = __builtin_amdgcn_update_dpp(0, x, 0x140, 0xF, 0xF, true);
    return __int_as_float(r);
}
typedef unsigned u32x2_pl __attribute__((ext_vector_type(2)));
__device__ __forceinline__ float rows_sum(float v) {
    const unsigned x = __float_as_uint(v);
    const u32x2_pl a = __builtin_amdgcn_permlane16_swap(x, x, false, false);
    const float s = __uint_as_float(a[0]) + __uint_as_float(a[1]);
    const unsigned y = __float_as_uint(s);
    const u32x2_pl b = __builtin_amdgcn_permlane32_swap(y, y, false, false);
    return __uint_as_float(b[0]) + __uint_as_float(b[1]);
}
__device__ __forceinline__ float wave_sum(float v) {
    v += dppx(v, 0); v += dppx(v, 1); v += dppx(v, 2); v += dppx(v, 3);
    return rows_sum(v);
}

#define XB_TMO      128
#define XB_XCNT(j)  (256  + 64 * (j))
#define XB_XSUB(j)  (1280 + 64 * (j))
#define XB_XGEN(j)  (2304 + 64 * (j))
#define XB_TOP      3328
#define XB_TOPGEN   3392
#define XCD_BAR_WORDS 3456
#define XB_SPIN_CAP (1u << 23)
__device__ __forceinline__ unsigned xb_ld(unsigned* p)              { return __hip_atomic_load(p, __ATOMIC_RELAXED, __HIP_MEMORY_SCOPE_AGENT); }
__device__ __forceinline__ unsigned xb_add(unsigned* p, unsigned v) { return __hip_atomic_fetch_add(p, v, __ATOMIC_RELAXED, __HIP_MEMORY_SCOPE_AGENT); }
__device__ __forceinline__ unsigned xb_xcc_id() { return (unsigned)__builtin_amdgcn_s_getreg((3 << 11) | 20) & 0xFu; }
#define XB_SPIN(cond, bar) do { unsigned _sp = 0; while (cond) { __builtin_amdgcn_s_sleep(1); \
    if ((++_sp & 255u) == 0u) { if (xb_ld(&(bar)[XB_TMO])) break; if (_sp > XB_SPIN_CAP) { atomicAdd(&(bar)[XB_TMO], 1u); break; } } } } while (0)
struct XcdBarrier { unsigned* bar; unsigned x; volatile LAS unsigned* st; };
__device__ __forceinline__ XcdBarrier xcd_barrier_post(unsigned* bar, volatile LAS unsigned* st) {
    XcdBarrier b; b.bar = bar; b.x = xb_xcc_id(); b.st = st;
    if (threadIdx.x == 0) st[2] = xb_add(&bar[XB_XCNT(b.x)], 1u);
    return b;
}
__device__ __forceinline__ void xcd_barrier_complete(unsigned* bar, unsigned x, unsigned& nloc, unsigned& nx) {
    const unsigned G = gridDim.x * gridDim.y * gridDim.z;
    unsigned sum, cnt, mine, sp = 0u;
    for (;;) {
        sum = 0u; cnt = 0u; mine = 0u;
#pragma unroll
        for (unsigned j = 0; j < 16; ++j) { const unsigned c = xb_ld(&bar[XB_XCNT(j)]); sum += c; cnt += (c > 0u) ? 1u : 0u; mine = (j == x) ? c : mine; }
        if (sum == G) break;
        __builtin_amdgcn_s_sleep(1);
        if ((++sp & 255u) == 0u) { if (xb_ld(&bar[XB_TMO])) break; if (sp > XB_SPIN_CAP) { atomicAdd(&bar[XB_TMO], 1u); break; } }
    }
    nloc = mine > 0u ? mine : 1u; nx = cnt > 0u ? cnt : 1u;
}
__device__ __forceinline__ void xcd_barrier(const XcdBarrier& b) {
    asm volatile("s_waitcnt vmcnt(0)" ::: "memory");
    __syncthreads();
    if (threadIdx.x == 0) {
        unsigned* bar = b.bar;
        __builtin_amdgcn_s_waitcnt(0);
        unsigned nloc = b.st[0], nx = b.st[1];
        if (nloc == 0u) { xcd_barrier_complete(bar, b.x, nloc, nx); b.st[0] = nloc; b.st[1] = nx; }
        const unsigned old = xb_add(&bar[XB_XSUB(b.x)], 1u);
        const unsigned gen = old / nloc;
        if (old + 1u == (gen + 1u) * nloc) {
            __builtin_amdgcn_fence(__ATOMIC_RELEASE, "agent");
            asm volatile("s_waitcnt vmcnt(0)" ::: "memory");
            const unsigned og = xb_add(&bar[XB_TOP], 1u);
            const unsigned tg = og / nx;
            if (og + 1u == (tg + 1u) * nx) xb_add(&bar[XB_TOPGEN], 1u);
            else XB_SPIN(xb_ld(&bar[XB_TOPGEN]) == tg, bar);
            __builtin_amdgcn_fence(__ATOMIC_ACQUIRE, "agent");
            xb_add(&bar[XB_XGEN(b.x)], 1u);
            asm volatile("s_waitcnt vmcnt(0)" ::: "memory");
        } else {
            XB_SPIN(xb_ld(&bar[XB_XGEN(b.x)]) == gen, bar);
            __builtin_amdgcn_fence(__ATOMIC_ACQUIRE, "agent");
            asm volatile("s_waitcnt vmcnt(0)" ::: "memory");
        }
    }
    __syncthreads();
}

namespace pg8 {
constexpr int BM = 256, BK = 64, HALF = 128, HTB = HALF * BK * 2, STAGE_BYTES = 8 * HTB, NXCD = 8, WGM = 8;
__host__ __device__ __forceinline__ int lds_byte(int r, int c) { const int st = (r >> 4) * 2 + (c >> 5), rr = r & 15, cc = c & 31, ob = rr * 64 + cc * 2; return st * 1024 + (ob ^ (((ob >> 9) & 1) << 5)); }
__host__ __device__ __forceinline__ void stage_rc(int b, int& R, int& C) { const int st = b / 1024, sb = b % 1024, swz = sb ^ (((sb >> 9) & 1) << 5); R = (st >> 1) * 16 + swz / 64; C = (st & 1) * 32 + (swz % 64) / 2; }
__host__ __device__ __forceinline__ int perm32(int rho) { const int n = rho >> 4, i = rho & 15; return 8 * (i >> 2) + 4 * n + (i & 3); }

struct Unit { int pm, pn, aux; const char* A; const char* B; const int* rows; };

struct TileOrder {
    int nM, nN, nwg, G, c;
    __device__ __forceinline__ void init(int nM_, int nN_, int G_, int c_) { nM = nM_; nN = nN_; nwg = nM * nN; G = G_; c = c_; }
    __device__ __forceinline__ bool tile(int i, int& pm, int& pn) const {
        const long L = (long)i * G + c; if (L >= nwg) return false;
        int wgid = (int)L; { const int q = nwg / NXCD, r = nwg % NXCD, xcd = wgid % NXCD, off = wgid / NXCD; wgid = (xcd < r ? xcd * (q + 1) : r * (q + 1) + (xcd - r) * q) + off; }
        const int nig = WGM * nN, gid = wgid / nig, fm = gid * WGM, gsz = (nM - fm) < WGM ? (nM - fm) : WGM;
        pm = fm + ((wgid % nig) % gsz); pn = (wgid % nig) / gsz; return true;
    }
};

typedef int i32x4_ __attribute__((ext_vector_type(4)));
typedef int i32x8_ __attribute__((ext_vector_type(8)));
__device__ __forceinline__ i32x8_ cat8(bf16x8 a, bf16x8 b) { const i32x4_ x = __builtin_bit_cast(i32x4_, a), y = __builtin_bit_cast(i32x4_, b); return __builtin_shufflevector(x, y, 0, 1, 2, 3, 4, 5, 6, 7); }
template <class Epi, class Sched, bool GATHER, bool F8 = false>
__device__ __forceinline__ void gemm_phase(LAS unsigned char* lds, const int K, const int lda, const int ldb, const Sched& S, const Epi& E) {
    int tid = threadIdx.x; asm volatile("" : "+v"(tid));
    const int wid = __builtin_amdgcn_readfirstlane(tid >> 6), lane = tid & 63, wr = wid >> 2, wc = wid & 3, fr = lane & 15, fq = lane >> 4;
    const int nt = K / BK;
    unsigned voffA[2][2], nvA[2][2], voffB[2];
#pragma unroll
    for (int i = 0; i < 2; ++i) { int R, C; stage_rc(tid * 16 + i * 8192, R, C); const int Rb = Epi::PERM ? ((R & ~31) + perm32(R & 31)) : R;
        voffB[i] = (unsigned)(Rb * ldb + C) * 2u;
#pragma unroll
        for (int h = 0; h < 2; ++h) { voffA[h][i] = (unsigned)((R + h * HALF) * lda + C) * 2u; nvA[h][i] = voffA[h][i]; } }
    const size_t kstep = (size_t)(BK * 2);
    const size_t hstepB = (size_t)HALF * ldb * 2;
    const unsigned ldsw = (unsigned)wid * 1024u;
    const int aoff = lds_byte(wr * 64 + fr, fq * 8), boff = lds_byte(wc * 32 + fr, fq * 8);
#define PG8_SA(b, h) (((b) * 2 + (h)) * HTB)
#define PG8_SB(b, h) ((4 + (b) * 2 + (h)) * HTB)
#define PG8_STAGE(bufoff, gbase, voff) do { _Pragma("unroll") for (int _i = 0; _i < 2; ++_i) \
        __builtin_amdgcn_global_load_lds((const unsigned*)((const char*)(gbase) + (voff)[_i]), (LAS unsigned*)(lds + (bufoff) + ldsw + _i * 8192), 16, 0, 0); } while (0)
#define PG8_LDA(dst, b, h) do { _Pragma("unroll") for (int m = 0; m < 4; ++m) { if constexpr (F8) { const i32x4_ lo_ = *(const LAS i32x4_*)(lds + PG8_SA(b, h) + aoff + m * 2048), hi_ = *(const LAS i32x4_*)(lds + PG8_SA(b, h) + aoff + m * 2048 + 1024); \
            dst##8[m] = __builtin_shufflevector(lo_, hi_, 0, 1, 2, 3, 4, 5, 6, 7); } else { _Pragma("unroll") for (int k = 0; k < 2; ++k) dst[m][k] = *(const LAS bf16x8*)(lds + PG8_SA(b, h) + aoff + m * 2048 + k * 1024); } } } while (0)
#define PG8_LDB(dst, b, h) do { _Pragma("unroll") for (int n = 0; n < 2; ++n) { if constexpr (F8) { const i32x4_ lo_ = *(const LAS i32x4_*)(lds + PG8_SB(b, h) + boff + n * 2048), hi_ = *(const LAS i32x4_*)(lds + PG8_SB(b, h) + boff + n * 2048 + 1024); \
            dst##8[n] = __builtin_shufflevector(lo_, hi_, 0, 1, 2, 3, 4, 5, 6, 7); } else { _Pragma("unroll") for (int k = 0; k < 2; ++k) dst[n][k] = *(const LAS bf16x8*)(lds + PG8_SB(b, h) + boff + n * 2048 + k * 1024); } } } while (0)
#define PG8_MMA(ai, bj, At, Bt) do { __builtin_amdgcn_s_setprio(1); _Pragma("unroll") for (int m = 0; m < 4; ++m) _Pragma("unroll") for (int n = 0; n < 2; ++n) { \
        if constexpr (F8) asm volatile("v_mfma_scale_f32_16x16x128_f8f6f4 %0, %1, %2, %0, %3, %3 op_sel_hi:[0,0,0]" : "+v"(acc[ai][bj][m][n]) : "v"(Bt##8[n]), "v"(At##8[m]), "v"(f8scale));   \
        else { _Pragma("unroll") for (int k = 0; k < 2; ++k) acc[ai][bj][m][n] = __builtin_amdgcn_mfma_f32_16x16x32_bf16(Bt[n][k], At[m][k], acc[ai][bj][m][n], 0, 0, 0); } } \
        __builtin_amdgcn_s_setprio(0); } while (0)
#define PG8_WAIT_V(n) asm volatile("s_waitcnt vmcnt(" #n ")" ::: "memory")
#define PG8_WAIT_L(n) asm volatile("s_waitcnt lgkmcnt(" #n ")" ::: "memory")
#define PG8_BAR __builtin_amdgcn_s_barrier()
#define PG8_SCHED __builtin_amdgcn_sched_barrier(0)
#define PG8_GATHER(dst, u) do { if constexpr (GATHER) { _Pragma("unroll") for (int _i = 0; _i < 2; ++_i) { int _R, _C; stage_rc(tid * 16 + _i * 8192, _R, _C); _Pragma("unroll") for (int _h = 0; _h < 2; ++_h) \
        dst[_h][_i] = ((unsigned)(u).rows[_R + _h * HALF] * (unsigned)lda + (unsigned)_C) * 2u; } } } while (0)
#define PG8_GATHER_LD(dst, u) do { _Pragma("unroll") for (int _i = 0; _i < 2; ++_i) { int _R, _C; stage_rc(tid * 16 + _i * 8192, _R, _C); _Pragma("unroll") for (int _h = 0; _h < 2; ++_h) dst[_h][_i] = (unsigned)(u).rows[_R + _h * HALF]; } } while (0)
#define PG8_GATHER_CV(dst, srcv) do { _Pragma("unroll") for (int _i = 0; _i < 2; ++_i) { int _R, _C; stage_rc(tid * 16 + _i * 8192, _R, _C); _Pragma("unroll") for (int _h = 0; _h < 2; ++_h) dst[_h][_i] = (srcv[_h][_i] * (unsigned)lda + (unsigned)_C) * 2u; } } while (0)
    Unit cur, nxt; int ui = 0;
    if (!S.next(0, cur)) return;
    f32x4 acc[2][2][4][2];
#pragma unroll
    for (int a = 0; a < 2; ++a)
#pragma unroll
        for (int b = 0; b < 2; ++b)
#pragma unroll
            for (int m = 0; m < 4; ++m)
#pragma unroll
                for (int n = 0; n < 2; ++n) acc[a][b][m][n] = (f32x4){0.f, 0.f, 0.f, 0.f};
    bf16x8 At[4][2], B0[2][2], B1[2][2];
    const int f8scale = 0x7f7f7f7f;
    i32x8_ At8[4], B08[2], B18[2];
    const char* cA = cur.A; const char* cB = cur.B;
    PG8_GATHER(voffA, cur);
    unsigned raw1[2][2];
    if constexpr (GATHER) { Unit n1; if (S.next(1, n1)) { PG8_GATHER_LD(raw1, n1); } }
    PG8_STAGE(PG8_SB(0, 0), cB, voffB); PG8_STAGE(PG8_SA(0, 0), cA, voffA[0]); PG8_STAGE(PG8_SB(0, 1), cB + hstepB, voffB); PG8_STAGE(PG8_SA(0, 1), cA, voffA[1]);
    if (wr == 1) PG8_BAR;
    PG8_WAIT_V(4); PG8_BAR;
    PG8_STAGE(PG8_SB(1, 0), cB + kstep, voffB); PG8_STAGE(PG8_SA(1, 0), cA + kstep, voffA[0]); PG8_STAGE(PG8_SB(1, 1), cB + hstepB + kstep, voffB);
    PG8_WAIT_V(6); PG8_BAR;
    for (;;) {
        const bool has_next = S.next(ui + 1, nxt);
        const char* nA = has_next ? nxt.A : cA; const char* nB = has_next ? nxt.B : cB;
        if constexpr (GATHER) {
            if (has_next) { PG8_GATHER_CV(nvA, raw1); } else {
#pragma unroll
            for (int h = 0; h < 2; ++h)
#pragma unroll
                for (int i = 0; i < 2; ++i) nvA[h][i] = voffA[h][i]; }
            { Unit n2; if (S.next(ui + 2, n2)) { PG8_GATHER_LD(raw1, n2); } } }
        for (int t = 0; t < nt; t += 2) {
            const bool last = (t == nt - 2);
            const char* a1 = cA + (size_t)(t + 1) * kstep;
            const char* a2 = last ? nA : cA + (size_t)(t + 2) * kstep; const char* b2 = last ? nB : cB + (size_t)(t + 2) * kstep;
            const char* a3 = a2 + kstep; const char* b3 = b2 + kstep;
            unsigned vA0[2], vA1[2];
            if constexpr (GATHER) { vA0[0] = last ? nvA[0][0] : voffA[0][0]; vA0[1] = last ? nvA[0][1] : voffA[0][1]; vA1[0] = last ? nvA[1][0] : voffA[1][0]; vA1[1] = last ? nvA[1][1] : voffA[1][1]; }
            else { vA0[0] = voffA[0][0]; vA0[1] = voffA[0][1]; vA1[0] = voffA[1][0]; vA1[1] = voffA[1][1]; }
            PG8_LDB(B0, 0, 0); PG8_SCHED; PG8_LDA(At, 0, 0); PG8_STAGE(PG8_SA(1, 1), a1, voffA[1]);
            PG8_WAIT_L(8); PG8_BAR; PG8_WAIT_L(0); PG8_MMA(0, 0, At, B0); PG8_BAR; PG8_SCHED;
            PG8_LDB(B1, 0, 1); PG8_STAGE(PG8_SB(0, 0), b2, voffB);
            PG8_BAR; PG8_WAIT_L(0); PG8_MMA(0, 1, At, B1); PG8_BAR;
            PG8_LDA(At, 0, 1); PG8_STAGE(PG8_SA(0, 0), a2, vA0);
            PG8_BAR; PG8_WAIT_L(0); PG8_MMA(1, 0, At, B0); PG8_BAR; PG8_SCHED;
            PG8_STAGE(PG8_SB(0, 1), b2 + hstepB, voffB);
            PG8_WAIT_V(6); PG8_BAR; PG8_MMA(1, 1, At, B1); PG8_BAR;
            PG8_LDB(B0, 1, 0); PG8_SCHED; PG8_LDA(At, 1, 0); PG8_STAGE(PG8_SA(0, 1), a2, vA1);
            PG8_WAIT_L(8); PG8_BAR; PG8_WAIT_L(0); PG8_MMA(0, 0, At, B0); PG8_BAR; PG8_SCHED;
            PG8_LDB(B1, 1, 1); PG8_STAGE(PG8_SB(1, 0), b3, voffB);
            PG8_BAR; PG8_WAIT_L(0); PG8_MMA(0, 1, At, B1); PG8_BAR;
            PG8_LDA(At, 1, 1); PG8_STAGE(PG8_SA(1, 0), a3, vA0);
            PG8_BAR; PG8_WAIT_L(0); PG8_MMA(1, 0, At, B0); PG8_BAR; PG8_SCHED;
            PG8_STAGE(PG8_SB(1, 1), b3 + hstepB, voffB);
            PG8_WAIT_V(6); PG8_BAR; PG8_MMA(1, 1, At, B1); PG8_BAR;
        }
        if constexpr (F8) asm volatile("s_nop 15\n\ts_nop 7" ::: "memory");
        { int tl_e = (int)threadIdx.x; asm volatile("" : "+v"(tl_e));
          const int fr_e = tl_e & 15, fq_e = (tl_e >> 4) & 3;
          E(acc, cur, wr, wc, fr_e, fq_e); }
        if (!has_next) break;
#pragma unroll
        for (int a = 0; a < 2; ++a)
#pragma unroll
            for (int b = 0; b < 2; ++b)
#pragma unroll
                for (int m = 0; m < 4; ++m)
#pragma unroll
                    for (int n = 0; n < 2; ++n) acc[a][b][m][n] = (f32x4){0.f, 0.f, 0.f, 0.f};
        cur = nxt; cA = nA; cB = nB; ++ui;
        if constexpr (GATHER) {
#pragma unroll
            for (int h = 0; h < 2; ++h)
#pragma unroll
                for (int i = 0; i < 2; ++i) voffA[h][i] = nvA[h][i]; }
    }
    PG8_WAIT_V(0);
    if (wr == 0) PG8_BAR;
    PG8_BAR;
#undef PG8_SA
#undef PG8_SB
#undef PG8_STAGE
#undef PG8_LDA
#undef PG8_LDB
#undef PG8_MMA
#undef PG8_WAIT_V
#undef PG8_WAIT_L
#undef PG8_BAR
#undef PG8_SCHED
#undef PG8_GATHER
#undef PG8_GATHER_LD
#undef PG8_GATHER_CV
}
}
using pg8::Unit;

struct Args { const float* in[37]; float* out; unsigned char* ws; int ph_lo, ph_hi; };
enum { I_XP = 0, I_XS, I_META, I_LNEG, I_LNEB, I_HLB, I_WIN, I_CONVW, I_CONVB, I_WR, I_BR, I_WI, I_BI, I_LAM, I_MU, I_W0, I_W2, I_A0, I_A2, I_G2, I_KK, I_KA, I_RK,
       I_LNXG, I_LNXB, I_HNG, I_RDEC, I_WBR, I_WOUT, I_LN1G, I_LN1B, I_ROUTER, I_EW1, I_EW3, I_EW2, I_LN2G, I_LN2B };
struct Frame {
    const float* const* in; float* out; unsigned char* ws; LAS unsigned char* lds; unsigned char* ldsg;
    int tid, lane, wave, G, bid;
    __device__ __forceinline__ bf16_t* hbuf() const { return (bf16_t*)(ws + WS_HBUF); }
    __device__ __forceinline__ bf16_t* br() const { return (bf16_t*)(ws + R_BR); }
    __device__ __forceinline__ bf16_t* brx() const { return (bf16_t*)out; }
    __device__ __forceinline__ bf16_t* ubuf() const { return (bf16_t*)(ws + R_U); }
    __device__ __forceinline__ bf16_t* pb(int n) const { return n < 3 ? (bf16_t*)(ws + R_PB + (size_t)n * SZ_TD2) : (bf16_t*)out; }
};

struct SchedPlain {
    pg8::TileOrder T; const char* A; const char* B; size_t astep, bstep;
    __device__ __forceinline__ bool next(int i, Unit& u) const { int pm, pn; if (!T.tile(i, pm, pn)) return false; u.pm = pm; u.pn = pn; u.aux = 0; u.A = A + (size_t)pm * astep; u.B = B + (size_t)pn * bstep; u.rows = nullptr; return true; }
};
struct SchedP {
    pg8::TileOrder T; const char* A; const char* B;
    __device__ __forceinline__ bool next(int i, Unit& u) const { int pm, pn; if (!T.tile(i, pm, pn)) return false; const int nb = pn >> 2, pl = pn & 3; u.pm = pm; u.pn = pl; u.aux = nb;
        u.A = A + (size_t)pm * 256 * 2048 * 2 + (size_t)nb * 512 * 2; u.B = B + (size_t)nb * 1024 * 512 * 2 + (size_t)pl * 256 * 512 * 2; u.rows = nullptr; return true; }
};
struct SchedE1 {
    pg8::TileOrder T; const char* A; const char* B; const int* stok; int e0;
    __device__ __forceinline__ bool next(int i, Unit& u) const { int pm, pn; if (!T.tile(i, pm, pn)) return false; const int el = pm / ETILES, pl = pm - el * ETILES, e = e0 + el; u.pm = pl; u.pn = pn; u.aux = el;
        u.A = A; u.B = B + (size_t)e * 4096 * D + (size_t)pn * 256 * D; u.rows = stok + (size_t)e * EROWS + pl * 256; return true; }
};
struct SchedE2 {
    pg8::TileOrder T; const char* A; const char* B; int e0;
    __device__ __forceinline__ bool next(int i, Unit& u) const { int pm, pn; if (!T.tile(i, pm, pn)) return false; const int el = pm / ETILES, pl = pm - el * ETILES, e = e0 + el; u.pm = pl; u.pn = pn; u.aux = e;
        u.A = A + ((size_t)el * EROWS + (size_t)pl * 256) * DFF; u.B = B + (size_t)e * D * DFF + (size_t)pn * 256 * DFF; u.rows = nullptr; return true; }
};

#define EPI_LOOP_AM _Pragma("unroll") for (int ai = 0; ai < 2; ++ai) _Pragma("unroll") for (int m = 0; m < 4; ++m)
struct EpiStoreBf16 {
    static constexpr bool PERM = true;
    bf16_t* O0; bf16_t* O1; bf16_t* O2; bf16_t* O3; int ldo;
    __device__ __forceinline__ void operator()(const f32x4 (&acc)[2][2][4][2], const Unit& u, int wr, int wc, int fr, int fq) const {
        bf16_t* base = (u.aux == 0) ? O0 : ((u.aux == 1) ? O1 : ((u.aux == 2) ? O2 : O3));
        const int row0 = u.pm * 256 + wr * 64 + fr, col0 = u.pn * 256 + wc * 32 + 8 * fq;
        EPI_LOOP_AM { bf16_t* rowp = base + (size_t)(row0 + ai * 128 + m * 16) * ldo + col0;
#pragma unroll
            for (int bj = 0; bj < 2; ++bj) { const f32x4 v0 = acc[ai][bj][m][0], v1 = acc[ai][bj][m][1];
                u32x4 w; w.x = pk2(v0[0], v0[1]); w.y = pk2(v0[2], v0[3]); w.z = pk2(v1[0], v1[1]); w.w = pk2(v1[2], v1[3]);
                *(u32x4*)(rowp + bj * 128) = w; } }
    }
};
struct EpiGate {
    static constexpr bool PERM = true;
    bf16_t* BR;
    __device__ __forceinline__ void operator()(const f32x4 (&acc)[2][2][4][2], const Unit& u, int wr, int wc, int fr, int fq) const {
        const int sec = u.pn >> 1;
        const int cbase = (sec == 0 ? 0 : (sec == 1 ? 1024 : 1536)) + (u.pn & 1) * 256 + wc * 32 + 8 * fq;
        const int row0 = u.pm * 256 + wr * 64 + fr;
        u32x4 xv[2][4][2];
        EPI_LOOP_AM { const bf16_t* rowp = BR + (size_t)(row0 + ai * 128 + m * 16) * 2048 + cbase; xv[ai][m][0] = *(const u32x4*)rowp; xv[ai][m][1] = *(const u32x4*)(rowp + 128); }
        EPI_LOOP_AM { bf16_t* rowp = BR + (size_t)(row0 + ai * 128 + m * 16) * 2048 + cbase;
#pragma unroll
            for (int bj = 0; bj < 2; ++bj) {
                const u32x4 x = xv[ai][m][bj];
                float g[8];
#pragma unroll
                for (int j = 0; j < 4; ++j) { g[j] = acc[ai][bj][m][0][j]; g[4 + j] = acc[ai][bj][m][1][j]; }
#pragma unroll
                for (int j = 0; j < 8; ++j) g[j] = (sec == 0) ? gelu_tanh_(g[j]) : siluf_(g[j]);
                const unsigned xs[4] = {x.x, x.y, x.z, x.w}; unsigned ws_[4];
#pragma unroll
                for (int j = 0; j < 4; ++j) ws_[j] = pk2(bf2f((bf16_t)(xs[j] & 0xffffu)) * g[2 * j], bf2f((bf16_t)(xs[j] >> 16)) * g[2 * j + 1]);
                u32x4 w; w.x = ws_[0]; w.y = ws_[1]; w.z = ws_[2]; w.w = ws_[3];
                *(u32x4*)(rowp + bj * 128) = w; } }
    }
};
struct EpiMerge {
    static constexpr bool PERM = false;
    const bf16_t* PB0; const bf16_t* PB1; const bf16_t* PB2; const bf16_t* PB3; bf16_t* MG;
    __device__ __forceinline__ void operator()(const f32x4 (&acc)[2][2][4][2], const Unit& u, int wr, int wc, int fr, int fq) const {
        const int row0 = u.pm * 256 + wr * 64 + fr, d0 = u.pn * 64 + wc * 16 + 4 * fq;
        u32x2 pbv[2][4][4];
        EPI_LOOP_AM { const size_t off = (size_t)(row0 + ai * 128 + m * 16) * D + d0;
            pbv[ai][m][0] = *(const u32x2*)(PB0 + off); pbv[ai][m][1] = *(const u32x2*)(PB1 + off); pbv[ai][m][2] = *(const u32x2*)(PB2 + off); pbv[ai][m][3] = *(const u32x2*)(PB3 + off); }
        EPI_LOOP_AM { const size_t off = (size_t)(row0 + ai * 128 + m * 16) * D + d0;
            float s[4] = {0.f, 0.f, 0.f, 0.f};
#pragma unroll
            for (int bj = 0; bj < 2; ++bj)
#pragma unroll
                for (int n = 0; n < 2; ++n) { const u32x2 p = pbv[ai][m][2 * bj + n]; const f32x4 a = acc[ai][bj][m][n];
                    constexpr float IS = 1.0f / WM_SCALE;
                    s[0] += sigmoidf_(a[0] * IS) * bf2f((bf16_t)(p.x & 0xffffu)); s[1] += sigmoidf_(a[1] * IS) * bf2f((bf16_t)(p.x >> 16));
                    s[2] += sigmoidf_(a[2] * IS) * bf2f((bf16_t)(p.y & 0xffffu)); s[3] += sigmoidf_(a[3] * IS) * bf2f((bf16_t)(p.y >> 16)); }
            u32x2 w; w.x = pk2(s[0], s[1]); w.y = pk2(s[2], s[3]);
            *(u32x2*)(MG + off) = w; }
    }
};
struct EpiOut {
    static constexpr bool PERM = true;
    const bf16_t* H; bf16_t* X1;
    __device__ __forceinline__ void operator()(const f32x4 (&acc)[2][2][4][2], const Unit& u, int wr, int wc, int fr, int fq) const {
        const int row0 = u.pm * 256 + wr * 64 + fr, col0 = u.pn * 256 + wc * 32 + 8 * fq;
        u32x4 hv[2][4][2];
        EPI_LOOP_AM { const size_t off = (size_t)(row0 + ai * 128 + m * 16) * D + col0; hv[ai][m][0] = *(const u32x4*)(H + off); hv[ai][m][1] = *(const u32x4*)(H + off + 128); }
        EPI_LOOP_AM { const size_t off = (size_t)(row0 + ai * 128 + m * 16) * D + col0;
#pragma unroll
            for (int bj = 0; bj < 2; ++bj) { const u32x4 p = hv[ai][m][bj]; const f32x4 a0 = acc[ai][bj][m][0], a1 = acc[ai][bj][m][1];
                u32x4 w;
                w.x = pk2(ALPHA * bf2f((bf16_t)(p.x & 0xffffu)) + a0[0], ALPHA * bf2f((bf16_t)(p.x >> 16)) + a0[1]);
                w.y = pk2(ALPHA * bf2f((bf16_t)(p.y & 0xffffu)) + a0[2], ALPHA * bf2f((bf16_t)(p.y >> 16)) + a0[3]);
                w.z = pk2(ALPHA * bf2f((bf16_t)(p.z & 0xffffu)) + a1[0], ALPHA * bf2f((bf16_t)(p.z >> 16)) + a1[1]);
                w.w = pk2(ALPHA * bf2f((bf16_t)(p.w & 0xffffu)) + a1[2], ALPHA * bf2f((bf16_t)(p.w >> 16)) + a1[3]);
                *(u32x4*)(X1 + off + bj * 128) = w; } }
    }
};
struct EpiSwiglu {
    static constexpr bool PERM = true;
    unsigned char* HE;
    __device__ __forceinline__ void operator()(const f32x4 (&acc)[2][2][4][2], const Unit& u, int wr, int wc, int fr, int fq) const {
        const int row0 = u.pm * 256 + wr * 64 + fr, col0 = u.pn * 128 + wc * 32 + 8 * fq;
        unsigned char* base = HE + (size_t)u.aux * EROWS * DFF;
        constexpr float IS = 1.0f / W13_SCALE;
        EPI_LOOP_AM { unsigned char* rowp = base + (size_t)(row0 + ai * 128 + m * 16) * DFF + col0;
            float h[8];
#pragma unroll
            for (int n = 0; n < 2; ++n)
#pragma unroll
                for (int j = 0; j < 4; ++j) h[4 * n + j] = siluf_(acc[ai][0][m][n][j] * IS) * (acc[ai][1][m][n][j] * IS);
            u32x2 w; w.x = pk4_fp8(h[0], h[1], h[2], h[3]); w.y = pk4_fp8(h[4], h[5], h[6], h[7]);
            *(u32x2*)rowp = w; }
    }
};
struct EpiScale {
    static constexpr bool PERM = true;
    bf16_t* YE; const float* SG;
    __device__ __forceinline__ void operator()(const f32x4 (&acc)[2][2][4][2], const Unit& u, int wr, int wc, int fr, int fq) const {
        const int row0 = u.pm * 256 + wr * 64 + fr, col0 = u.pn * 256 + wc * 32 + 8 * fq;
        bf16_t* base = YE + (size_t)u.aux * EROWS * D; const float* sg = SG + (size_t)u.aux * EROWS;
        float gv[2][4];
        EPI_LOOP_AM { gv[ai][m] = sg[row0 + ai * 128 + m * 16]; }
        EPI_LOOP_AM { const int row = row0 + ai * 128 + m * 16; const float g = gv[ai][m] * (1.0f / W2_SCALE); bf16_t* rowp = base + (size_t)row * D + col0;
#pragma unroll
            for (int bj = 0; bj < 2; ++bj) { const f32x4 v0 = acc[ai][bj][m][0] * g, v1 = acc[ai][bj][m][1] * g;
                u32x4 w; w.x = pk2(v0[0], v0[1]); w.y = pk2(v0[2], v0[3]); w.z = pk2(v1[0], v1[1]); w.w = pk2(v1[2], v1[3]);
                *(u32x4*)(rowp + bj * 128) = w; } }
    }
};

template <class ColMap>
__device__ __forceinline__ void tr_tile(const Frame& F, const float* src, size_t ld_src, bf16_t* dst, size_t ldd, int n0, int k0, const ColMap& cm) {
    LAS float* tile = (LAS float*)F.lds;
    const int a = F.tid >> 6, b = F.tid & 63;
    const int col = cm(n0 + b);
#pragma unroll
    for (int j = 0; j < 8; ++j) { const int kk = a + 8 * j; tile[b * 65 + kk] = (col >= 0) ? src[(size_t)(k0 + kk) * ld_src + col] : 0.f; }
    __syncthreads();
#pragma unroll
    for (int j = 0; j < 8; ++j) { const int nn = a + 8 * j; dst[(size_t)(n0 + nn) * ldd + k0 + b] = f2bf(tile[nn * 65 + b]); }
    __syncthreads();
}
template <class ColMap>
__device__ __forceinline__ void tr_strip(const Frame& F, const float* src, size_t ld_src, bf16_t* dst, size_t ldd, int n0, int k0, const ColMap& cm) {
    LAS float* tile = (LAS float*)F.lds;
    const int a = F.tid >> 6, b = F.tid & 63;
    const int col = cm(n0 + b);
    float v[32];
#pragma unroll
    for (int j = 0; j < 32; ++j) v[j] = (col >= 0) ? src[(size_t)(k0 + a + 8 * j) * ld_src + col] : 0.f;
#pragma unroll
    for (int j = 0; j < 32; ++j) tile[b * 257 + a + 8 * j] = v[j];
    __syncthreads();
#pragma unroll
    for (int j = 0; j < 8; ++j) { const int nn = a + 8 * j;
#pragma unroll
        for (int m = 0; m < 2; ++m) { const int kk = 2 * b + 128 * m; *(unsigned*)(dst + (size_t)(n0 + nn) * ldd + k0 + kk) = pk2(tile[nn * 257 + kk], tile[nn * 257 + kk + 1]); } }
    __syncthreads();
}
template <class ColMap>
__device__ __forceinline__ void tr_strip8m(const Frame& F, const float* src, size_t ld_src, unsigned char* dst, size_t ldd, int n0, int k0, const ColMap& cm, float scale) {
    LAS float* tile = (LAS float*)F.lds;
    const int a = F.tid >> 6, b = F.tid & 63; const int col = cm(n0 + b);
    float v[32];
#pragma unroll
    for (int j = 0; j < 32; ++j) v[j] = src[(size_t)(k0 + a + 8 * j) * ld_src + col];
#pragma unroll
    for (int j = 0; j < 32; ++j) tile[b * 257 + a + 8 * j] = v[j] * scale;
    __syncthreads();
#pragma unroll
    for (int j = 0; j < 8; ++j) { const int nn = a + 8 * j; const LAS float* tp = tile + nn * 257 + 4 * b;
        *(unsigned*)(dst + (size_t)(n0 + nn) * ldd + k0 + 4 * b) = pk4_fp8(tp[0], tp[1], tp[2], tp[3]); }
    __syncthreads();
}
__device__ __forceinline__ void tr_strip8(const Frame& F, const float* src, size_t ld_src, unsigned char* dst, size_t ldd, int n0, int k0, int coff, float scale) {
    LAS float* tile = (LAS float*)F.lds;
    const int a = F.tid >> 6, b = F.tid & 63;
    float v[32];
#pragma unroll
    for (int j = 0; j < 32; ++j) v[j] = src[(size_t)(k0 + a + 8 * j) * ld_src + coff + n0 + b];
#pragma unroll
    for (int j = 0; j < 32; ++j) tile[b * 257 + a + 8 * j] = v[j] * scale;
    __syncthreads();
#pragma unroll
    for (int j = 0; j < 8; ++j) { const int nn = a + 8 * j; const LAS float* tp = tile + nn * 257 + 4 * b;
        *(unsigned*)(dst + (size_t)(n0 + nn) * ldd + k0 + 4 * b) = pk4_fp8(tp[0], tp[1], tp[2], tp[3]); }
    __syncthreads();
}
struct CmId { int off; __device__ __forceinline__ int operator()(int n) const { return off + n; } };
struct CmW1 { __device__ __forceinline__ int operator()(int n) const { return n < 512 ? n : (n < 2432 ? n + 512 : -1); } };
struct CmW2 { __device__ __forceinline__ int operator()(int n) const { return n < 2048 ? 2944 + n : 3456 + n; } };
struct CmWG { __device__ __forceinline__ int operator()(int n) const { return n < 512 ? 512 + n : (n < 1024 ? 4480 + n : 5504 + n); } };
struct CmWM { __device__ __forceinline__ int operator()(int n) const { const int pn = n >> 8, c = n & 255, bj = c >> 7, wc = (c >> 5) & 3, nn = (c >> 4) & 1, fq = (c >> 2) & 3, j = c & 3;
        return 7040 + (2 * bj + nn) * 1024 + 64 * pn + 16 * wc + 4 * fq + j; } };

__device__ __forceinline__ void phase_prep_weights(const Frame& F0) {
    Frame F = F0; { size_t z_ = 0; asm volatile("" : "+v"(F.tid), "+v"(F.lane), "+s"(z_), "+s"(F.bid), "+s"(F.G), "+s"(F.wave)); F.ws = F0.ws + z_; F.out = F0.out + z_; }
    for (int job = F.bid; job < 2 * 912; job += F.G) {
        const int li = job / 912; int j = job - li * 912;
        const float* win = F.in[I_WIN] + (size_t)li * D * N_IN;
        if (j < 160) { tr_strip(F, win, N_IN, (bf16_t*)(F.ws + WS_W1T) + (size_t)li * N1 * D, D, (j >> 2) * 64, (j & 3) * 256, CmW1()); continue; } j -= 160;
        if (j < 192) { tr_strip(F, win, N_IN, (bf16_t*)(F.ws + WS_W2T) + (size_t)li * N2 * D, D, (j >> 2) * 64, (j & 3) * 256, CmW2()); continue; } j -= 192;
        if (j < 96) { tr_strip(F, win, N_IN, (bf16_t*)(F.ws + WS_WGT) + (size_t)li * NG * D, D, (j >> 2) * 64, (j & 3) * 256, CmWG()); continue; } j -= 96;
        if (j < 256) { tr_strip8m(F, win, N_IN, (unsigned char*)(F.ws + WS_WMT) + (size_t)li * NM * D, D, (j >> 2) * 64, (j & 3) * 256, CmWM(), WM_SCALE); continue; } j -= 256;
        if (j < 128) { const int nb = j >> 5, r = j & 31;
            tr_strip(F, F.in[I_WBR] + ((size_t)li * 4 + nb) * 512 * D, D, (bf16_t*)(F.ws + WS_WBT) + ((size_t)li * 4 + nb) * D * 512, 512, (r >> 1) * 64, (r & 1) * 256, CmId{0}); continue; } j -= 128;
        if (j < 64) { tr_strip(F, F.in[I_WOUT] + (size_t)li * D * D, D, (bf16_t*)(F.ws + WS_WOT) + (size_t)li * D * D, D, (j >> 2) * 64, (j & 3) * 256, CmId{0}); continue; } j -= 64;
        tr_tile(F, F.in[I_G2] + (size_t)li * 128 * 512, 512, (bf16_t*)(F.ws + WS_G2T) + (size_t)li * 512 * 128, 128, (j >> 1) * 64, (j & 1) * 64, CmId{0});
    }
    for (int job = F.bid; job < 128; job += F.G) {
        if (job < 64) { const int li = job >> 5, d = (job >> 4) & 1, m = (job >> 3) & 1, nt = job & 7;
            tr_tile(F, F.in[m ? I_A2 : I_W2] + ((size_t)li * 2 + d) * 64 * 512, 512, (bf16_t*)(F.ws + WS_RW2T) + (((size_t)li * 2 + d) * 2 + m) * 512 * 64, 64, nt * 64, 0, CmId{0});
        } else { const int j = job - 64, li = j >> 5, d = (j >> 4) & 1, m = (j >> 3) & 1, g = j & 7;
            tr_tile(F, F.in[m ? I_WI : I_WR] + (((size_t)li * 2 + d) * 8 + g) * 64 * 64, 64, (bf16_t*)(F.ws + WS_LRUT) + ((((size_t)li * 2 + d) * 2 + m) * 8 + g) * 64 * 64, 64, 0, 0, CmId{0}); }
    }
    if (F.bid == 0) { float* lb = (float*)(F.ws + WS_LB); const float* h = F.in[I_HLB];
        for (int c = F.tid; c < 512; c += NTHREADS) { lb[c] = 0.f; lb[512 + c] = 1.0f / (1.0f + expf(h[c] - h[512 + c])); } }
}
__device__ __forceinline__ void phase_prep_experts(const Frame& F0, int li, int jlo, int jhi, int units) {
    Frame F = F0; { size_t z_ = 0; asm volatile("" : "+v"(F.tid), "+v"(F.lane), "+s"(z_), "+s"(F.bid), "+s"(F.G), "+s"(F.wave)); F.ws = F0.ws + z_; F.out = F0.out + z_; }
    const int nskip = (units > F.G && F.G > 64) ? units % F.G : 0;
    if (F.bid < nskip) return;
    for (int job = jlo + F.bid - nskip; job < jhi; job += F.G - nskip) {
        const bool is13 = job < NE * 256; const int e = is13 ? (job >> 8) : ((job - NE * 256) >> 7); int j = is13 ? (job & 255) : 256 + ((job - NE * 256) & 127);
        if (j < 256) { const int nt = j >> 2, ks = j & 3, p = nt >> 2, r = nt & 3, which = r >> 1, nsub = r & 1;
            const float* src = F.in[which ? I_EW3 : I_EW1] + ((size_t)li * NE + e) * D * DFF;
            const int n0 = 64 * nt;
            tr_strip8(F, src, DFF, (unsigned char*)F.out + OUT_W13 + (size_t)e * 4096 * D, D, n0, ks * 256, 128 * p + 64 * nsub - n0, W13_SCALE);
        } else { j -= 256;
            tr_strip8(F, F.in[I_EW2] + ((size_t)li * NE + e) * DFF * D, D, (unsigned char*)F.out + OUT_W2 + (size_t)e * D * DFF, DFF, (j >> 3) * 64, (j & 7) * 256, 0, W2_SCALE); }
    }
}

__device__ __forceinline__ void ln_stats(const float (&x)[16], float& mu, float& rstd) {
    float s = 0.f;
#pragma unroll
    for (int i = 0; i < 16; ++i) s += x[i];
    mu = wave_sum(s) * (1.0f / 1024.0f);
    float q = 0.f;
#pragma unroll
    for (int i = 0; i < 16; ++i) { const float dlt = x[i] - mu; q += dlt * dlt; }
    rstd = rsqrtf(wave_sum(q) * (1.0f / 1024.0f) + 1e-5f);
}
__device__ __forceinline__ void ld16_f32(const float* p, int lane, float (&x)[16]) {
#pragma unroll
    for (int j = 0; j < 2; ++j) { const f32x4 a = *(const f32x4*)(p + 512 * j + 8 * lane), b = *(const f32x4*)(p + 512 * j + 8 * lane + 4);
#pragma unroll
        for (int i = 0; i < 4; ++i) { x[8 * j + i] = a[i]; x[8 * j + 4 + i] = b[i]; } }
}
__device__ __forceinline__ void ld16_bf16(const bf16_t* p, int lane, float (&x)[16]) {
#pragma unroll
    for (int j = 0; j < 2; ++j) { const u32x4 a = *(const u32x4*)(p + 512 * j + 8 * lane); const unsigned w[4] = {a.x, a.y, a.z, a.w};
#pragma unroll
        for (int i = 0; i < 4; ++i) { x[8 * j + 2 * i] = bf2f((bf16_t)(w[i] & 0xffffu)); x[8 * j + 2 * i + 1] = bf2f((bf16_t)(w[i] >> 16)); } }
}
__device__ __forceinline__ void unpack16(const u32x4 (&a)[2], float (&x)[16]) {
#pragma unroll
    for (int j = 0; j < 2; ++j) { const unsigned w[4] = {a[j].x, a[j].y, a[j].z, a[j].w};
#pragma unroll
        for (int i = 0; i < 4; ++i) { x[8 * j + 2 * i] = bf2f((bf16_t)(w[i] & 0xffffu)); x[8 * j + 2 * i + 1] = bf2f((bf16_t)(w[i] >> 16)); } }
}
__device__ __forceinline__ void ldraw16(const bf16_t* p, int lane, u32x4 (&a)[2]) { a[0] = __builtin_nontemporal_load((const u32x4*)(p + 8 * lane)); a[1] = __builtin_nontemporal_load((const u32x4*)(p + 512 + 8 * lane)); }
__device__ __forceinline__ void st16_bf16(bf16_t* p, int lane, const float (&x)[16]) {
#pragma unroll
    for (int j = 0; j < 2; ++j) { u32x4 w; w.x = pk2(x[8 * j], x[8 * j + 1]); w.y = pk2(x[8 * j + 2], x[8 * j + 3]); w.z = pk2(x[8 * j + 4], x[8 * j + 5]); w.w = pk2(x[8 * j + 6], x[8 * j + 7]);
        *(u32x4*)(p + 512 * j + 8 * lane) = w; }
}
__device__ __forceinline__ void st16_fp8(unsigned char* p, int lane, const float (&x)[16]) {
#pragma unroll
    for (int j = 0; j < 2; ++j) { u32x2 w8; w8.x = pk4_fp8(x[8 * j], x[8 * j + 1], x[8 * j + 2], x[8 * j + 3]); w8.y = pk4_fp8(x[8 * j + 4], x[8 * j + 5], x[8 * j + 6], x[8 * j + 7]); *(u32x2*)(p + 512 * j + 8 * lane) = w8; }
}
__device__ __forceinline__ void st16_f32(float* p, int lane, const float (&x)[16]) {
#pragma unroll
    for (int j = 0; j < 2; ++j) { *(f32x4*)(p + 512 * j + 8 * lane) = (f32x4){x[8 * j], x[8 * j + 1], x[8 * j + 2], x[8 * j + 3]}; *(f32x4*)(p + 512 * j + 8 * lane + 4) = (f32x4){x[8 * j + 4], x[8 * j + 5], x[8 * j + 6], x[8 * j + 7]}; }
}
__device__ __forceinline__ void ln_apply(float (&x)[16], float mu, float rstd, const float (&gg)[16], const float (&bb)[16]) {
#pragma unroll
    for (int i = 0; i < 16; ++i) x[i] = (x[i] - mu) * rstd * gg[i] + bb[i];
}

__device__ __forceinline__ void phase_embed(const Frame& F0) {
    Frame F = F0; { size_t z_ = 0; asm volatile("" : "+v"(F.tid), "+v"(F.lane), "+s"(z_), "+s"(F.bid), "+s"(F.G), "+s"(F.wave)); F.ws = F0.ws + z_; F.out = F0.out + z_; }
    const int gw = F.bid * NWAVES + F.wave, nw = F.G * NWAVES;
    float gg[16], bb[16]; ld16_f32(F.in[I_LNEG], F.lane, gg); ld16_f32(F.in[I_LNEB], F.lane, bb);
    for (int row0 = gw; row0 < NTOK; row0 += 2 * nw) {
        float xs[2][16];
#pragma unroll
        for (int j = 0; j < 2; ++j) { const int row = row0 + j * nw; if (row < NTOK) { const int s = row / LSEQ, t = row - s * LSEQ;
            const float* src = (t < NMETA) ? F.in[I_META] + (size_t)t * D : ((s < NSEQ0) ? F.in[I_XP] + ((size_t)s * SEQ + (t - NMETA)) * D : F.in[I_XS] + ((size_t)(s - NSEQ0) * SEQ + (t - NMETA)) * D);
            ld16_f32(src, F.lane, xs[j]); } }
#pragma unroll
        for (int j = 0; j < 2; ++j) { const int row = row0 + j * nw; if (row < NTOK) {
            float mu, rstd; ln_stats(xs[j], mu, rstd); ln_apply(xs[j], mu, rstd, gg, bb);
            st16_bf16(F.hbuf() + (size_t)row * D, F.lane, xs[j]); st16_fp8((unsigned char*)F.out + OUT_HIN8 + (size_t)row * D, F.lane, xs[j]); } }
    }
}

__device__ __forceinline__ void phase_ln1_router(const Frame& F0, int li) {
    Frame F = F0; { size_t z_ = 0; asm volatile("" : "+v"(F.tid), "+v"(F.lane), "+s"(z_), "+s"(F.bid), "+s"(F.G), "+s"(F.wave)); F.ws = F0.ws + z_; F.out = F0.out + z_; }
    LAS float* RW = (LAS float*)F.lds;
    LAS unsigned* hl0 = (LAS unsigned*)(F.lds + 65536);
    for (int i = F.tid; i < 32 * 512; i += NTHREADS) hl0[i] = 0u;
    const float* router = F.in[I_ROUTER] + (size_t)li * D * NE;
    {
        float rv[32];
#pragma unroll
        for (int j = 0; j < 32; ++j) rv[j] = router[F.tid + j * NTHREADS];
#pragma unroll
        for (int j = 0; j < 32; ++j) { const int i = F.tid + j * NTHREADS; RW[(i & 15) * D + (i >> 4)] = rv[j]; } }
    { unsigned* hist = (unsigned*)(F.ws + WS_HIST); for (int i = F.bid * NTHREADS + F.tid; i < 2 * 32 * 1024; i += F.G * NTHREADS) hist[32 * 1024 + i] = 0u;
      if (F.bid == 0 && F.tid < 64) { unsigned* ctl = (unsigned*)(F.ws + WS_CTL); ctl[CW_CNT + F.tid] = 0u; ctl[CW_TIE + F.tid] = 0u; }
      int* stok = (int*)(F.ws + WS_STOK); float* sg = (float*)(F.ws + WS_SGATE);
      for (int i = F.bid * NTHREADS + F.tid; i < NE * (EROWS - EVALID); i += F.G * NTHREADS) { const int e = i / (EROWS - EVALID), r = EVALID + i % (EROWS - EVALID); stok[e * EROWS + r] = 0; sg[e * EROWS + r] = 0.f; } }
    __syncthreads();
    const bf16_t* X1 = (const bf16_t*)(F.ws + R_X1); float* aff = (float*)(F.ws + WS_AFF);
    float gg[16], bb[16]; ld16_f32(F.in[I_LN1G] + (size_t)li * D, F.lane, gg); ld16_f32(F.in[I_LN1B] + (size_t)li * D, F.lane, bb);
    const int gw = F.bid * NWAVES + F.wave, nw = F.G * NWAVES;
    for (int row0 = gw; row0 < NTOK; row0 += 4 * nw) {
      u32x4 XR[4][2];
#pragma unroll
      for (int jr = 0; jr < 4; ++jr) { const int row = row0 + jr * nw; if (row < NTOK) ldraw16(X1 + (size_t)row * D, F.lane, XR[jr]); }
#pragma unroll
      for (int jr = 0; jr < 4; ++jr) { const int row = row0 + jr * nw; if (row < NTOK) {
        float x[16]; unpack16(XR[jr], x);
        float mu, rstd; ln_stats(x, mu, rstd); ln_apply(x, mu, rstd, gg, bb);
        st16_bf16(F.hbuf() + (size_t)row * D, F.lane, x);
        { unsigned char* h8 = F.ws + R_H8 + (size_t)row * D;
#pragma unroll
          for (int j = 0; j < 2; ++j) { u32x2 w8; w8.x = pk4_fp8(x[8 * j], x[8 * j + 1], x[8 * j + 2], x[8 * j + 3]); w8.y = pk4_fp8(x[8 * j + 4], x[8 * j + 5], x[8 * j + 6], x[8 * j + 7]); *(u32x2*)(h8 + 512 * j + 8 * F.lane) = w8; } }
        float lg[16];
#pragma unroll
        for (int e = 0; e < 16; ++e) lg[e] = 0.f;
#pragma unroll 4
        for (int e = 0; e < 16; ++e) { float a = 0.f;
#pragma unroll
            for (int j = 0; j < 2; ++j) { const f32x4 w0 = *(const LAS f32x4*)(RW + e * D + 512 * j + 8 * F.lane), w1 = *(const LAS f32x4*)(RW + e * D + 512 * j + 8 * F.lane + 4);
                a += x[8 * j] * w0[0] + x[8 * j + 1] * w0[1] + x[8 * j + 2] * w0[2] + x[8 * j + 3] * w0[3] + x[8 * j + 4] * w1[0] + x[8 * j + 5] * w1[1] + x[8 * j + 6] * w1[2] + x[8 * j + 7] * w1[3]; }
            lg[e] = a; }
        float mx = -1e30f;
#pragma unroll
        for (int e = 0; e < 16; ++e) { lg[e] = wave_sum(lg[e]); mx = fmaxf(mx, lg[e]); }
        float den = 0.f;
#pragma unroll
        for (int e = 0; e < 16; ++e) { lg[e] = __expf(lg[e] - mx); den += lg[e]; }
        const float inv = __builtin_amdgcn_rcpf(den);
        float mine = 0.f;
#pragma unroll
        for (int e = 0; e < 16; ++e) mine = (F.lane == e) ? lg[e] * inv : mine;
        if (F.lane < 16) { aff[(size_t)row * 16 + F.lane] = mine;
            unsigned bin = __float_as_uint(mine) >> 20; if (bin > 1023u) bin = 1023u;
            (void)__hip_atomic_fetch_add(hl0 + ((row >= TOK0 ? 16 : 0) + F.lane) * 512 + (bin >> 1), 1u << (16 * (bin & 1u)), __ATOMIC_RELAXED, __HIP_MEMORY_SCOPE_WORKGROUP); }
      } }
    }
    __syncthreads();
    { unsigned* gh = (unsigned*)(F.ws + WS_HIST); for (int i = F.tid; i < 32 * 512; i += NTHREADS) { const unsigned v = hl0[i]; if (v & 0xffffu) atomicAdd(gh + 2 * i, v & 0xffffu); if (v >> 16) atomicAdd(gh + 2 * i + 1, v >> 16); } }
    __syncthreads();
}

__device__ __forceinline__ void find_bin(const unsigned* h, unsigned target, int lane, unsigned& bin, unsigned& rem, unsigned& bincnt) {
    unsigned c[16]; unsigned ls = 0;
#pragma unroll
    for (int i = 0; i < 16; ++i) { c[i] = __hip_atomic_load(h + 16 * lane + i, __ATOMIC_RELAXED, __HIP_MEMORY_SCOPE_AGENT); ls += c[i]; }
    unsigned x = ls;
#pragma unroll
    for (int o = 1; o < 64; o <<= 1) { const unsigned v = __shfl_down(x, o); if (lane + o < 64) x += v; }
    const unsigned above = x - ls;
    const bool own = (above < target) && (target <= above + ls);
    unsigned b = 0, r = 1, bc = 1;
    if (own) { unsigned cum = above; bool done = false;
#pragma unroll
        for (int i = 15; i >= 0; --i) { if (!done && target <= cum + c[i]) { b = 16 * lane + i; r = target - cum; bc = c[i]; done = true; } cum += c[i]; } }
    const unsigned long long m = __ballot(own);
    const int src = m ? (int)__builtin_ctzll(m) : 0;
    bin = __shfl(b, src); rem = __shfl(r, src); bincnt = __shfl(bc, src);
}
__device__ __forceinline__ void phase_topk(const Frame& F0, int pass) {
    Frame F = F0; { size_t z_ = 0; asm volatile("" : "+v"(F.tid), "+v"(F.lane), "+s"(z_), "+s"(F.bid), "+s"(F.G), "+s"(F.wave)); F.ws = F0.ws + z_; F.out = F0.out + z_; }
    LAS unsigned* hl = (LAS unsigned*)F.lds;
    LAS unsigned* selp = (LAS unsigned*)(F.lds + 131072);
    unsigned* hist = (unsigned*)(F.ws + WS_HIST);
    const float* aff = (const float*)(F.ws + WS_AFF);
    for (int i = F.tid; i < 32 * 1024; i += NTHREADS) hl[i] = 0u;
    for (int q = F.wave; q < 32; q += NWAVES) {
        const unsigned cap = (q < 16) ? CAP0 : CAP1; unsigned prefix = 0, rem = cap, bcnt = 0;
        if (pass > 1) { prefix = selp[q]; rem = selp[32 + q]; }
        { unsigned bin, r; find_bin(hist + ((size_t)(pass - 1) * 32 + q) * 1024, rem, F.lane, bin, r, bcnt); prefix = (pass == 1) ? bin : ((prefix << 10) | bin); rem = r; }
        if (F.lane == 0) { selp[q] = prefix; selp[32 + q] = rem; selp[64 + q] = bcnt; }
    }
    __syncthreads();
    if (pass < 3) {
        for (int tb0 = F.bid; tb0 < NTOK / 32; tb0 += 4 * F.G) {
            unsigned bv[4];
#pragma unroll
            for (int u = 0; u < 4; ++u) { const int tb = tb0 + u * F.G, tbc = tb < NTOK / 32 ? tb : NTOK / 32 - 1; bv[u] = __float_as_uint(aff[((size_t)tbc * 32 + (F.tid >> 4)) * 16 + (F.tid & 15)]); }
#pragma unroll
            for (int u = 0; u < 4; ++u) { const int tb = tb0 + u * F.G;
                const int t = tb * 32 + (F.tid >> 4), e = F.tid & 15, q = (t >= TOK0 ? 16 : 0) + e;
                const unsigned bits = bv[u];
                unsigned bin; bool ok;
                if (pass == 0) { bin = bits >> 20; ok = true; }
                else if (pass == 1) { bin = (bits >> 10) & 1023u; ok = (bits >> 20) == selp[q]; }
                else { bin = bits & 1023u; ok = (bits >> 10) == selp[q]; }
                if (bin > 1023u) bin = 1023u;
                if (ok && tb < NTOK / 32) (void)__hip_atomic_fetch_add(hl + q * 1024 + bin, 1u, __ATOMIC_RELAXED, __HIP_MEMORY_SCOPE_WORKGROUP); }
        }
        __syncthreads();
        unsigned* gh = hist + (size_t)pass * 32 * 1024;
        for (int i = F.tid; i < 32 * 1024; i += NTHREADS) { const unsigned v = hl[i]; if (v) atomicAdd(gh + i, v); }
    } else {
        unsigned* ctl = (unsigned*)(F.ws + WS_CTL); int* stok = (int*)(F.ws + WS_STOK); float* sg = (float*)(F.ws + WS_SGATE); int* inv = (int*)(F.ws + WS_INV);
        LAS unsigned* lcnt = selp + 96;
        LAS unsigned* lbase = selp + 128;
        if (F.tid < 32) lcnt[F.tid] = 0u;
        __syncthreads();
        auto selected = [&](int t, int e, int set, int q, unsigned bits) -> bool {
            const unsigned thr = selp[q]; bool sel = bits > thr; const bool tie = (bits == thr); if (tie) sel = true;
            unsigned long long need = __ballot(tie && (selp[64 + q] != selp[32 + q]));
            while (need) { const int src = (int)__builtin_ctzll(need); need &= need - 1;
                const int t_s = __shfl(t, src), e_s = __shfl(e, src), set_s = __shfl(set, src); const unsigned thr_s = __shfl(thr, src);
                unsigned c = 0; for (int t2 = (set_s ? TOK0 : 0) + F.lane; t2 < t_s; t2 += 64) c += (__float_as_uint(aff[(size_t)t2 * 16 + e_s]) == thr_s) ? 1u : 0u;
#pragma unroll
                for (int o = 32; o > 0; o >>= 1) c += __shfl_xor(c, o);
                if (F.lane == src) sel = c < selp[32 + q]; }
            return sel; };
        for (int tb = F.bid; tb < NTOK / 32; tb += F.G) {
            const int t = tb * 32 + (F.tid >> 4), e = F.tid & 15, set = (t >= TOK0) ? 1 : 0, q = set * 16 + e;
            if (selected(t, e, set, q, __float_as_uint(aff[(size_t)t * 16 + e]))) (void)__hip_atomic_fetch_add(lcnt + q, 1u, __ATOMIC_RELAXED, __HIP_MEMORY_SCOPE_WORKGROUP); }
        __syncthreads();
        if (F.tid < 32) { const unsigned n = lcnt[F.tid]; lbase[F.tid] = n ? atomicAdd(ctl + CW_CNT + F.tid, n) : 0u; lcnt[F.tid] = 0u; }
        __syncthreads();
        for (int tb = F.bid; tb < NTOK / 32; tb += F.G) {
            const int t = tb * 32 + (F.tid >> 4), e = F.tid & 15, set = (t >= TOK0) ? 1 : 0, q = set * 16 + e;
            const float a = aff[(size_t)t * 16 + e];
            int pos = -1;
            if (selected(t, e, set, q, __float_as_uint(a))) { const unsigned sl = lbase[q] + __hip_atomic_fetch_add(lcnt + q, 1u, __ATOMIC_RELAXED, __HIP_MEMORY_SCOPE_WORKGROUP); const unsigned cap = set ? CAP1 : CAP0;
                if (sl < cap) { pos = (int)(set ? CAP0 + sl : sl); stok[e * EROWS + pos] = t; sg[e * EROWS + pos] = a; } }
            inv[(size_t)t * 16 + e] = pos;
        }
    }
    __syncthreads();
}

__device__ __forceinline__ void phase_combine(const Frame& F0, int li) {
    Frame F = F0; { size_t z_ = 0; asm volatile("" : "+v"(F.tid), "+v"(F.lane), "+s"(z_), "+s"(F.bid), "+s"(F.G), "+s"(F.wave)); F.ws = F0.ws + z_; F.out = F0.out + z_; }
    const bf16_t* ye = (const bf16_t*)(F.ws + R_YE); const int* inv = (const int*)(F.ws + WS_INV);
    float gg[16], bb[16]; ld16_f32(F.in[I_LN2G] + (size_t)li * D, F.lane, gg); ld16_f32(F.in[I_LN2B] + (size_t)li * D, F.lane, bb);
    const int gw = F.bid * NWAVES + F.wave, nw = F.G * NWAVES;
    for (int row0 = gw; row0 < NTOK; row0 += 4 * nw) {
        u32x4 HR[4][2]; int iv[4];
#pragma unroll
        for (int j = 0; j < 4; ++j) { const int row = row0 + j * nw; iv[j] = -1; if (row < NTOK) { ldraw16(F.hbuf() + (size_t)row * D, F.lane, HR[j]); if (F.lane < 16) iv[j] = inv[(size_t)row * 16 + F.lane]; } }
        u32x4 Y0[4][2], Y1[4][2]; unsigned long long rest[4]; bool h0[4], h1[4];
#pragma unroll
        for (int j = 0; j < 4; ++j) { unsigned long long em = __ballot(iv[j] >= 0) & 0xFFFFull; h0[j] = false; h1[j] = false;
            if (em) { const int e = (int)__builtin_ctzll(em); em &= em - 1; const int p = __shfl(iv[j], e); ldraw16(ye + ((size_t)e * EROWS + p) * D, F.lane, Y0[j]); h0[j] = true; }
            if (em) { const int e = (int)__builtin_ctzll(em); em &= em - 1; const int p = __shfl(iv[j], e); ldraw16(ye + ((size_t)e * EROWS + p) * D, F.lane, Y1[j]); h1[j] = true; }
            rest[j] = em; }
#pragma unroll
        for (int j = 0; j < 4; ++j) { const int row = row0 + j * nw; if (row < NTOK) {
            float x[16]; unpack16(HR[j], x);
#pragma unroll
            for (int i = 0; i < 16; ++i) x[i] *= ALPHA;
            if (h0[j]) { float y[16]; unpack16(Y0[j], y);
#pragma unroll
                for (int i = 0; i < 16; ++i) x[i] += y[i]; }
            if (h1[j]) { float y[16]; unpack16(Y1[j], y);
#pragma unroll
                for (int i = 0; i < 16; ++i) x[i] += y[i]; }
            unsigned long long em = rest[j];
            while (em) { const int e = (int)__builtin_ctzll(em); em &= em - 1; const int p = __shfl(iv[j], e); float y[16]; ld16_bf16(ye + ((size_t)e * EROWS + p) * D, F.lane, y);
#pragma unroll
                for (int i = 0; i < 16; ++i) x[i] += y[i]; }
            float mu, rstd; ln_stats(x, mu, rstd); ln_apply(x, mu, rstd, gg, bb);
            if (li == NLAYER - 1) { const int s = row / LSEQ, t = row - s * LSEQ; if (t >= NMETA) st16_f32(F.out + ((size_t)s * SEQ + (t - NMETA)) * D, F.lane, x); }
            else { st16_bf16(F.hbuf() + (size_t)row * D, F.lane, x); st16_fp8((unsigned char*)F.out + OUT_HIN8 + (size_t)row * D, F.lane, x); } } }
    }
}

__device__ __forceinline__ f32x4 mfma16(bf16x8 x, bf16x8 y, f32x4 c) { return __builtin_amdgcn_mfma_f32_16x16x32_bf16(x, y, c, 0, 0, 0); }
__device__ __forceinline__ float dpp_f(float v, int ctrl_sel) {
    const int x = __float_as_int(v); int r;
    if (ctrl_sel == 0) r = __builtin_amdgcn_update_dpp(0, x, 0xB1, 0xF, 0xF, true);
    else if (ctrl_sel == 1) r = __builtin_amdgcn_update_dpp(0, x, 0x4E, 0xF, 0xF, true);
    else r = __builtin_amdgcn_update_dpp(0, x, 0x141, 0xF, 0xF, true);
    return __int_as_float(r);
}
__device__ __forceinline__ float red8(float v) { v += dpp_f(v, 0); v += dpp_f(v, 1); v += dpp_f(v, 2); return v; }
__device__ __forceinline__ float ldbf(const bf16_t* p) { return bf2f(*p); }

__device__ __forceinline__ bf16x8 pack4_(f32x4 a) { u32x4 r; r.x = pk2(a[0], a[1]); r.y = pk2(a[2], a[3]); r.z = 0u; r.w = 0u; return __builtin_bit_cast(bf16x8, r); }
__device__ __forceinline__ bf16x8 pack8_(f32x4 a, f32x4 b) { u32x4 r; r.x = pk2(a[0], a[1]); r.y = pk2(a[2], a[3]); r.z = pk2(b[0], b[1]); r.w = pk2(b[2], b[3]); return __builtin_bit_cast(bf16x8, r); }
__device__ __forceinline__ bf16x8 ld4_(const LAS bf16_t* p) { const u32x2 v = *(const LAS u32x2*)p; u32x4 r; r.x = v.x; r.y = v.y; r.z = 0u; r.w = 0u; return __builtin_bit_cast(bf16x8, r); }
__device__ __forceinline__ bf16x8 ld44_(const LAS bf16_t* p, const LAS bf16_t* q) { const u32x2 v = *(const LAS u32x2*)p, w = *(const LAS u32x2*)q; u32x4 r; r.x = v.x; r.y = v.y; r.z = w.x; r.w = w.y; return __builtin_bit_cast(bf16x8, r); }
__device__ __forceinline__ void rwkv_task(const Frame& F1, int li, int s, int d, int hg) {
    Frame F = F1; asm volatile("" : "+v"(F.tid), "+v"(F.lane));
    constexpr int DER = 17152;
    LAS float* ST = (LAS float*)(F.lds + 4 * DER);
    constexpr int STS = 260, STB = 2 * 16 * STS * 4;
    LAS bf16_t* TW = (LAS bf16_t*)(F.lds + 4 * DER + STB);
    LAS bf16_t* AD = TW + 16 * 72;
    LAS float* HS = (LAS float*)(F.lds + 4 * DER + STB + 4608);
    const int w = F.wave, hl = w >> 1, half = w & 1, h = 4 * hg + hl, lane = F.lane, fr = lane & 15, fq = lane >> 4, c = 64 * h + lane;
    LAS bf16_t* KAP = (LAS bf16_t*)(F.lds + hl * DER);
    LAS bf16_t* BH = KAP + 16 * 72; LAS bf16_t* KH = BH + 16 * 72; LAS bf16_t* RTL = KH + 16 * 72;
    LAS bf16_t* KBT = RTL + 16 * 72;
    LAS bf16_t* BBT = KBT + 64 * 20; LAS bf16_t* VT = BBT + 64 * 20;
    LAS float* GC = (LAS float*)(VT + 64 * 20);
    const bf16_t* U = F.ubuf();
    const float* mu = F.in[I_MU] + (size_t)li * 1920;
    const bf16_t* W2T = (const bf16_t*)(F.ws + WS_RW2T) + (((size_t)li * 2 + d) * 2 + 0) * 512 * 64 + (size_t)(64 * h + 32 * half + fr) * 64 + fq * 8; const bf16_t* A2T = W2T + (size_t)512 * 64;
    const float mu_r = mu[c], mu_k = mu[512 + c], mu_v = mu[1024 + c];
    const float w0c = F.in[I_W0][((size_t)li * 2 + d) * 512 + c], a0c = F.in[I_A0][((size_t)li * 2 + d) * 512 + c];
    const float kkc = F.in[I_KK][(size_t)li * 512 + c], kac = F.in[I_KA][(size_t)li * 512 + c], rkc = F.in[I_RK][(size_t)li * 512 + c];
    const int p_tt = F.tid >> 5, p_j = (F.tid & 31) * 2;
    const float mu_wd0 = mu[1536 + d * 64 + p_j], mu_wd1 = mu[1537 + d * 64 + p_j], mu_ad0 = mu[1664 + d * 64 + p_j], mu_ad1 = mu[1665 + d * 64 + p_j];
    float* bon = (float*)(F.ws + WS_BON);
    bf16_t* yout = (d == 0 ? F.br() : F.brx());
    const int ldy = (d == 0 ? 2048 : 1024);
    f32x4 Sacc[2][4];
#pragma unroll
    for (int it = 0; it < 2; ++it)
#pragma unroll
        for (int jt = 0; jt < 4; ++jt) Sacc[it][jt] = (f32x4){0.f, 0.f, 0.f, 0.f};
    const size_t rowbase = (size_t)s * LSEQ;
    const bool second = (d == 0) ? (half == 1) : (half == 0);
    unsigned pw[3], pa[3]; unsigned short pr[10], pk_[10], pv[10];
    auto prefetchA = [&](int t0) __attribute__((always_inline)) {
        { const int t = t0 + p_tt; const bf16_t* up = U + (rowbase + t) * N1 + 64 * d + p_j;
          const bf16_t* um = up - ((t > 0) ? N1 : 0); const bf16_t* upl = up + ((t < LSEQ - 1) ? N1 : 0);
          pw[1] = *(const unsigned*)(up + U1_WDN); pa[1] = *(const unsigned*)(up + U1_ADN);
          pw[0] = *(const unsigned*)(um + U1_WDN); pa[0] = *(const unsigned*)(um + U1_ADN);
          pw[2] = *(const unsigned*)(upl + U1_WDN); pa[2] = *(const unsigned*)(upl + U1_ADN); }
    };
    auto prefetchB = [&](int t0) __attribute__((always_inline)) {
        { const int tb = t0 + 8 * half - 1;
#pragma unroll
          for (int i = 0; i < 10; ++i) { int t = tb + i; t = t < 0 ? 0 : (t > LSEQ - 1 ? LSEQ - 1 : t); const bf16_t* up = U + (rowbase + t) * N1 + c;
            pr[i] = up[U1_R]; pk_[i] = up[U1_K]; pv[i] = up[U1_V]; } }
    };
    bf16x8 Xw[2][2], Xa[2][2];
#pragma unroll
    for (int ct = 0; ct < 2; ++ct)
#pragma unroll
        for (int ks = 0; ks < 2; ++ks) { Xw[ct][ks] = *(const bf16x8*)(W2T + ct * 16 * 64 + ks * 32); Xa[ct][ks] = *(const bf16x8*)(A2T + ct * 16 * 64 + ks * 32);
            asm volatile("" : "+v"(Xw[ct][ks]), "+v"(Xa[ct][ks])); }
    auto do_p1 = [&](int t0) __attribute__((always_inline)) {
        { float x[2], y[2];
          const unsigned mkm = (t0 + p_tt > 0) ? 0xffffffffu : 0u, mkp = (t0 + p_tt < LSEQ - 1) ? 0xffffffffu : 0u;
          const unsigned pw0 = pw[0] & mkm, pw2 = pw[2] & mkp, pa0 = pa[0] & mkm, pa2 = pa[2] & mkp;
#pragma unroll
          for (int e = 0; e < 2; ++e) { const int sh = 16 * e;
            const float x0 = bf2f((bf16_t)((pw[1] >> sh) & 0xffffu)), xm = bf2f((bf16_t)((pw0 >> sh) & 0xffffu)), xp = bf2f((bf16_t)((pw2 >> sh) & 0xffffu));
            const float y0 = bf2f((bf16_t)((pa[1] >> sh) & 0xffffu)), ym = bf2f((bf16_t)((pa0 >> sh) & 0xffffu)), yp = bf2f((bf16_t)((pa2 >> sh) & 0xffffu));
            { const float xa_ = x0 + (e ? mu_wd1 : mu_wd0) * (0.5f * (xm + xp) - x0); x[e] = 1.0f - 2.0f * __builtin_amdgcn_rcpf(1.0f + __expf(2.0f * xa_)); } y[e] = y0 + (e ? mu_ad1 : mu_ad0) * (0.5f * (ym + yp) - y0); }
          *(LAS unsigned*)(TW + p_tt * 72 + p_j) = pk2(x[0], x[1]); *(LAS unsigned*)(AD + p_tt * 72 + p_j) = pk2(y[0], y[1]); }
    };
    { const int t00 = (d == 0) ? 0 : LSEQ - 16, t01 = (d == 0) ? 16 : LSEQ - 32;
      prefetchA(t00); prefetchB(t00); do_p1(t00); prefetchA(t01); }
    __syncthreads();
    for (int ci = 0; ci < LSEQ / 16; ++ci) {
        const int t0 = (d == 0) ? 16 * ci : LSEQ - 16 - 16 * ci;
        { bf16x8 Yt[2], Ya[2];
#pragma unroll
          for (int ks = 0; ks < 2; ++ks) { Yt[ks] = *(const LAS bf16x8*)(TW + fr * 72 + ks * 32 + fq * 8); Ya[ks] = *(const LAS bf16x8*)(AD + fr * 72 + ks * 32 + fq * 8); }
#pragma unroll
          for (int ct = 0; ct < 2; ++ct) { f32x4 aw = (f32x4){0.f, 0.f, 0.f, 0.f}, aa = aw;
            aw = mfma16(Xw[ct][0], Yt[0], aw); aw = mfma16(Xw[ct][1], Yt[1], aw); aa = mfma16(Xa[ct][0], Ya[0], aa); aa = mfma16(Xa[ct][1], Ya[1], aa);
            *(LAS f32x4*)(ST + fr * STS + 64 * hl + 32 * half + ct * 16 + 4 * fq) = aw; *(LAS f32x4*)(ST + 16 * STS + fr * STS + 64 * hl + 32 * half + ct * 16 + 4 * fq) = aa; } }
        __syncthreads();
        { const bool lo_ok = (t0 + 8 * half - 1 >= 0), hi_ok = (t0 + 8 * half + 8 < LSEQ);
          if (!lo_ok) { pr[0] = 0; pk_[0] = 0; pv[0] = 0; }
          if (!hi_ok) { pr[9] = 0; pk_[9] = 0; pv[9] = 0; } }
        float lwv[8]; float tot = 0.f, other = 0.f;
#pragma unroll
        for (int i = 0; i < 8; ++i) { lwv[i] = -0.60653065971f * sigmoidf_(ST[(8 * half + i) * STS + 64 * hl + lane] + w0c); tot += lwv[i];
            other += -0.60653065971f * sigmoidf_(ST[(8 * (half ^ 1) + i) * STS + 64 * hl + lane] + w0c); }
        { const float off = second ? other : 0.f, glast = tot + other, eglast = __expf(glast);
          float run = 0.f, bsel = 0.f;
#pragma unroll
          for (int i = 0; i < 8; i += 2) {
            const int tt0 = 8 * half + i;
            const f32x2 rm = (f32x2){bf2f(pr[i]), bf2f(pr[i + 1])}, r1 = (f32x2){bf2f(pr[i + 1]), bf2f(pr[i + 2])}, rp = (f32x2){bf2f(pr[i + 2]), bf2f(pr[i + 3])};
            const f32x2 km = (f32x2){bf2f(pk_[i]), bf2f(pk_[i + 1])}, k1 = (f32x2){bf2f(pk_[i + 1]), bf2f(pk_[i + 2])}, kp = (f32x2){bf2f(pk_[i + 2]), bf2f(pk_[i + 3])};
            const f32x2 vm = (f32x2){bf2f(pv[i]), bf2f(pv[i + 1])}, v1 = (f32x2){bf2f(pv[i + 1]), bf2f(pv[i + 2])}, vp = (f32x2){bf2f(pv[i + 2]), bf2f(pv[i + 3])};
            const f32x2 r = r1 + mu_r * (0.5f * (rm + rp) - r1), k = k1 + mu_k * (0.5f * (km + kp) - k1), v = v1 + mu_v * (0.5f * (vm + vp) - v1);
            const f32x2 al = (f32x2){ST[16 * STS + tt0 * STS + 64 * hl + lane], ST[16 * STS + (tt0 + 1) * STS + 64 * hl + lane]} + a0c;
            const f32x2 a = (f32x2){sigmoidf_(al.x), sigmoidf_(al.y)};
            const f32x2 kd = k * (1.0f + (a - 1.0f) * kac), kk = k * kkc, sq = kk * kk, bs = r * kd * rkc;
            const f32x2 inrm = (f32x2){__builtin_amdgcn_rsqf(fmaxf(wave_sum(sq.x), 1e-24f)), __builtin_amdgcn_rsqf(fmaxf(wave_sum(sq.y), 1e-24f))};
            const float b0 = wave_sum(bs.x), b1 = wave_sum(bs.y);
            bsel = ((lane & 7) == i) ? b0 : (((lane & 7) == i + 1) ? b1 : bsel);
            const f32x2 kkn = kk * inrm, bt = kkn * a;
            run += lwv[i]; const float g0 = off + ((d == 0) ? run : (tot - run + lwv[i]));
            run += lwv[i + 1]; const float g1 = off + ((d == 0) ? run : (tot - run + lwv[i + 1]));
            const f32x2 eg = (f32x2){__expf(g0), __expf(g1)}, eng = (f32x2){__builtin_amdgcn_rcpf(eg.x), __builtin_amdgcn_rcpf(eg.y)}, ebar = eglast * eng;
            const f32x2 egm1 = (f32x2){__expf(g0 - lwv[i]), __expf(g1 - lwv[i + 1])};
            const f32x2 kap = kkn * egm1, bh = bt * eng, kh = kd * eng, rt = r * eg, kb = kd * ebar, bbn = -(bt * ebar);
            const int u0 = (d == 0) ? tt0 : 15 - tt0, u1 = (d == 0) ? u0 + 1 : u0 - 1, ulo = (d == 0) ? u0 : u1;
            { const unsigned p = pk2(kap.x, kap.y); KAP[u0 * 72 + lane] = (bf16_t)(p & 0xffffu); KAP[u1 * 72 + lane] = (bf16_t)(p >> 16); }
            { const unsigned p = pk2(bh.x, bh.y); BH[u0 * 72 + lane] = (bf16_t)(p & 0xffffu); BH[u1 * 72 + lane] = (bf16_t)(p >> 16); }
            { const unsigned p = pk2(kh.x, kh.y); KH[u0 * 72 + lane] = (bf16_t)(p & 0xffffu); KH[u1 * 72 + lane] = (bf16_t)(p >> 16); }
            { const unsigned p = pk2(rt.x, rt.y); RTL[u0 * 72 + lane] = (bf16_t)(p & 0xffffu); RTL[u1 * 72 + lane] = (bf16_t)(p >> 16); }
            { unsigned p = pk2(kb.x, kb.y); if (d) p = (p >> 16) | (p << 16); *(LAS unsigned*)(KBT + lane * 20 + ulo) = p; }
            { unsigned p = pk2(bbn.x, bbn.y); if (d) p = (p >> 16) | (p << 16); *(LAS unsigned*)(BBT + lane * 20 + ulo) = p; }
            { unsigned p = pk2(v.x, v.y); if (d) p = (p >> 16) | (p << 16); *(LAS unsigned*)(VT + lane * 20 + ulo) = p; } }
          bon[(rowbase + t0 + 8 * half + (lane & 7)) * 16 + d * 8 + h] = bsel;
          if (half == 0) GC[lane] = eglast; }
        if (ci + 1 < LSEQ / 16) { const int t1 = (d == 0) ? t0 + 16 : t0 - 16;
            prefetchB(t1);
            do_p1(t1);
            if (ci + 2 < LSEQ / 16) prefetchA((d == 0) ? t0 + 32 : t0 - 32); }
        __syncthreads();
        f32x4 aA = (f32x4){0.f, 0.f, 0.f, 0.f}, aAT = aA, aBT = aA, aC1 = aA, aC2 = aA;
#pragma unroll
        for (int ks = 0; ks < 2; ++ks) { const int o = fr * 72 + 32 * ks + 8 * fq;
            const bf16x8 fK = *(const LAS bf16x8*)(KAP + o), fB = *(const LAS bf16x8*)(BH + o), fH = *(const LAS bf16x8*)(KH + o), fR = *(const LAS bf16x8*)(RTL + o);
            aA = mfma16(fK, fB, aA); aAT = mfma16(fB, fK, aAT); aBT = mfma16(fH, fK, aBT); aC1 = mfma16(fH, fR, aC1); aC2 = mfma16(fB, fR, aC2); }
        f32x4 N, NT, H1;
#pragma unroll
        for (int e = 0; e < 4; ++e) { const int row = 4 * fq + e;
            N[e] = (fr < row) ? -aA[e] : 0.f; NT[e] = (row < fr) ? -aAT[e] : 0.f; aBT[e] = (row < fr) ? aBT[e] : 0.f;
            aC1[e] = (row <= fr) ? aC1[e] : 0.f; aC2[e] = (row <= fr) ? aC2[e] : 0.f; H1[e] = NT[e] + ((row == fr) ? 1.0f : 0.f); }
        const f32x4 Z4 = (f32x4){0.f, 0.f, 0.f, 0.f};
        const bf16x8 pN = pack4_(N), pNT = pack4_(NT);
        const f32x4 N2 = mfma16(pNT, pN, Z4), N2T = mfma16(pN, pNT, Z4);
        const bf16x8 pN2 = pack4_(N2), pN2T = pack4_(N2T);
        const f32x4 N4 = mfma16(pN2T, pN2, Z4), N4T = mfma16(pN2, pN2T, Z4);
        const bf16x8 pN4 = pack4_(N4);
        const f32x4 N8 = mfma16(pack4_(N4T), pN4, Z4);
        const f32x4 G1T = mfma16(pN2, pack4_(H1), H1);
        const f32x4 G2T = mfma16(pN4, pack4_(G1T), G1T);
        const f32x4 TT = mfma16(pack4_(N8), pack4_(G2T), G2T);
        const bf16x8 pTT = pack4_(TT), pBT = pack4_(aBT), pC1 = pack4_(aC1), pC2 = pack4_(aC2);
#pragma unroll
        for (int it = 0; it < 2; ++it) {
            const int i0 = 32 * half + 16 * it;
            const bf16x8 Vf = ld4_(VT + (i0 + fr) * 20 + 4 * fq);
            const bf16x8 Sf0 = pack8_(Sacc[it][0], Sacc[it][1]), Sf1 = pack8_(Sacc[it][2], Sacc[it][3]);
            f32x4 R = mfma16(ld44_(KAP + fr * 72 + 4 * fq, KAP + fr * 72 + 16 + 4 * fq), Sf0, Z4);
            R = mfma16(ld44_(KAP + fr * 72 + 32 + 4 * fq, KAP + fr * 72 + 48 + 4 * fq), Sf1, R);
            R = mfma16(pBT, Vf, R);
            const f32x4 Uu = mfma16(pTT, pack4_(R), Z4);
            f32x4 y = mfma16(Sf0, ld44_(RTL + fr * 72 + 4 * fq, RTL + fr * 72 + 16 + 4 * fq), Z4);
            y = mfma16(Sf1, ld44_(RTL + fr * 72 + 32 + 4 * fq, RTL + fr * 72 + 48 + 4 * fq), y);
            y = mfma16(Vf, pC1, y);
            const bf16x8 pU = pack4_(Uu), pUn = pack4_(-Uu);
            y = mfma16(pUn, pC2, y);
            { const int t = (d == 0) ? (t0 + fr) : (t0 + 15 - fr); u32x2 o; o.x = pk2(y[0], y[1]); o.y = pk2(y[2], y[3]);
              *(u32x2*)(yout + (rowbase + t) * ldy + 512 + 64 * h + i0 + 4 * fq) = o; }
#pragma unroll
            for (int jt = 0; jt < 4; ++jt) { const f32x4 dc = *(const LAS f32x4*)(GC + 16 * jt + 4 * fq);
                f32x4 acc = Sacc[it][jt] * dc;
                acc = mfma16(ld4_(KBT + (16 * jt + fr) * 20 + 4 * fq), Vf, acc);
                acc = mfma16(ld4_(BBT + (16 * jt + fr) * 20 + 4 * fq), pU, acc);
                Sacc[it][jt] = acc; }
            __builtin_amdgcn_sched_barrier(0);
        }
    }
    __syncthreads();
}

__device__ __forceinline__ void lru_block(const Frame& F1, int li, int s, int d, int g) {
    Frame F = F1; asm volatile("" : "+v"(F.tid), "+v"(F.lane));
    const int lane = F.lane, fr = lane & 15, fq = lane >> 4, c = 64 * g + lane;
    LAS bf16_t* XCT = (LAS bf16_t*)F.lds + F.wave * (16 * 72);
    constexpr int RSS = 68;
    LAS float* RS = (LAS float*)(F.lds + 18432) + F.wave * (3 * 16 * RSS);
    const bf16_t* U = F.ubuf();
    bf16x8 Xr[4][2], Xi[4][2];
    { const bf16_t* wrt = (const bf16_t*)(F.ws + WS_LRUT) + ((((size_t)li * 2 + d) * 2 + 0) * 8 + g) * 64 * 64; const bf16_t* wit = wrt + (size_t)8 * 64 * 64;
#pragma unroll
      for (int ct = 0; ct < 4; ++ct)
#pragma unroll
        for (int ks = 0; ks < 2; ++ks) { Xr[ct][ks] = *(const bf16x8*)(wrt + (ct * 16 + fr) * 64 + ks * 32 + fq * 8); Xi[ct][ks] = *(const bf16x8*)(wit + (ct * 16 + fr) * 64 + ks * 32 + fq * 8); } }
    const float* cw = F.in[I_CONVW] + (size_t)li * 4 * 512;
    const float cw0 = cw[c], cw1 = cw[512 + c], cw2 = cw[1024 + c], cw3 = cw[1536 + c], cb = F.in[I_CONVB][(size_t)li * 512 + c];
    const float brc = F.in[I_BR][((size_t)li * 2 + d) * 512 + c], bic = F.in[I_BI][((size_t)li * 2 + d) * 512 + c];
    const float lamfac = -8.0f * softplusf_(-F.in[I_LAM][((size_t)li * 2 + d) * 512 + c]);
    bf16_t* hout = (d == 0 ? F.br() : F.brx()); const int ldy = (d == 0 ? 2048 : 1024);
    const size_t rowbase = (size_t)s * LSEQ;
    float hs = 0.f;
    unsigned short px[19];
    auto lru_prefetch = [&](int t0) {
#pragma unroll
        for (int i = 0; i < 19; ++i) { int t = t0 - 2 + i; t = t < 0 ? 0 : (t > LSEQ - 1 ? LSEQ - 1 : t); px[i] = U[(rowbase + t) * N1 + U1_AX + c]; } };
    lru_prefetch((d == 0) ? 0 : LSEQ - 16);
    for (int ci = 0; ci < LSEQ / 16; ++ci) {
        const int t0 = (d == 0) ? 16 * ci : LSEQ - 16 - 16 * ci;
        { float xa[19];
#pragma unroll
          for (int i = 0; i < 19; ++i) { const int t = t0 - 2 + i; xa[i] = (t >= 0 && t < LSEQ) ? bf2f(px[i]) : 0.f; }
          if (ci + 1 < LSEQ / 16) lru_prefetch((d == 0) ? t0 + 16 : t0 - 16);
#pragma unroll
          for (int tt = 0; tt < 16; ++tt) { const float xc = cb + cw0 * xa[tt] + cw1 * xa[tt + 1] + cw2 * xa[tt + 2] + cw3 * xa[tt + 3];
            XCT[tt * 72 + lane] = f2bf(xc); RS[32 * RSS + tt * RSS + lane] = xc; } }
        { bf16x8 Y[2];
#pragma unroll
          for (int ks = 0; ks < 2; ++ks) Y[ks] = *(const LAS bf16x8*)(XCT + fr * 72 + ks * 32 + fq * 8);
#pragma unroll
          for (int ct = 0; ct < 4; ++ct) { f32x4 ar = (f32x4){0.f, 0.f, 0.f, 0.f}, ai = ar;
            ar = mfma16(Xr[ct][0], Y[0], ar); ar = mfma16(Xr[ct][1], Y[1], ar); ai = mfma16(Xi[ct][0], Y[0], ai); ai = mfma16(Xi[ct][1], Y[1], ai);
            *(LAS f32x4*)(RS + fr * RSS + ct * 16 + 4 * fq) = ar; *(LAS f32x4*)(RS + 16 * RSS + fr * RSS + ct * 16 + 4 * fq) = ai; } }
        { float av[16], bbv[16];
#pragma unroll
          for (int i = 0; i < 16; ++i) { const int tt = (d == 0) ? i : 15 - i;
            const float r = sigmoidf_(RS[tt * RSS + lane] + brc), ig = sigmoidf_(RS[16 * RSS + tt * RSS + lane] + bic), xc = RS[32 * RSS + tt * RSS + lane];
            const float a = __expf(lamfac * r); av[i] = a; bbv[i] = __builtin_amdgcn_sqrtf(fmaxf(1.0f - a * a, 0.f)) * ig * xc; }
#pragma unroll
          for (int i = 0; i < 16; ++i) { const int tt = (d == 0) ? i : 15 - i; hs = av[i] * hs + bbv[i]; hout[(rowbase + t0 + tt) * ldy + c] = f2bf(hs); } }
    }
}
__device__ __forceinline__ void lru_task(const Frame& F, int li, int s, int d) { lru_block(F, li, s, d, F.wave); __syncthreads(); }

__device__ __forceinline__ void phase_scan1(const Frame& F0, int li) {
    Frame F = F0; { size_t z_ = 0; asm volatile("" : "+v"(F.tid), "+v"(F.lane), "+s"(z_), "+s"(F.bid), "+s"(F.G), "+s"(F.wave)); F.ws = F0.ws + z_; F.out = F0.out + z_; }
    if (F.G == 256) {
        if (F.bid < 192) rwkv_task(F, li, F.bid >> 2, (F.bid >> 1) & 1, F.bid & 1);
        else {
            const int j = F.bid - 192, b0 = 12 * j + F.wave;
            lru_block(F, li, b0 >> 4, (b0 >> 3) & 1, b0 & 7);
            if (F.wave < 4) { const int b1 = 12 * j + 8 + F.wave; lru_block(F, li, b1 >> 4, (b1 >> 3) & 1, b1 & 7); }
            __syncthreads(); }
    } else {
        for (int task = F.bid; task < 288; task += F.G) {
            if (task < 192) rwkv_task(F, li, task >> 2, (task >> 1) & 1, task & 1);
            else lru_task(F, li, (task - 192) >> 1, (task - 192) & 1);
        }
    }
}

__device__ __forceinline__ void phase_post1(const Frame& F0, int li) {
    Frame F = F0; { size_t z_ = 0; asm volatile("" : "+v"(F.tid), "+v"(F.lane), "+s"(z_), "+s"(F.bid), "+s"(F.G), "+s"(F.wave)); F.ws = F0.ws + z_; F.out = F0.out + z_; }
    const int lane = F.lane, fr = lane & 15, fq = lane >> 4;
    LAS bf16_t* SG = (LAS bf16_t*)F.lds + F.wave * (16 * 136);
    const bf16_t* U = F.ubuf(); const bf16_t* G2T = (const bf16_t*)(F.ws + WS_G2T) + (size_t)li * 512 * 128;
    const float* mu = F.in[I_MU] + (size_t)li * 1920; const float* bon = (const float*)(F.ws + WS_BON);
    const float* lng = F.in[I_LNXG] + (size_t)li * 512; const float* lnb = F.in[I_LNXB] + (size_t)li * 512;
    bf16_t* BR = F.br(); const bf16_t* BRX = F.brx();
    LAS float* PM = (LAS float*)(F.lds + 40960);
    for (int i = F.tid; i < 512; i += NTHREADS) { PM[i] = mu[1024 + i]; PM[512 + i] = lng[i]; PM[1024 + i] = lnb[i]; }
    __syncthreads();
    const int gw = F.bid * NWAVES + F.wave, nw = F.G * NWAVES;
    for (int tile = gw; tile < NTOK / 16; tile += nw) {
        const int row0 = tile * 16;
#pragma unroll 4
        for (int r = 0; r < 16; ++r) { bf16_t* p = BR + (size_t)(row0 + r) * 2048 + 8 * lane; const u32x4 a = *(const u32x4*)p, b = *(const u32x4*)(BRX + (size_t)(row0 + r) * 1024 + 8 * lane);
            const unsigned aw[4] = {a.x, a.y, a.z, a.w}, bw[4] = {b.x, b.y, b.z, b.w}; unsigned o[4];
#pragma unroll
            for (int j = 0; j < 4; ++j) o[j] = pk2(bf2f((bf16_t)(aw[j] & 0xffffu)) + bf2f((bf16_t)(bw[j] & 0xffffu)), bf2f((bf16_t)(aw[j] >> 16)) + bf2f((bf16_t)(bw[j] >> 16)));
            u32x4 w; w.x = o[0]; w.y = o[1]; w.z = o[2]; w.w = o[3]; *(u32x4*)p = w; }
#pragma unroll 4
        for (int r = 0; r < 16; ++r) { const int row = row0 + r, s = row / LSEQ, t = row - s * LSEQ; const bf16_t* up = U + (size_t)row * N1 + U1_GDN + 2 * lane;
            const unsigned x0 = *(const unsigned*)up, xm = (t > 0) ? *(const unsigned*)(up - N1) : 0u, xp = (t < LSEQ - 1) ? *(const unsigned*)(up + N1) : 0u;
            const float m0 = mu[1792 + 2 * lane], m1 = mu[1793 + 2 * lane];
            const float a0 = bf2f((bf16_t)(x0 & 0xffffu)), a1 = bf2f((bf16_t)(x0 >> 16));
            const float g0 = a0 + m0 * (0.5f * (bf2f((bf16_t)(xm & 0xffffu)) + bf2f((bf16_t)(xp & 0xffffu))) - a0), g1 = a1 + m1 * (0.5f * (bf2f((bf16_t)(xm >> 16)) + bf2f((bf16_t)(xp >> 16))) - a1);
            *(LAS unsigned*)(SG + r * 136 + 2 * lane) = pk2(sigmoidf_(g0), sigmoidf_(g1)); }
        bf16x8 Y[4];
#pragma unroll
        for (int ks = 0; ks < 4; ++ks) Y[ks] = *(const LAS bf16x8*)(SG + fr * 136 + ks * 32 + fq * 8);
        const int row = row0 + fr, s = row / LSEQ, t = row - s * LSEQ;
        struct HIn { u32x2 a[4], b[4], v0[4], vm[4], vp[4]; float b0, b1; };
        auto hload = [&](int h, HIn& I) __attribute__((always_inline)) {
#pragma unroll
            for (int ct = 0; ct < 4; ++ct) { const int col = 512 + 64 * h + ct * 16 + 4 * fq; I.a[ct] = *(const u32x2*)(BR + (size_t)row * 2048 + col); I.b[ct] = *(const u32x2*)(BRX + (size_t)row * 1024 + col);
                const bf16_t* up = U + (size_t)row * N1 + U1_V + 64 * h + ct * 16 + 4 * fq;
                I.v0[ct] = *(const u32x2*)up; I.vm[ct] = *(const u32x2*)(up - ((t > 0) ? N1 : 0)); I.vp[ct] = *(const u32x2*)(up + ((t < LSEQ - 1) ? N1 : 0)); }
            I.b0 = bon[(size_t)row * 16 + h]; I.b1 = bon[(size_t)row * 16 + 8 + h]; };
        auto hcomp = [&](int h, const HIn& I) __attribute__((always_inline)) {
            f32x4 gacc[4];
#pragma unroll
            for (int ct = 0; ct < 4; ++ct) { gacc[ct] = (f32x4){0.f, 0.f, 0.f, 0.f};
#pragma unroll
                for (int ks = 0; ks < 4; ++ks) { const bf16x8 X = *(const bf16x8*)(G2T + (size_t)(64 * h + ct * 16 + fr) * 128 + ks * 32 + fq * 8); gacc[ct] = mfma16(X, Y[ks], gacc[ct]); } }
            float y[16]; float sm = 0.f;
#pragma unroll
            for (int ct = 0; ct < 4; ++ct) { const u32x2 a = I.a[ct], b = I.b[ct];
                y[4 * ct] = bf2f((bf16_t)(a.x & 0xffffu)) + bf2f((bf16_t)(b.x & 0xffffu)); y[4 * ct + 1] = bf2f((bf16_t)(a.x >> 16)) + bf2f((bf16_t)(b.x >> 16));
                y[4 * ct + 2] = bf2f((bf16_t)(a.y & 0xffffu)) + bf2f((bf16_t)(b.y & 0xffffu)); y[4 * ct + 3] = bf2f((bf16_t)(a.y >> 16)) + bf2f((bf16_t)(b.y >> 16)); }
#pragma unroll
            for (int i = 0; i < 16; ++i) sm += y[i];
            sm = rows_sum(sm);
            const float mean = sm * (1.0f / 64.0f); float q = 0.f;
#pragma unroll
            for (int i = 0; i < 16; ++i) { const float dl = y[i] - mean; q += dl * dl; }
            q = rows_sum(q);
            const float rstd = rsqrtf(q * (1.0f / 64.0f) + 64e-5f);
            const float bsum = I.b0 + I.b1;
            const unsigned mkm = (t > 0) ? 0xffffffffu : 0u, mkp = (t < LSEQ - 1) ? 0xffffffffu : 0u;
#pragma unroll
            for (int ct = 0; ct < 4; ++ct) { const int cc = 64 * h + ct * 16 + 4 * fq;
                const f32x4 pmu = *(const LAS f32x4*)(PM + cc), pg = *(const LAS f32x4*)(PM + 512 + cc), pb = *(const LAS f32x4*)(PM + 1024 + cc);
                const unsigned v0w[2] = {I.v0[ct].x, I.v0[ct].y}, vmw[2] = {I.vm[ct].x & mkm, I.vm[ct].y & mkm}, vpw[2] = {I.vp[ct].x & mkp, I.vp[ct].y & mkp}; float o[4];
#pragma unroll
                for (int e = 0; e < 4; ++e) { const int sh = (e & 1) * 16; const float x0 = bf2f((bf16_t)((v0w[e >> 1] >> sh) & 0xffffu)), xm = bf2f((bf16_t)((vmw[e >> 1] >> sh) & 0xffffu)), xp = bf2f((bf16_t)((vpw[e >> 1] >> sh) & 0xffffu));
                    const float v = x0 + pmu[e] * (0.5f * (xm + xp) - x0);
                    const float yn = (y[4 * ct + e] - mean) * rstd * pg[e] + pb[e];
                    o[e] = (yn + bsum * v) * gacc[ct][e]; }
                u32x2 w; w.x = pk2(o[0], o[1]); w.y = pk2(o[2], o[3]);
                *(u32x2*)(BR + (size_t)row * 2048 + 512 + cc) = w; } };
        HIn hN, hC;
        hload(0, hN);
#pragma unroll 1
        for (int h = 0; h < 8; ++h) { hC = hN;
            if (h + 1 < 8) hload(h + 1, hN);
            hcomp(h, hC); }
    }
    __syncthreads();
}

template <int DK>
__device__ __forceinline__ void gla_task(const Frame& F1, int li, int s, int hd, int d) {
    Frame F = F1; asm volatile("" : "+v"(F.tid), "+v"(F.lane));
    constexpr bool RET = (DK == 64); constexpr int QS = DK + 8, TS = 72, NDT = DK / 16, NKS = DK / 32;
    LAS bf16_t* QT = (LAS bf16_t*)F.lds;
    LAS bf16_t* KT = QT + 64 * QS;
    LAS bf16_t* KBT = KT + 64 * QS;
    LAS bf16_t* VT = KBT + DK * TS;
    LAS float* DEC = (LAS float*)(VT + 128 * TS);
    const int lane = F.lane, w = F.wave, fr = lane & 15, fq = lane >> 4, tid = F.tid;
    const bf16_t* U = F.ubuf();
    bf16_t* oout = (d == 0 ? F.br() : F.brx()); const int ldy = (d == 0 ? 2048 : 1024);
    const int ocol = (d == 0 ? (RET ? 1536 : 1024) : (RET ? 512 : 0)) + 128 * hd;
    const size_t rowbase = (size_t)s * LSEQ;
    const int pd = tid & 127, pg = tid >> 7;
    float lbv = 0.f, lgam = 0.f, invf = 0.f, cth = 1.f, sth = 0.f;
    if constexpr (!RET) lbv = ((const float*)(F.ws + WS_LB))[(size_t)li * 512 + 128 * hd + pd];
    else { const float gam = sigmoidf_(F.in[I_RDEC][((size_t)li * 2 + d) * 4 + hd]); lgam = __logf(gam);
           invf = expf(-(float)(tid & 31) * (9.210340371976184f / 32.0f)); cth = cosf(invf); sth = (d == 0) ? sinf(invf) : -sinf(invf); }
    f32x4 Sacc[NDT];
#pragma unroll
    for (int i = 0; i < NDT; ++i) Sacc[i] = (f32x4){0.f, 0.f, 0.f, 0.f};
    unsigned short ra[16], rb[16], rc[16];
    const int ri = tid & 31; const bool risk = (tid & 32) != 0; const int rg2 = tid >> 6;
    auto prefetch = [&](int sc) { const int nt = (sc < 32) ? 64 : 16, tau0 = 64 * sc;
        if (16 * pg < nt) { const int tb = tau0 + 16 * pg;
#pragma unroll
            for (int i = 0; i < 16; ++i) { const int t = d ? (LSEQ - 1 - (tb + i)) : (tb + i); const bf16_t* up = U + (rowbase + t) * N2 + 128 * hd + pd;
                if constexpr (!RET) { ra[i] = up[U2_CQ]; rb[i] = up[U2_CF + 512 * d]; rc[i] = up[U2_CI]; } else rc[i] = up[U2_DV]; } }
        if constexpr (RET) { if (8 * rg2 < nt) { const int tb = tau0 + 8 * rg2; const int tfirst = d ? (LSEQ - 1 - tb) : tb;
#pragma unroll
            for (int j = 0; j < 8; ++j) { const int t = d ? (tfirst - j) : (tfirst + j); const bf16_t* up = U + (rowbase + t) * N2 + (risk ? U2_DK : U2_DQ) + 64 * hd + ri; ra[j] = up[0]; rb[j] = up[32]; } } } };
    prefetch(0);
    for (int sc = 0; sc < 33; ++sc) {
        const int nt = (sc < 32) ? 64 : 16, nsub = nt >> 4, tau0 = 64 * sc;
        if (16 * pg < nt) {
            if constexpr (!RET) {
                float kk[16]; float eb = 1.0f;
#pragma unroll
                for (int i = 0; i < 16; ++i) { const float fr_ = bf2f(rb[i]), sg = sigmoidf_(fr_); const float f = lbv + (1.0f - lbv) * sg, k = (1.0f - lbv) * (1.0f - sg);
                    eb *= f; const float enb = __builtin_amdgcn_rcpf(eb); const float q = siluf_(bf2f(ra[i])) * 0.08838834764831845f;
                    QT[(16 * pg + i) * QS + pd] = f2bf(q * eb); KT[(16 * pg + i) * QS + pd] = f2bf(k * enb); kk[i] = k * enb;
                    VT[pd * TS + 16 * pg + i] = rc[i]; }
#pragma unroll
                for (int i = 0; i < 16; i += 2) *(LAS unsigned*)(KBT + pd * TS + 16 * pg + i) = pk2(kk[i] * eb, kk[i + 1] * eb);
                DEC[pg * DK + pd] = eb;
            } else {
#pragma unroll
                for (int i = 0; i < 16; ++i) VT[pd * TS + 16 * pg + i] = rc[i];
                if (pd < 64) DEC[pg * DK + pd] = __expf(16.0f * lgam);
            }
        }
        if constexpr (RET) {
            if (8 * rg2 < nt) {
                const int tb = tau0 + 8 * rg2; const int tfirst = d ? (LSEQ - 1 - tb) : tb;
                const float ang = (float)tfirst * invf; float cs = cosf(ang), sn = sinf(ang);
#pragma unroll
                for (int j = 0; j < 8; ++j) { const int tl = 8 * rg2 + j, il = tl & 15; const float x1 = bf2f(ra[j]), x2 = bf2f(rb[j]);
                    const float o1 = x1 * cs - x2 * sn, o2 = x1 * sn + x2 * cs;
                    if (!risk) { const float sc_ = __expf((float)(il + 1) * lgam); QT[tl * QS + ri] = f2bf(o1 * sc_); QT[tl * QS + ri + 32] = f2bf(o2 * sc_); }
                    else { const float s1 = 0.125f * __expf(-(float)(il + 1) * lgam), s2 = 0.125f * __expf((float)(15 - il) * lgam);
                        KT[tl * QS + ri] = f2bf(o1 * s1); KT[tl * QS + ri + 32] = f2bf(o2 * s1); KBT[ri * TS + tl] = f2bf(o1 * s2); KBT[(ri + 32) * TS + tl] = f2bf(o2 * s2); }
                    const float cn = cs * cth - sn * sth; sn = sn * cth + cs * sth; cs = cn; }
            }
        }
        if (sc + 1 < 33) prefetch(sc + 1);
        __syncthreads();
#pragma unroll 2
        for (int g = 0; g < nsub; ++g) {
            const int r0 = 16 * g;
            f32x4 aacc = (f32x4){0.f, 0.f, 0.f, 0.f};
#pragma unroll
            for (int ks = 0; ks < NKS; ++ks) { const bf16x8 X = *(const LAS bf16x8*)(KT + (r0 + fr) * QS + 32 * ks + 8 * fq), Y = *(const LAS bf16x8*)(QT + (r0 + fr) * QS + 32 * ks + 8 * fq); aacc = mfma16(X, Y, aacc); }
#pragma unroll
            for (int e = 0; e < 4; ++e) aacc[e] = (4 * fq + e <= fr) ? aacc[e] : 0.f;
            u32x4 ya; ya.x = pk2(aacc[0], aacc[1]); ya.y = pk2(aacc[2], aacc[3]); ya.z = 0u; ya.w = 0u;
            const u32x2 vv = *(const LAS u32x2*)(VT + (16 * w + fr) * TS + r0 + 4 * fq);
            u32x4 xv; xv.x = vv.x; xv.y = vv.y; xv.z = 0u; xv.w = 0u;
            f32x4 o = (f32x4){0.f, 0.f, 0.f, 0.f};
            o = mfma16(__builtin_bit_cast(bf16x8, xv), __builtin_bit_cast(bf16x8, ya), o);
#pragma unroll
            for (int ks = 0; ks < NKS; ++ks) { u32x4 xs; xs.x = pk2(Sacc[2 * ks][0], Sacc[2 * ks][1]); xs.y = pk2(Sacc[2 * ks][2], Sacc[2 * ks][3]); xs.z = pk2(Sacc[2 * ks + 1][0], Sacc[2 * ks + 1][1]); xs.w = pk2(Sacc[2 * ks + 1][2], Sacc[2 * ks + 1][3]);
                const u32x2 q0 = *(const LAS u32x2*)(QT + (r0 + fr) * QS + 32 * ks + 4 * fq), q1 = *(const LAS u32x2*)(QT + (r0 + fr) * QS + 32 * ks + 16 + 4 * fq);
                u32x4 yq; yq.x = q0.x; yq.y = q0.y; yq.z = q1.x; yq.w = q1.y;
                o = mfma16(__builtin_bit_cast(bf16x8, xs), __builtin_bit_cast(bf16x8, yq), o); }
            { const int tau = tau0 + r0 + fr, t = d ? (LSEQ - 1 - tau) : tau; u32x2 ov; ov.x = pk2(o[0], o[1]); ov.y = pk2(o[2], o[3]);
              *(u32x2*)(oout + (rowbase + t) * ldy + ocol + 16 * w + 4 * fq) = ov; }
#pragma unroll
            for (int dt = 0; dt < NDT; ++dt) { const f32x4 dc = *(const LAS f32x4*)(DEC + g * DK + 16 * dt + 4 * fq);
                const u32x2 kb = *(const LAS u32x2*)(KBT + (16 * dt + fr) * TS + r0 + 4 * fq); u32x4 xk; xk.x = kb.x; xk.y = kb.y; xk.z = 0u; xk.w = 0u;
                Sacc[dt] = mfma16(__builtin_bit_cast(bf16x8, xk), __builtin_bit_cast(bf16x8, xv), Sacc[dt] * dc); }
        }
        __syncthreads();
    }
}
__device__ __forceinline__ void phase_scan2(const Frame& F0, int li) {
    Frame F = F0; { size_t z_ = 0; asm volatile("" : "+v"(F.tid), "+v"(F.lane), "+s"(z_), "+s"(F.bid), "+s"(F.G), "+s"(F.wave)); F.ws = F0.ws + z_; F.out = F0.out + z_; }
    for (int task = F.bid; task < 768; task += F.G) {
        const int k = task % 384, s = k >> 3, hd = (k >> 1) & 3, d = k & 1;
                if (task < 384) gla_task<128>(F, li, s, hd, d); else gla_task<64>(F, li, s, hd, d);
    }
}
__device__ __forceinline__ void phase_post2(const Frame& F0, int li) {
    Frame F = F0; { size_t z_ = 0; asm volatile("" : "+v"(F.tid), "+v"(F.lane), "+s"(z_), "+s"(F.bid), "+s"(F.G), "+s"(F.wave)); F.ws = F0.ws + z_; F.out = F0.out + z_; }
    const int lane = F.lane; bf16_t* BR = F.br(); const bf16_t* BRX = F.brx();
    { unsigned* hist = (unsigned*)(F.ws + WS_HIST); for (int i = F.bid * NTHREADS + F.tid; i < 32 * 1024; i += F.G * NTHREADS) hist[i] = 0u; }
    const float* ng = F.in[I_HNG] + (size_t)li * 512 + 8 * lane;
    float g8[8];
#pragma unroll
    for (int i = 0; i < 8; ++i) g8[i] = ng[i];
    const int gw = F.bid * NWAVES + F.wave, nw = F.G * NWAVES;
    for (int row0 = gw; row0 < NTOK; row0 += 4 * nw) {
        u32x4 A[4][2], B[4][2];
#pragma unroll
        for (int j = 0; j < 4; ++j) { const int row = row0 + j * nw; if (row < NTOK) {
#pragma unroll
            for (int sec = 0; sec < 2; ++sec) { A[j][sec] = __builtin_nontemporal_load((const u32x4*)(BR + (size_t)row * 2048 + 1024 + 512 * sec + 8 * lane)); B[j][sec] = __builtin_nontemporal_load((const u32x4*)(BRX + (size_t)row * 1024 + 512 * sec + 8 * lane)); } } }
#pragma unroll
        for (int j = 0; j < 4; ++j) { const int row = row0 + j * nw; if (row < NTOK) {
#pragma unroll
            for (int sec = 0; sec < 2; ++sec) {
                const unsigned aw[4] = {A[j][sec].x, A[j][sec].y, A[j][sec].z, A[j][sec].w}, bw[4] = {B[j][sec].x, B[j][sec].y, B[j][sec].z, B[j][sec].w}; float o[8];
#pragma unroll
                for (int i = 0; i < 4; ++i) { o[2 * i] = bf2f((bf16_t)(aw[i] & 0xffffu)) + bf2f((bf16_t)(bw[i] & 0xffffu)); o[2 * i + 1] = bf2f((bf16_t)(aw[i] >> 16)) + bf2f((bf16_t)(bw[i] >> 16)); }
                float sm = 0.f;
                if (sec == 1) {
#pragma unroll
                    for (int i = 0; i < 8; ++i) sm += o[i];
                    sm += dppx(sm, 0); sm += dppx(sm, 1); sm += dppx(sm, 2); sm += dppx(sm, 3);
                    sm *= (1.0f / 128.0f); }
                float q = 0.f;
#pragma unroll
                for (int i = 0; i < 8; ++i) { o[i] -= sm; q += o[i] * o[i]; }
                q += dppx(q, 0); q += dppx(q, 1); q += dppx(q, 2); q += dppx(q, 3);
                const float rs = rsqrtf(q * (1.0f / 128.0f) + 1e-6f);
#pragma unroll
                for (int i = 0; i < 8; ++i) o[i] = o[i] * rs * (sec == 0 ? g8[i] : 1.0f);
                u32x4 wv; wv.x = pk2(o[0], o[1]); wv.y = pk2(o[2], o[3]); wv.z = pk2(o[4], o[5]); wv.w = pk2(o[6], o[7]);
                *(u32x4*)(BR + (size_t)row * 2048 + 1024 + 512 * sec + 8 * lane) = wv; } } }
    }
}

constexpr int NPL = 17, NPHASE = 1 + NLAYER * NPL;
__global__ void __launch_bounds__(NTHREADS, 2) mega(Args args) {
    extern __shared__ __attribute__((aligned(16))) unsigned char lds_raw[];
    Frame F; F.in = args.in; F.out = args.out; F.ws = args.ws; F.lds = (LAS unsigned char*)lds_raw; F.ldsg = lds_raw;
    F.tid = threadIdx.x; F.lane = F.tid & 63; F.wave = __builtin_amdgcn_readfirstlane(F.tid >> 6); F.G = gridDim.x; F.bid = blockIdx.x;
    const int lo = args.ph_lo, hi = args.ph_hi;
    const bool single = (hi - lo) > 1;
    volatile LAS unsigned* misc = (volatile LAS unsigned*)(F.lds + LDS_MISC);
    if (F.tid < 8) misc[F.tid] = 0u;
    __syncthreads();
    XcdBarrier bar; bar.bar = (unsigned*)(F.ws + WS_CTL) + CW_BAR; bar.x = 0; bar.st = misc;
    if (single) bar = xcd_barrier_post((unsigned*)(F.ws + WS_CTL) + CW_BAR, misc);
#ifndef PH_MASK
#define PH_MASK 0xFFFFFFu
#endif
#define PHON(o) (((PH_MASK) >> (o)) & 1u)
#ifndef DUP_MASK
#define DUP_MASK 0u
#endif
#define DUPN(o) (1 + (int)(((DUP_MASK) >> (o)) & 1u))
#define CJ_A1 904
#define CJ_A2 1784
#define CJ_G  2974
#define CJ_P  3390
#define CJ_M  4096
#define IN(k) (lo <= (k) && (k) < hi)
#define SEAM(k) do { if (IN(k) && IN((k) + 1)) xcd_barrier(bar); } while (0)
    LAS unsigned char* glds = F.lds;
    if (PHON(20) && IN(0)) { phase_prep_weights(F); phase_embed(F); }
    SEAM(0);
    if (single) {
        if (F.tid == 0) { unsigned ok = ((F.G & 7) == 0) ? 1u : 0u;
            for (int j = 0; j < 16; ++j) { const unsigned cj = xb_ld(bar.bar + XB_XCNT(j)); if (j < 8 ? (cj != (unsigned)F.G / 8u) : (cj != 0u)) ok = 0u; }
            const unsigned r = misc[2]; misc[3] = (ok && bar.x < 8u && r < (unsigned)F.G / 8u) ? (r * 8u + bar.x) : (unsigned)F.bid; }
        __syncthreads();
        F.bid = __builtin_amdgcn_readfirstlane((int)misc[3]);
    }
    for (int li = 0; li < NLAYER; ++li) {
        const int pb = 1 + li * NPL;
        for (int rep = 0; rep < DUPN(0); ++rep) if (PHON(0) && IN(pb + 0)) { Frame Fq = F; { size_t z_ = 0; asm volatile("" : "+s"(z_), "+s"(Fq.bid), "+s"(Fq.G)); Fq.ws = F.ws + z_; Fq.out = F.out + z_; } const Frame& F = Fq;
            SchedPlain S; S.T.init(NTILE_M, N1 / 256, F.G, F.bid); S.A = (const char*)F.hbuf(); S.B = (const char*)(F.ws + WS_W1T + (size_t)li * N1 * D * 2); S.astep = (size_t)256 * D * 2; S.bstep = (size_t)256 * D * 2;
            EpiStoreBf16 E; E.O0 = E.O1 = E.O2 = E.O3 = F.ubuf(); E.ldo = N1;
            pg8::gemm_phase<EpiStoreBf16, SchedPlain, false>(glds, D, D, D, S, E); }
        if (PHON(0) && IN(pb + 0)) phase_prep_experts(F, li, 0, CJ_A1, NTILE_M * (N1 / 256));
        SEAM(pb + 0);
        for (int rep = 0; rep < DUPN(1); ++rep) if (PHON(1) && IN(pb + 1)) phase_scan1(F, li);
        SEAM(pb + 1);
        if (PHON(2) && IN(pb + 2)) phase_post1(F, li);
        SEAM(pb + 2);
        for (int rep = 0; rep < DUPN(3); ++rep) if (PHON(3) && IN(pb + 3)) { Frame Fq = F; { size_t z_ = 0; asm volatile("" : "+s"(z_), "+s"(Fq.bid), "+s"(Fq.G)); Fq.ws = F.ws + z_; Fq.out = F.out + z_; } const Frame& F = Fq;
            SchedPlain S; S.T.init(NTILE_M, N2 / 256, F.G, F.bid); S.A = (const char*)F.hbuf(); S.B = (const char*)(F.ws + WS_W2T + (size_t)li * N2 * D * 2); S.astep = (size_t)256 * D * 2; S.bstep = (size_t)256 * D * 2;
            EpiStoreBf16 E; E.O0 = E.O1 = E.O2 = E.O3 = F.ubuf(); E.ldo = N2;
            pg8::gemm_phase<EpiStoreBf16, SchedPlain, false>(glds, D, D, D, S, E); }
        if (PHON(3) && IN(pb + 3)) phase_prep_experts(F, li, CJ_A1, CJ_A2, NTILE_M * (N2 / 256));
        SEAM(pb + 3);
        for (int rep = 0; rep < DUPN(4); ++rep) if (PHON(4) && IN(pb + 4)) phase_scan2(F, li);
        SEAM(pb + 4);
        if (PHON(5) && IN(pb + 5)) phase_post2(F, li);
        SEAM(pb + 5);
        if (PHON(6) && IN(pb + 6)) { Frame Fq = F; { size_t z_ = 0; asm volatile("" : "+s"(z_), "+s"(Fq.bid), "+s"(Fq.G)); Fq.ws = F.ws + z_; Fq.out = F.out + z_; } const Frame& F = Fq;
            SchedPlain S; S.T.init(NTILE_M, NG / 256, F.G, F.bid); S.A = (const char*)F.hbuf(); S.B = (const char*)(F.ws + WS_WGT + (size_t)li * NG * D * 2); S.astep = (size_t)256 * D * 2; S.bstep = (size_t)256 * D * 2;
            EpiGate E; E.BR = F.br();
            pg8::gemm_phase<EpiGate, SchedPlain, false>(glds, D, D, D, S, E); }
        if (PHON(6) && IN(pb + 6)) phase_prep_experts(F, li, CJ_A2, CJ_G, NTILE_M * (NG / 256));
        SEAM(pb + 6);
        for (int rep = 0; rep < DUPN(7); ++rep) if (PHON(7) && IN(pb + 7)) { Frame Fq = F; { size_t z_ = 0; asm volatile("" : "+s"(z_), "+s"(Fq.bid), "+s"(Fq.G)); Fq.ws = F.ws + z_; Fq.out = F.out + z_; } const Frame& F = Fq;
            SchedP S; S.T.init(NTILE_M, 16, F.G, F.bid); S.A = (const char*)F.br(); S.B = (const char*)(F.ws + WS_WBT + (size_t)li * 4 * D * 512 * 2);
            EpiStoreBf16 E; E.O0 = F.pb(0); E.O1 = F.pb(1); E.O2 = F.pb(2); E.O3 = F.pb(3); E.ldo = D;
            pg8::gemm_phase<EpiStoreBf16, SchedP, false>(glds, 512, 2048, 512, S, E); }
        if (PHON(7) && IN(pb + 7)) phase_prep_experts(F, li, CJ_G, CJ_P, NTILE_M * 16);
        SEAM(pb + 7);
        for (int rep = 0; rep < DUPN(8); ++rep) if (PHON(8) && IN(pb + 8)) { Frame Fq = F; { size_t z_ = 0; asm volatile("" : "+s"(z_), "+s"(Fq.bid), "+s"(Fq.G)); Fq.ws = F.ws + z_; Fq.out = F.out + z_; } const Frame& F = Fq;
            SchedPlain S; S.T.init(NTILE_M, NM / 256, F.G, F.bid); S.A = (const char*)F.out + OUT_HIN8; S.B = (const char*)(F.ws + WS_WMT + (size_t)li * NM * D); S.astep = (size_t)256 * D; S.bstep = (size_t)256 * D;
            EpiMerge E; E.PB0 = F.pb(0); E.PB1 = F.pb(1); E.PB2 = F.pb(2); E.PB3 = F.pb(3); E.MG = (bf16_t*)(F.ws + R_MERGED);
            pg8::gemm_phase<EpiMerge, SchedPlain, false, true>(glds, D / 2, D / 2, D / 2, S, E); }
        if (PHON(8) && IN(pb + 8)) phase_prep_experts(F, li, CJ_P, CJ_M, NTILE_M * (NM / 256));
        SEAM(pb + 8);
        if (PHON(9) && IN(pb + 9) && ((F.bid & 1) == 0)) phase_prep_experts(F, li, CJ_M, NE * 384, 4 * NTILE_M);
        for (int rep = 0; rep < DUPN(9); ++rep) if (PHON(9) && IN(pb + 9)) { Frame Fq = F; { size_t z_ = 0; asm volatile("" : "+s"(z_), "+s"(Fq.bid), "+s"(Fq.G)); Fq.ws = F.ws + z_; Fq.out = F.out + z_; } const Frame& F = Fq;
            SchedPlain S; S.T.init(NTILE_M, D / 256, F.G, F.bid); S.A = (const char*)(F.ws + R_MERGED); S.B = (const char*)(F.ws + WS_WOT + (size_t)li * D * D * 2); S.astep = (size_t)256 * D * 2; S.bstep = (size_t)256 * D * 2;
            EpiOut E; E.H = F.hbuf(); E.X1 = (bf16_t*)(F.ws + R_X1);
            pg8::gemm_phase<EpiOut, SchedPlain, false>(glds, D, D, D, S, E); }
        if (PHON(9) && IN(pb + 9) && ((F.bid & 1) == 1)) phase_prep_experts(F, li, CJ_M, NE * 384, 4 * NTILE_M);
        SEAM(pb + 9);
        if (PHON(10) && IN(pb + 10)) phase_ln1_router(F, li);
        SEAM(pb + 10);
        for (int p = 1; p < 4; ++p) { if (PHON(11) && IN(pb + 10 + p)) phase_topk(F, p); SEAM(pb + 10 + p); }
        for (int rnd = 0; rnd < 1; ++rnd) {
            for (int rep = 0; rep < DUPN(15); ++rep) if (PHON(15) && IN(pb + 14 + 2 * rnd)) { Frame Fq = F; { size_t z_ = 0; asm volatile("" : "+s"(z_), "+s"(Fq.bid), "+s"(Fq.G)); Fq.ws = F.ws + z_; Fq.out = F.out + z_; } const Frame& F = Fq;
                SchedE1 S; S.T.init(NE * ETILES, 16, F.G, F.bid); S.A = (const char*)(F.ws + R_H8); S.B = (const char*)F.out + OUT_W13; S.stok = (const int*)(F.ws + WS_STOK); S.e0 = 0;
                EpiSwiglu E; E.HE = (unsigned char*)(F.ws + R_HE);
                pg8::gemm_phase<EpiSwiglu, SchedE1, true, true>(glds, D / 2, D / 2, D / 2, S, E); }
            SEAM(pb + 14 + 2 * rnd);
            for (int rep = 0; rep < DUPN(16); ++rep) if (PHON(16) && IN(pb + 15 + 2 * rnd)) { Frame Fq = F; { size_t z_ = 0; asm volatile("" : "+s"(z_), "+s"(Fq.bid), "+s"(Fq.G)); Fq.ws = F.ws + z_; Fq.out = F.out + z_; } const Frame& F = Fq;
                SchedE2 S; S.T.init(NE * ETILES, 4, F.G, F.bid); S.A = (const char*)(F.ws + R_HE); S.B = (const char*)F.out + OUT_W2; S.e0 = 0;
                EpiScale E; E.YE = (bf16_t*)(F.ws + R_YE); E.SG = (const float*)(F.ws + WS_SGATE);
                pg8::gemm_phase<EpiScale, SchedE2, false, true>(glds, DFF / 2, DFF / 2, DFF / 2, S, E); }
            SEAM(pb + 15 + 2 * rnd);
        }
        if (PHON(19) && IN(pb + 16)) phase_combine(F, li);
        SEAM(pb + 16);
    }
}

#ifndef MK_SINGLE
#define MK_SINGLE 1
#endif
extern "C" void kernel_launch(void* const* d_in, const int* in_sizes, int n_in, void* d_out, int out_size, void* d_ws, size_t ws_size, hipStream_t stream) {
    static int grid = 0;
    if (grid == 0) {
        if (n_in != 37 || in_sizes[0] != NSEQ0 * SEQ * D || out_size != NSEQ * SEQ * D || ws_size < WS_END) {
            fprintf(stderr, "kernel_launch: unexpected shapes: n_in %d in0 %d out %d ws %zu (need %zu); nothing launched\n", n_in, n_in > 0 ? in_sizes[0] : -1, out_size, ws_size, (size_t)WS_END); grid = -1; return; }
        int dev = 0, cus = 0, per_cu = 0;
        if (hipGetDevice(&dev) != hipSuccess || hipDeviceGetAttribute(&cus, hipDeviceAttributeMultiprocessorCount, dev) != hipSuccess) { grid = -1; return; }
        if (hipFuncSetAttribute((const void*)mega, hipFuncAttributeMaxDynamicSharedMemorySize, LDS_BYTES) != hipSuccess) { fprintf(stderr, "kernel_launch: hipFuncSetAttribute failed\n"); grid = -1; return; }
        if (hipOccupancyMaxActiveBlocksPerMultiprocessor(&per_cu, (const void*)mega, NTHREADS, LDS_BYTES) != hipSuccess || per_cu < 1) fprintf(stderr, "kernel_launch: occupancy query reports %d\n", per_cu);
        (void)hipGetLastError();
        grid = cus;
    }
    if (grid < 0) return;
    if (hipMemsetAsync((char*)d_ws + WS_CTL, 0, CTL_BYTES, stream) != hipSuccess) return;
    Args a{};
    for (int i = 0; i < 37; ++i) a.in[i] = (const float*)d_in[i];
    a.out = (float*)d_out; a.ws = (unsigned char*)d_ws;
#if MK_SINGLE
    a.ph_lo = 0; a.ph_hi = NPHASE;
    hipLaunchKernelGGL(mega, dim3(grid), dim3(NTHREADS), LDS_BYTES, stream, a);
#else
    for (int p = 0; p < NPHASE; ++p) { a.ph_lo = p; a.ph_hi = p + 1; hipLaunchKernelGGL(mega, dim3(grid), dim3(NTHREADS), LDS_BYTES, stream, a); }
#endif
}
```
